# Optimizing an MI355X kernel written in HIP

```python
import math
import jax, jax.numpy as jnp
from jax import lax
import numpy as np

D_MODEL = 1024
BATCH = 16
SEQ = 2048
DEPTH = 1

MIX_WIDTH = D_MODEL
FNET_WIDTH = MIX_WIDTH // 2
FNET_GROUPS = 4
FNET_GROUP_DIM = FNET_WIDTH // FNET_GROUPS
HEAD_DIM = 64
N_Q_HEADS = (MIX_WIDTH - FNET_WIDTH) // HEAD_DIM
N_KV_HEADS = 2
GQA_GROUP = N_Q_HEADS // N_KV_HEADS
ATTN_WIDTH = N_Q_HEADS * HEAD_DIM
KV_WIDTH = N_KV_HEADS * HEAD_DIM
IN_WIDTH = FNET_WIDTH + ATTN_WIDTH + 2 * KV_WIDTH
D_FF = 2752
GRID_W = 64
AXIS_DIM = HEAD_DIM // 2
ROPE_THETA = 10000.0
Q_BLOCK = 128
EPS = 1e-6

kernel_name = "hybrid_fnet_gqa_axial_macaron_encoder"


def rms_norm(x, g):
    xf = x.astype(jnp.float32)
    y = xf * lax.rsqrt(jnp.mean(xf * xf, axis=-1, keepdims=True) + EPS)
    return (y * g.astype(jnp.float32)).astype(x.dtype)


def swiglu(h, w_gate, w_up, w_down):
    return (jax.nn.silu(h @ w_gate) * (h @ w_up)) @ w_down


def axial_rope_tables(seq):
    rows = seq // GRID_W
    row_idx = jnp.repeat(jnp.arange(rows, dtype=jnp.float32), GRID_W)
    col_idx = jnp.tile(jnp.arange(GRID_W, dtype=jnp.float32), rows)
    inv_freq = ROPE_THETA ** (-jnp.arange(0, AXIS_DIM, 2, dtype=jnp.float32) / AXIS_DIM)
    ang_r = row_idx[:, None] * inv_freq[None, :]
    ang_c = col_idx[:, None] * inv_freq[None, :]
    return jnp.cos(ang_r), jnp.sin(ang_r), jnp.cos(ang_c), jnp.sin(ang_c)


def rotate(x, cos, sin):
    half = x.shape[-1] // 2
    x1, x2 = x[..., :half], x[..., half:]
    c = cos[None, :, None, :].astype(x.dtype)
    s = sin[None, :, None, :].astype(x.dtype)
    return jnp.concatenate([x1 * c - x2 * s, x1 * s + x2 * c], axis=-1)


def apply_axial_rope(x, tables):
    cr, sr, cc, sc = tables
    return jnp.concatenate([rotate(x[..., :AXIS_DIM], cr, sr),
                            rotate(x[..., AXIS_DIM:], cc, sc)], axis=-1)


def fourier_mixer(hf, fnet_w, fnet_b):
    b, s, _ = hf.shape
    g = hf.reshape(b, s, FNET_GROUPS, FNET_GROUP_DIM).astype(jnp.float32)
    mixed = jnp.real(jnp.fft.fft2(g, axes=(1, 3), norm="ortho")).astype(hf.dtype)
    out = jnp.einsum('bsgc,gcd->bsgd', mixed, fnet_w) + fnet_b[None, None]
    return out.reshape(b, s, FNET_WIDTH)


def gqa_attention(q, k, v, q_norm, k_norm):
    b, s, _ = q.shape
    q = rms_norm(q.reshape(b, s, N_Q_HEADS, HEAD_DIM), q_norm)
    k = rms_norm(k.reshape(b, s, N_KV_HEADS, HEAD_DIM), k_norm)
    v = v.reshape(b, s, N_KV_HEADS, HEAD_DIM)
    tables = axial_rope_tables(s)
    q = apply_axial_rope(q, tables)
    k = apply_axial_rope(k, tables)
    scale = 1.0 / math.sqrt(HEAD_DIM)
    n_blocks = s // Q_BLOCK
    qb = q.reshape(b, n_blocks, Q_BLOCK, N_KV_HEADS, GQA_GROUP, HEAD_DIM)
    qb = jnp.moveaxis(qb, 1, 0)

    def attend_block(q_blk):
        scores = jnp.einsum('bqhgd,bkhd->bhgqk', q_blk, k).astype(jnp.float32) * scale
        p = jax.nn.softmax(scores, axis=-1).astype(v.dtype)
        return jnp.einsum('bhgqk,bkhd->bqhgd', p, v)

    o = lax.map(attend_block, qb)
    o = jnp.moveaxis(o, 0, 1)
    return o.reshape(b, s, ATTN_WIDTH)


def setup_inputs(seed: int = 0) -> dict:
    key = jax.random.key(seed)
    ks = jax.random.split(key, 20)
    D, F = D_MODEL, D_FF
    nrm = lambda k, shape, fan_in: jax.random.normal(k, shape, jnp.float32) * fan_in ** -0.5
    gain = lambda k, n: 1.0 + 0.05 * jax.random.normal(k, (n,), jnp.float32)
    return {
        "x": jax.random.normal(ks[0], (BATCH, SEQ, D), jnp.float32),
        "ffn1_norm": gain(ks[1], D),
        "ffn1_w_gate": nrm(ks[2], (D, F), D),
        "ffn1_w_up": nrm(ks[3], (D, F), D),
        "ffn1_w_down": nrm(ks[4], (F, D), F),
        "mix_norm": gain(ks[5], D),
        "w_in": nrm(ks[6], (D, IN_WIDTH), D),
        "fnet_w": nrm(ks[7], (FNET_GROUPS, FNET_GROUP_DIM, FNET_GROUP_DIM), FNET_GROUP_DIM),
        "fnet_b": 0.02 * jax.random.normal(ks[8], (FNET_GROUPS, FNET_GROUP_DIM), jnp.float32),
        "q_norm": gain(ks[9], HEAD_DIM),
        "k_norm": gain(ks[10], HEAD_DIM),
        "w_out": nrm(ks[11], (MIX_WIDTH, D), MIX_WIDTH),
        "ffn2_norm": gain(ks[12], D),
        "ffn2_w_gate": nrm(ks[13], (D, F), D),
        "ffn2_w_up": nrm(ks[14], (D, F), D),
        "ffn2_w_down": nrm(ks[15], (F, D), F),
        "final_norm": gain(ks[16], D),
    }


def reference(x, ffn1_norm, ffn1_w_gate, ffn1_w_up, ffn1_w_down, mix_norm, w_in,
              fnet_w, fnet_b, q_norm, k_norm, w_out, ffn2_norm, ffn2_w_gate,
              ffn2_w_up, ffn2_w_down, final_norm):
    for _ in range(DEPTH):
        x = x + 0.5 * swiglu(rms_norm(x, ffn1_norm), ffn1_w_gate, ffn1_w_up, ffn1_w_down)
        h = rms_norm(x, mix_norm)
        u = h @ w_in
        o0 = FNET_WIDTH
        o1 = o0 + ATTN_WIDTH
        o2 = o1 + KV_WIDTH
        f_out = fourier_mixer(u[..., :o0], fnet_w, fnet_b)
        a_out = gqa_attention(u[..., o0:o1], u[..., o1:o2], u[..., o2:], q_norm, k_norm)
        x = x + jnp.concatenate([f_out, a_out], axis=-1) @ w_out
        x = x + 0.5 * swiglu(rms_norm(x, ffn2_norm), ffn2_w_gate, ffn2_w_up, ffn2_w_down)
    return rms_norm(x, final_norm)
```

```cpp
#include <hip/hip_runtime.h>
#include <hip/hip_bf16.h>
#include <cstdio>
#include <cstdint>
#include <cmath>
namespace pg8 {
#define PG8_LAS __attribute__((address_space(3)))
typedef unsigned short bf16_t;
typedef short bf16x8 __attribute__((ext_vector_type(8)));
typedef float f32x4 __attribute__((ext_vector_type(4)));
typedef unsigned u32x4 __attribute__((ext_vector_type(4)));
constexpr int BM = 256, BK = 64, HALF = 128, HTB = HALF * BK * 2  , STAGE_BYTES = 8 * HTB, NXCD = 8, WGM = 8;

__host__ __device__ __forceinline__ int lds_byte(int r, int c) { const int st = (r >> 4) * 2 + (c >> 5), rr = r & 15, cc = c & 31, ob = rr * 64 + cc * 2; return st * 1024 + (ob ^ (((ob >> 9) & 1) << 5)); }
__host__ __device__ __forceinline__ void stage_rc(int b, int& R, int& C) { const int st = b / 1024, sb = b % 1024, swz = sb ^ (((sb >> 9) & 1) << 5); R = (st >> 1) * 16 + swz / 64; C = (st & 1) * 32 + (swz % 64) / 2; }
__host__ __device__ __forceinline__ int perm32(int rho) { const int n = rho >> 4, i = rho & 15; return 8 * (i >> 2) + 4 * n + (i & 3); }

struct Unit { int pm, pn, arow, brow; };
struct Gemm { const bf16_t* A; const bf16_t* Bt; int M, N, K; };

struct StaticOrder {
    int nM, nN, nwg, G, c, dft;
    __host__ __device__ void init(int M, int N, int G_, int c_) { nM = M / BM; nN = N / BM; nwg = nM * nN; G = G_; c = c_; dft = 0; }
    __host__ __device__ bool next(int i, Unit& u) const {
        const long L = (long)i * G + c; if (L >= nwg) return false;
        int wgid = (int)L; { const int q = nwg / NXCD, r = nwg % NXCD, xcd = wgid % NXCD, off = wgid / NXCD; wgid = (xcd < r ? xcd * (q + 1) : r * (q + 1) + (xcd - r) * q) + off; }
        const int nig = WGM * nN, gid = wgid / nig, fm = gid * WGM, gsz = (nM - fm) < WGM ? (nM - fm) : WGM;
        u.pm = fm + ((wgid % nig) % gsz); u.pn = (wgid % nig) / gsz;
        if (dft) { u.arow = u.pm & 7; u.brow = (u.pm >> 3) * 2 + u.pn; } else { u.arow = u.pm; u.brow = u.pn; }
        return true;
    }
    __device__ __forceinline__ void a_ready(const Unit&) const {}
    __device__ __forceinline__ void done(const Unit&) const {}
};


typedef float f32x2_t __attribute__((ext_vector_type(2))); typedef __bf16 bf16x2_t __attribute__((ext_vector_type(2)));
typedef unsigned u32x2 __attribute__((ext_vector_type(2)));
__device__ __forceinline__ unsigned cvt_pk_bf16(float lo, float hi) { f32x2_t v = {lo, hi}; bf16x2_t b = __builtin_convertvector(v, bf16x2_t); return __builtin_bit_cast(unsigned, b); }
constexpr int DM_ = 1024;
constexpr float EPS_ = 1e-6f;
__device__ __forceinline__ float row_rstd(const float* __restrict__ stats, int row, int fq) {
    const f32x4 v = *(const f32x4*)((const char*)stats + ((unsigned)row * 64u + 16u * (unsigned)fq));
    float s = (v[0] + v[1]) + (v[2] + v[3]);
    s += __shfl_xor(s, 16); s += __shfl_xor(s, 32);
    return __builtin_amdgcn_rsqf(s * (1.0f / DM_) + EPS_);
}

struct EpiSwiGLU {
    static constexpr bool PERM = true, AFTER_DRAIN = false;
    bf16_t* __restrict__ O; const float* __restrict__ stats;
    __device__ __forceinline__ void operator()(const f32x4 (&acc)[2][2][4][2], const Unit& u, int wr, int wc, int fr_in, int fq_in, PG8_LAS unsigned char*) const {
        int fr = fr_in, fq = fq_in; asm volatile("" : "+v"(fr), "+v"(fq));
        const int row0 = u.pm * BM + wr * 64 + fr, col0 = u.pn * 128 + wc * 32 + 8 * fq;
#pragma unroll
        for (int ai = 0; ai < 2; ++ai)
#pragma unroll
            for (int m = 0; m < 4; ++m) {
                const int row = row0 + ai * HALF + m * 16;
                const float rs = row_rstd(stats, row, fq);
                float a[8];
#pragma unroll
                for (int n = 0; n < 2; ++n)
#pragma unroll
                    for (int j = 0; j < 4; ++j) {
                        const float g = acc[ai][0][m][n][j] * rs, up = acc[ai][1][m][n][j] * rs;
                        const float e = __builtin_amdgcn_exp2f(g * -1.4426950408889634f);
                        a[n * 4 + j] = g * __builtin_amdgcn_rcpf(1.0f + e) * up;
                    }
                u32x4 w; w.x = cvt_pk_bf16(a[0], a[1]); w.y = cvt_pk_bf16(a[2], a[3]); w.z = cvt_pk_bf16(a[4], a[5]); w.w = cvt_pk_bf16(a[6], a[7]);
                *(u32x4*)(O + (size_t)row * 2816 + col0) = w;
            }
    }
};

struct EpiResid {
    static constexpr bool PERM = false, AFTER_DRAIN = false;
    const float* __restrict__ resid; float* __restrict__ out; bf16_t* __restrict__ outb; float* __restrict__ stats_out; const float* __restrict__ bias; float alpha;
    __device__ __forceinline__ void operator()(const f32x4 (&acc)[2][2][4][2], const Unit& u, int wr, int wc, int fr_in, int fq_in, PG8_LAS unsigned char*) const {
        int fr = fr_in, fq = fq_in; asm volatile("" : "+v"(fr), "+v"(fq));
        const int row0 = u.pm * BM + wr * 64 + fr, col0 = u.pn * BM + wc * 32 + 4 * fq;
        f32x4 bv[2][2];
#pragma unroll
        for (int bj = 0; bj < 2; ++bj)
#pragma unroll
            for (int n = 0; n < 2; ++n) bv[bj][n] = bias ? *(const f32x4*)(bias + col0 + bj * HALF + n * 16) : (f32x4){0.f, 0.f, 0.f, 0.f};
#pragma unroll
        for (int ai = 0; ai < 2; ++ai)
#pragma unroll
            for (int m = 0; m < 4; ++m) {
                const int row = row0 + ai * HALF + m * 16; const size_t off = (size_t)row * DM_ + col0; float ss = 0.f;
#pragma unroll
                for (int bj = 0; bj < 2; ++bj)
#pragma unroll
                    for (int n = 0; n < 2; ++n) {
                        const f32x4 r = *(const f32x4*)(resid + off + bj * HALF + n * 16);
                        const f32x4 o = r + acc[ai][bj][m][n] * alpha + bv[bj][n];
                        *(f32x4*)(out + off + bj * HALF + n * 16) = o;
                        ss += (o[0] * o[0] + o[1] * o[1]) + (o[2] * o[2] + o[3] * o[3]);
                        if (outb) { u32x2 w; w.x = cvt_pk_bf16(o[0], o[1]); w.y = cvt_pk_bf16(o[2], o[3]); *(u32x2*)(outb + off + bj * HALF + n * 16) = w; }
                    }
                ss += __shfl_xor(ss, 16); ss += __shfl_xor(ss, 32);
                if (stats_out && fq == 0) stats_out[(size_t)row * 16 + u.pn * 4 + wc] = ss;
            }
    }
};

struct EpiBf16Plain {
    static constexpr bool PERM = true, AFTER_DRAIN = false;
    bf16_t* __restrict__ O; int ldc;
    __device__ __forceinline__ void operator()(const f32x4 (&acc)[2][2][4][2], const Unit& u, int wr, int wc, int fr_in, int fq_in, PG8_LAS unsigned char*) const {
        int fr = fr_in, fq = fq_in; asm volatile("" : "+v"(fr), "+v"(fq));
        const int row0 = u.pm * BM + wr * 64 + fr, col0 = u.pn * BM + wc * 32 + 8 * fq;
#pragma unroll
        for (int ai = 0; ai < 2; ++ai)
#pragma unroll
            for (int m = 0; m < 4; ++m) { bf16_t* rowp = O + (size_t)(row0 + ai * HALF + m * 16) * ldc + col0;
#pragma unroll
                for (int bj = 0; bj < 2; ++bj) { const f32x4 v0 = acc[ai][bj][m][0], v1 = acc[ai][bj][m][1];
                    u32x4 w; w.x = cvt_pk_bf16(v0[0], v0[1]); w.y = cvt_pk_bf16(v0[2], v0[3]); w.z = cvt_pk_bf16(v1[0], v1[1]); w.w = cvt_pk_bf16(v1[2], v1[3]);
                    *(u32x4*)(rowp + bj * HALF) = w; } }
    }
};

struct EpiWin {
    static constexpr bool PERM = false, AFTER_DRAIN = false;
    const float* __restrict__ stats; bf16_t* __restrict__ XT; bf16_t* __restrict__ Qb; bf16_t* __restrict__ Kb; bf16_t* __restrict__ Vb;
    const float* __restrict__ qn; const float* __restrict__ kn; const float* __restrict__ ropeC; const float* __restrict__ ropeS;
    template <int TY> __device__ __forceinline__ void head_path(const f32x4 (&acc)[2][2][4][2], bf16_t* __restrict__ dst, unsigned pitchb, const float* __restrict__ gn, const float (&rs)[2][4], int row0, int fq) const {
        const float qs = (TY == 0) ? 0.125f * 1.4426950408889634f : 1.0f;
        const unsigned fqb = 16u * (unsigned)fq;
#pragma unroll
        for (int ai = 0; ai < 2; ++ai)
#pragma unroll
            for (int m = 0; m < 4; ++m) {
                const int row = row0 + ai * HALF + m * 16; const int s = row & 2047;
                f32x4 v[2][2];
#pragma unroll
                for (int bj = 0; bj < 2; ++bj)
#pragma unroll
                    for (int n = 0; n < 2; ++n) v[bj][n] = acc[ai][bj][m][n] * rs[ai][m];
                if (TY != 2) {
                    float ss = 0.f;
#pragma unroll
                    for (int bj = 0; bj < 2; ++bj)
#pragma unroll
                        for (int n = 0; n < 2; ++n) ss += (v[bj][n][0] * v[bj][n][0] + v[bj][n][1] * v[bj][n][1]) + (v[bj][n][2] * v[bj][n][2] + v[bj][n][3] * v[bj][n][3]);
                    ss += __shfl_xor(ss, 16); ss += __shfl_xor(ss, 32);
                    const float r = __builtin_amdgcn_rsqf(ss * (1.0f / 64.0f) + EPS_);
#pragma unroll
                    for (int bj = 0; bj < 2; ++bj) {
                        const unsigned pos = bj ? (unsigned)(s & 63) : (unsigned)(s >> 6);
                        const f32x4 c = *(const f32x4*)((const char*)ropeC + (pos * 64u + fqb)), sn = *(const f32x4*)((const char*)ropeS + (pos * 64u + fqb));
                        const f32x4 g1 = *(const f32x4*)((const char*)gn + (128u * bj + fqb)), g2 = *(const f32x4*)((const char*)gn + (128u * bj + 64u + fqb));
                        const f32x4 x1 = v[bj][0] * r * g1, x2 = v[bj][1] * r * g2;
                        v[bj][0] = (x1 * c - x2 * sn) * qs; v[bj][1] = (x1 * sn + x2 * c) * qs;
                    }
                }
                const unsigned ob = (unsigned)row * pitchb + 8u * (unsigned)fq;
#pragma unroll
                for (int bj = 0; bj < 2; ++bj)
#pragma unroll
                    for (int n = 0; n < 2; ++n) { u32x2 w; w.x = cvt_pk_bf16(v[bj][n][0], v[bj][n][1]); w.y = cvt_pk_bf16(v[bj][n][2], v[bj][n][3]); *(u32x2*)((char*)dst + (ob + 64u * bj + 32u * n)) = w; }
                asm volatile("" ::: "memory"); __builtin_amdgcn_sched_barrier(0);
            }
    }
    __device__ __forceinline__ void operator()(const f32x4 (&acc)[2][2][4][2], const Unit& u, int wr, int wc, int fr_in, int fq_in, PG8_LAS unsigned char* lds) const {
        int fr = fr_in, fq = fq_in; asm volatile("" : "+v"(fr), "+v"(fq));
        const int lrow0 = wr * 64 + fr, row0 = u.pm * BM + lrow0;
        float rs[2][4];
#pragma unroll
        for (int ai = 0; ai < 2; ++ai)
#pragma unroll
            for (int m = 0; m < 4; ++m) rs[ai][m] = row_rstd(stats, row0 + ai * HALF + m * 16, fq);
        if (u.pn < 4) {
            const int lane = fq * 16 + fr;
            PG8_LAS unsigned short* stg = (PG8_LAS unsigned short*)(lds + STAGE_BYTES + (wr * 4 + wc) * 2560);
            const int b = u.pm >> 3, s0 = (u.pm & 7) * BM;
            bf16_t* xt = XT + ((size_t)(b * 512 + u.pn * 128 + wc * 32) * 4096 + s0 + wr * 64 + (lane & 7) * 8);
#pragma unroll
            for (int ai = 0; ai < 2; ++ai)
#pragma unroll
                for (int bj = 0; bj < 2; ++bj)
#pragma unroll
                    for (int n = 0; n < 2; ++n) {
#pragma unroll
                        for (int m = 0; m < 4; ++m) { const f32x4 v = acc[ai][bj][m][n] * rs[ai][m];
                            const unsigned w0 = cvt_pk_bf16(v[0], v[1]), w1 = cvt_pk_bf16(v[2], v[3]);
                            PG8_LAS unsigned short* p = stg + (4 * fq) * 80 + 16 * m + fr;
                            p[0] = (unsigned short)w0; p[80] = (unsigned short)(w0 >> 16); p[160] = (unsigned short)w1; p[240] = (unsigned short)(w1 >> 16); }
#pragma unroll
                        for (int i = 0; i < 2; ++i) { const int col = i * 8 + (lane >> 3);
                            const u32x4 w = *(const PG8_LAS u32x4*)(stg + col * 80 + (lane & 7) * 8);
                            *(u32x4*)(xt + (size_t)(n * 16 + col) * 4096 + bj * 2048 + ai * HALF) = w; }
                        asm volatile("" ::: "memory"); __builtin_amdgcn_sched_barrier(0);
                    }
        } else if (u.pn < 6) { head_path<0>(acc, Qb + (size_t)((u.pn - 4) * 4 + wc) * 64, 1024u, qn, rs, row0, fq);
        } else if (wc < 2)   { head_path<1>(acc, Kb + (size_t)wc * 64, 256u, kn, rs, row0, fq);
        } else               { head_path<2>(acc, Vb + (size_t)(wc - 2) * 64, 256u, kn, rs, row0, fq); }
    }
};

template <class Epi, class Sched, bool ALIGN_EPI = false, bool SP2 = false>
__device__ __forceinline__ void gemm_phase(PG8_LAS unsigned char* lds, const Gemm g, const Sched& S, const Epi& E) {
    int tid_ = threadIdx.x; asm volatile("" : "+v"(tid_));
    const int tid = tid_, wid = __builtin_amdgcn_readfirstlane(tid >> 6), lane = tid & 63, wr = wid >> 2, wc = wid & 3, fr = lane & 15, fq = lane >> 4;
    const int K = g.K, nt = K / BK;
    unsigned voffA[2], voffB[2];
#pragma unroll
    for (int i = 0; i < 2; ++i) { int R, C; stage_rc(tid * 16 + i * 8192, R, C); const int Rb = Epi::PERM ? ((R & ~31) + perm32(R & 31)) : R;
        voffA[i] = (unsigned)(R * K + C) * 2u; voffB[i] = (unsigned)(Rb * K + C) * 2u; }
    const size_t kstep = (size_t)(BK * 2);
    const size_t hstep = (size_t)HALF * K * 2;
    const size_t tstep = 2 * hstep;
    const unsigned ldsw = (unsigned)wid * 1024u;
    const int aoff = lds_byte(wr * 64 + fr, fq * 8), boff = lds_byte(wc * 32 + fr, fq * 8);
#define PG8_SA(b, h) (((b) * 2 + (h)) * HTB)
#define PG8_SB(b, h) ((4 + (b) * 2 + (h)) * HTB)
#define PG8_STAGE(bufoff, gbase, voff) do { _Pragma("unroll") for (int _i = 0; _i < 2; ++_i) \
        __builtin_amdgcn_global_load_lds((const unsigned*)((const char*)(gbase) + (voff)[_i]), (PG8_LAS unsigned*)(lds + (bufoff) + ldsw + _i * 8192), 16, 0, 0); } while (0)
#define PG8_LDA(dst, b, h) do { _Pragma("unroll") for (int m = 0; m < 4; ++m) _Pragma("unroll") for (int k = 0; k < 2; ++k) dst[m][k] = *(const PG8_LAS bf16x8*)(lds + PG8_SA(b, h) + aoff + m * 2048 + k * 1024); } while (0)
#define PG8_LDB(dst, b, h) do { _Pragma("unroll") for (int n = 0; n < 2; ++n) _Pragma("unroll") for (int k = 0; k < 2; ++k) dst[n][k] = *(const PG8_LAS bf16x8*)(lds + PG8_SB(b, h) + boff + n * 2048 + k * 1024); } while (0)
#define PG8_MMA(ai, bj, At, Bt) do { __builtin_amdgcn_s_setprio(1); _Pragma("unroll") for (int m = 0; m < 4; ++m) _Pragma("unroll") for (int n = 0; n < 2; ++n) _Pragma("unroll") for (int k = 0; k < 2; ++k) \
        acc[ai][bj][m][n] = __builtin_amdgcn_mfma_f32_16x16x32_bf16(Bt[n][k], At[m][k], acc[ai][bj][m][n], 0, 0, 0); __builtin_amdgcn_s_setprio(0); } while (0)
#define PG8_WAIT_V(n) asm volatile("s_waitcnt vmcnt(" #n ")" ::: "memory")
#define PG8_WAIT_L(n) asm volatile("s_waitcnt lgkmcnt(" #n ")" ::: "memory")
#define PG8_BAR __builtin_amdgcn_s_barrier()
#define PG8_SCHED __builtin_amdgcn_sched_barrier(0)
    Unit cur, nxt; int ui = 0;
    if (!S.next(0, cur)) return;
    f32x4 acc[2][2][4][2];
#pragma unroll
    for (int a = 0; a < 2; ++a)
#pragma unroll
        for (int b = 0; b < 2; ++b)
#pragma unroll
            for (int m = 0; m < 4; ++m)
#pragma unroll
                for (int n = 0; n < 2; ++n) acc[a][b][m][n] = (f32x4){0.f, 0.f, 0.f, 0.f};
    bf16x8 At[4][2], B0[2][2], B1[2][2];
    const char* cA = (const char*)g.A + (size_t)cur.arow * tstep; const char* cB = (const char*)g.Bt + (size_t)cur.brow * tstep;
    S.a_ready(cur);
    if constexpr (SP2) {
        PG8_STAGE(PG8_SB(0, 0), cB, voffB); PG8_STAGE(PG8_SB(0, 1), cB + hstep, voffB); PG8_STAGE(PG8_SA(0, 0), cA, voffA); PG8_STAGE(PG8_SA(0, 1), cA + hstep, voffA);
        if (wr == 1) PG8_BAR;
        PG8_WAIT_V(2); PG8_BAR;
        PG8_STAGE(PG8_SB(1, 0), cB + kstep, voffB); PG8_STAGE(PG8_SA(1, 0), cA + kstep, voffA); PG8_STAGE(PG8_SB(1, 1), cB + hstep + kstep, voffB);
        PG8_WAIT_V(6); PG8_BAR;
    } else {
        PG8_STAGE(PG8_SB(0, 0), cB, voffB); PG8_STAGE(PG8_SA(0, 0), cA, voffA); PG8_STAGE(PG8_SB(0, 1), cB + hstep, voffB); PG8_STAGE(PG8_SA(0, 1), cA + hstep, voffA);
        if (wr == 1) PG8_BAR;
        PG8_WAIT_V(4); PG8_BAR;
        PG8_STAGE(PG8_SB(1, 0), cB + kstep, voffB); PG8_STAGE(PG8_SA(1, 0), cA + kstep, voffA); PG8_STAGE(PG8_SB(1, 1), cB + hstep + kstep, voffB);
        PG8_WAIT_V(6); PG8_BAR;
    }
    for (;;) {
        const bool has_next = S.next(ui + 1, nxt);
        const char* nA = has_next ? (const char*)g.A + (size_t)nxt.arow * tstep : cA; const char* nB = has_next ? (const char*)g.Bt + (size_t)nxt.brow * tstep : cB;
        for (int t = 0; t < nt; t += 2) {
            const bool last = (t == nt - 2);
            const char* a1 = cA + (size_t)(t + 1) * kstep;
            const char* a2 = last ? nA : cA + (size_t)(t + 2) * kstep; const char* b2 = last ? nB : cB + (size_t)(t + 2) * kstep;
            const char* a3 = a2 + kstep; const char* b3 = b2 + kstep;
            if (last && has_next) S.a_ready(nxt);
            if constexpr (SP2) {
            PG8_LDB(B0, 0, 0); PG8_LDB(B1, 0, 1); PG8_SCHED; PG8_LDA(At, 0, 0); PG8_STAGE(PG8_SA(1, 1), a1 + hstep, voffA);
            PG8_WAIT_V(8); PG8_WAIT_L(0); PG8_BAR; PG8_MMA(0, 0, At, B0); PG8_MMA(0, 1, At, B1); PG8_BAR; PG8_SCHED;
            PG8_LDA(At, 0, 1); PG8_STAGE(PG8_SB(0, 0), b2, voffB); PG8_STAGE(PG8_SB(0, 1), b2 + hstep, voffB); PG8_STAGE(PG8_SA(0, 0), a2, voffA);
            PG8_WAIT_V(8); PG8_WAIT_L(0); PG8_BAR; PG8_MMA(1, 0, At, B0); PG8_MMA(1, 1, At, B1); PG8_BAR; PG8_SCHED;
            PG8_LDB(B0, 1, 0); PG8_LDB(B1, 1, 1); PG8_SCHED; PG8_LDA(At, 1, 0); PG8_STAGE(PG8_SA(0, 1), a2 + hstep, voffA);
            PG8_WAIT_V(8); PG8_WAIT_L(0); PG8_BAR; PG8_MMA(0, 0, At, B0); PG8_MMA(0, 1, At, B1); PG8_BAR; PG8_SCHED;
            PG8_LDA(At, 1, 1); PG8_STAGE(PG8_SB(1, 0), b3, voffB); PG8_STAGE(PG8_SB(1, 1), b3 + hstep, voffB); PG8_STAGE(PG8_SA(1, 0), a3, voffA);
            PG8_WAIT_V(8); PG8_WAIT_L(0); PG8_BAR; PG8_MMA(1, 0, At, B0); PG8_MMA(1, 1, At, B1); PG8_BAR; PG8_SCHED;
            } else {
            PG8_LDB(B0, 0, 0); PG8_SCHED; PG8_LDA(At, 0, 0); PG8_STAGE(PG8_SA(1, 1), a1 + hstep, voffA);
            PG8_WAIT_L(8); PG8_BAR; PG8_WAIT_L(0); PG8_MMA(0, 0, At, B0); PG8_BAR; PG8_SCHED;
            PG8_LDB(B1, 0, 1); PG8_STAGE(PG8_SB(0, 0), b2, voffB);
            PG8_BAR; PG8_WAIT_L(0); PG8_MMA(0, 1, At, B1); PG8_BAR;
            PG8_LDA(At, 0, 1); PG8_STAGE(PG8_SA(0, 0), a2, voffA);
            PG8_BAR; PG8_WAIT_L(0); PG8_MMA(1, 0, At, B0); PG8_BAR; PG8_SCHED;
            PG8_STAGE(PG8_SB(0, 1), b2 + hstep, voffB);
            PG8_WAIT_V(6); PG8_BAR; PG8_MMA(1, 1, At, B1); PG8_BAR;
            PG8_LDB(B0, 1, 0); PG8_SCHED; PG8_LDA(At, 1, 0); PG8_STAGE(PG8_SA(0, 1), a2 + hstep, voffA);
            PG8_WAIT_L(8); PG8_BAR; PG8_WAIT_L(0); PG8_MMA(0, 0, At, B0); PG8_BAR; PG8_SCHED;
            PG8_LDB(B1, 1, 1); PG8_STAGE(PG8_SB(1, 0), b3, voffB);
            PG8_BAR; PG8_WAIT_L(0); PG8_MMA(0, 1, At, B1); PG8_BAR;
            PG8_LDA(At, 1, 1); PG8_STAGE(PG8_SA(1, 0), a3, voffA);
            PG8_BAR; PG8_WAIT_L(0); PG8_MMA(1, 0, At, B0); PG8_BAR; PG8_SCHED;
            PG8_STAGE(PG8_SB(1, 1), b3 + hstep, voffB);
            PG8_WAIT_V(6); PG8_BAR; PG8_MMA(1, 1, At, B1); PG8_BAR;
            }
        }
        if constexpr (ALIGN_EPI) { if (wr == 0) PG8_BAR; }
        if constexpr (!Epi::AFTER_DRAIN) { E(acc, cur, wr, wc, fr, fq, lds); S.done(cur); }
        if (!has_next) break;
#pragma unroll
        for (int a = 0; a < 2; ++a)
#pragma unroll
            for (int b = 0; b < 2; ++b)
#pragma unroll
                for (int m = 0; m < 4; ++m)
#pragma unroll
                    for (int n = 0; n < 2; ++n) acc[a][b][m][n] = (f32x4){0.f, 0.f, 0.f, 0.f};
        cur = nxt; cA = nA; cB = nB; ++ui;
        if constexpr (ALIGN_EPI) { if (wr == 1) PG8_BAR; }
    }
    PG8_WAIT_V(0);
    if constexpr (!ALIGN_EPI) { if (wr == 0) PG8_BAR; }
    PG8_BAR;
    if constexpr (Epi::AFTER_DRAIN) { E.fused(acc, cur, wr, wc, fr, fq, lds, wid, lane); S.done(cur); }
#undef PG8_SA
#undef PG8_SB
#undef PG8_STAGE
#undef PG8_LDA
#undef PG8_LDB
#undef PG8_MMA
#undef PG8_WAIT_V
#undef PG8_WAIT_L
#undef PG8_BAR
#undef PG8_SCHED
}
}
namespace attn_body {
using bf16=__hip_bfloat16;
using bf16x8=__attribute__((ext_vector_type(8)))short;
using s16x4=__attribute__((ext_vector_type(4)))short;
using f32x16=__attribute__((ext_vector_type(16)))float;
using u32x4=__attribute__((ext_vector_type(4)))unsigned;
constexpr int BATCH=16,NHEAD=8,SEQ=2048,D=64; constexpr int QP=512,KP=128,VP=128,OP=1024,OCOL=512;
constexpr int NW=8,QBLK=32,QB=QBLK*NW,KVBLK=64,NQB=SEQ/QB;
constexpr int ATTN_UNIT_ROWS=QB;
__device__ __forceinline__ int crow(int r,int hi){return (r&3)+8*(r>>2)+4*hi;}
#define SBAR() __builtin_amdgcn_sched_barrier(0)
__device__ __forceinline__ void cmask(f32x16&p0,f32x16&p1,int jb,int qrel,int hi){
  const float NEG=-INFINITY; int kb=64*jb+4*hi;
  #pragma unroll
  for(int r=0;r<16;++r){int kv=kb+(r&3)+8*(r>>2); if(kv>qrel)p0[r]=NEG; if(kv+32>qrel)p1[r]=NEG;}
}

constexpr int NSLOT=3, SLOTB=8192;
constexpr int LDS_K=0, LDS_V=NSLOT*SLOTB, LDS_WS=2*NSLOT*SLOTB, LDS_OST=LDS_WS+NW*64*4, LDS_BYTES=LDS_OST+NW*4096;
constexpr float C2=0.125f*1.4426950408889634f;
__device__ __forceinline__ void glds16(const void*gsrc,unsigned lds_dst){unsigned keep;
  asm volatile("s_mov_b32 %0, m0\n\ts_mov_b32 m0, %2\n\ts_nop 0\n\tglobal_load_lds_dwordx4 %1, off\n\ts_mov_b32 m0, %0":"=&s"(keep):"v"(gsrc),"s"(lds_dst):"memory");}
__device__ __forceinline__ float max3f(float a,float b,float c){float r;asm("v_max3_f32 %0, %1, %2, %3":"=v"(r):"v"(a),"v"(b),"v"(c));return r;}
__device__ __forceinline__ float max2f(float a,float b){float r;asm("v_max_f32_e32 %0, %1, %2":"=v"(r):"v"(a),"v"(b));return r;}
__device__ __forceinline__ float fadd_s(float a,float b){float r;asm("v_add_f32_e32 %0, %1, %2":"=v"(r):"v"(a),"v"(b));return r;}
__device__ __forceinline__ float fsub_s(float a,float b){float r;asm("v_sub_f32_e32 %0, %1, %2":"=v"(r):"v"(a),"v"(b));return r;}
typedef float f32x2_t __attribute__((ext_vector_type(2))); typedef __bf16 bf16x2_t __attribute__((ext_vector_type(2)));
__device__ __forceinline__ unsigned cvtpk_s(float lo,float hi){f32x2_t v={lo,hi};bf16x2_t b=__builtin_convertvector(v,bf16x2_t);return __builtin_bit_cast(unsigned,b);}
#define WAIT_BAR(N) asm volatile("s_waitcnt vmcnt(" #N ") lgkmcnt(0)\n\ts_barrier":::"memory")

__device__ __forceinline__ void qkt(f32x16&p0,f32x16&p1,const char*Kslot,const bf16x8*qr,const f32x16&negm,int r32,int hi){
  const char*kb=Kslot+hi*1024+r32*16;
  #pragma unroll
  for(int d0=0;d0<4;++d0){
    const bf16x8 b0=*reinterpret_cast<const bf16x8*>(kb+d0*2048);
    const bf16x8 b1=*reinterpret_cast<const bf16x8*>(kb+d0*2048+512);
    if(d0==0){p0=__builtin_amdgcn_mfma_f32_32x32x16_bf16(b0,qr[0],negm,0,0,0);p1=__builtin_amdgcn_mfma_f32_32x32x16_bf16(b1,qr[0],negm,0,0,0);}
    else{p0=__builtin_amdgcn_mfma_f32_32x32x16_bf16(b0,qr[d0],p0,0,0,0);p1=__builtin_amdgcn_mfma_f32_32x32x16_bf16(b1,qr[d0],p1,0,0,0);}}
}
typedef __attribute__((address_space(3))) const char* lds_cptr;
typedef short v4i16_t __attribute__((ext_vector_type(4)));
__device__ __forceinline__ void kload8(bf16x8*kf,lds_cptr kp){
  kf[0]=*(const __attribute__((address_space(3))) bf16x8*)(kp);      kf[1]=*(const __attribute__((address_space(3))) bf16x8*)(kp+512);
  kf[2]=*(const __attribute__((address_space(3))) bf16x8*)(kp+2048); kf[3]=*(const __attribute__((address_space(3))) bf16x8*)(kp+2560);
  kf[4]=*(const __attribute__((address_space(3))) bf16x8*)(kp+4096); kf[5]=*(const __attribute__((address_space(3))) bf16x8*)(kp+4608);
  kf[6]=*(const __attribute__((address_space(3))) bf16x8*)(kp+6144); kf[7]=*(const __attribute__((address_space(3))) bf16x8*)(kp+6656);
}
__device__ __forceinline__ void kload2(bf16x8*kf,lds_cptr kp,int j){ kf[2*j]=*(const __attribute__((address_space(3))) bf16x8*)(kp+j*2048); kf[2*j+1]=*(const __attribute__((address_space(3))) bf16x8*)(kp+j*2048+512); }
__device__ __forceinline__ s16x4 vtr(lds_cptr p){ return __builtin_bit_cast(s16x4,__builtin_amdgcn_ds_read_tr16_b64_v4i16((__attribute__((address_space(3))) v4i16_t*)p)); }
__device__ __forceinline__ float rowmax(const f32x16&p0,const f32x16&p1){
  float a=max3f(p0[0],p0[1],p1[0]),b=max3f(p0[2],p0[3],p1[1]);a=max3f(a,p1[2],p1[3]);
  #pragma unroll
  for(int r=4;r<16;r+=4){a=max3f(a,p0[r],p0[r+1]);b=max3f(b,p0[r+2],p0[r+3]);a=max3f(a,p1[r],p1[r+1]);b=max3f(b,p1[r+2],p1[r+3]);}
  const float m=max2f(a,b);
  auto rr=__builtin_amdgcn_permlane32_swap(__float_as_uint(m),__float_as_uint(m),false,false);
  return max2f(__uint_as_float(rr[0]),__uint_as_float(rr[1]));
}
__device__ __forceinline__ void pv(f32x16*o,int vb,bf16x8 pa0,bf16x8 pa1,bf16x8 pa2,bf16x8 pa3){
  #pragma unroll
  for(int d0=0;d0<2;++d0){s16x4 lo[4],hi[4];
    #pragma unroll
    for(int ks=0;ks<4;++ks){
      asm volatile("ds_read_b64_tr_b16 %0,%1 offset:%c2":"=&v"(lo[ks]):"v"(vb),"i"(d0*4096+ks*1024):"memory");
      asm volatile("ds_read_b64_tr_b16 %0,%1 offset:%c2":"=&v"(hi[ks]):"v"(vb),"i"(d0*4096+ks*1024+512):"memory");}
    asm volatile("s_waitcnt lgkmcnt(0)":::"memory");SBAR();
    #define PK(k) (bf16x8){lo[k][0],lo[k][1],lo[k][2],lo[k][3],hi[k][0],hi[k][1],hi[k][2],hi[k][3]}
    o[d0]=__builtin_amdgcn_mfma_f32_32x32x16_bf16(pa0,PK(0),o[d0],0,0,0);
    o[d0]=__builtin_amdgcn_mfma_f32_32x32x16_bf16(pa1,PK(1),o[d0],0,0,0);
    o[d0]=__builtin_amdgcn_mfma_f32_32x32x16_bf16(pa2,PK(2),o[d0],0,0,0);
    o[d0]=__builtin_amdgcn_mfma_f32_32x32x16_bf16(pa3,PK(3),o[d0],0,0,0);
    #undef PK
  }
}

#ifndef ATTN_STORE16
#define ATTN_STORE16(p,v) (*(u32x4*)(p)=(v))
#endif
template<int THRL> __device__ __forceinline__ void attn_unit(int b,int h,int qb,const bf16*Q,const bf16*__restrict__ K,const bf16*__restrict__ V,bf16*O,char*shm){
  int tid_=threadIdx.x; asm volatile("":"+v"(tid_)); const int tid=tid_,lane=tid&63,r32=lane&31,hi=lane>>5; const int wid=__builtin_amdgcn_readfirstlane(tid>>6);
  const long rowbase=(long)b*SEQ; const int q0=qb*QB;
  const bf16*Qw=Q+(rowbase+q0+wid*QBLK)*QP+h*D;
  const int kvh=h>>2; const bf16*Kh=K+rowbase*KP+kvh*D,*Vh=V+rowbase*VP+kvh*D;
  const unsigned lds0=(unsigned)(uintptr_t)shm;
  float*wsf=(float*)(shm+LDS_WS)+wid*64;
  const bf16*ksrc=Kh+(long)lane*KP+wid*8;
  const bf16*vsrc=Vh+(long)(16*(wid&3)+(lane>>2))*VP+(wid>>2)*32+(lane&3)*8;
  const unsigned kdst=lds0+LDS_K+wid*1024, vdst=lds0+LDS_V+wid*1024;
  #define DMA_K(t,slot) glds16(ksrc+(long)(t)*KVBLK*KP,(unsigned)__builtin_amdgcn_readfirstlane(kdst+(slot)))
  #define DMA_V(t,slot) glds16(vsrc+(long)(t)*KVBLK*VP,(unsigned)__builtin_amdgcn_readfirstlane(vdst+(slot)))
  const int vb0=(int)(lds0+LDS_V)+((lane>>4)&1)*32+(lane&3)*8+(4*hi+((lane&15)>>2))*64;
  const char*Kbase=shm+LDS_K; bf16x8 kf[8];
  const lds_cptr shm3=(lds_cptr)shm; const lds_cptr kp0=shm3+LDS_K+hi*1024+r32*16; const lds_cptr vp0=shm3+LDS_V+((lane>>4)&1)*32+(lane&3)*8+(4*hi+((lane&15)>>2))*64;
  const int NT=SEQ/KVBLK;
  DMA_K(0,0);DMA_V(0,0);DMA_K(1,SLOTB);
  bf16x8 qr[4];
  #pragma unroll
  for(int d0=0;d0<4;++d0)qr[d0]=*reinterpret_cast<const bf16x8*>(&Qw[(long)r32*QP+d0*16+hi*8]);
  float mhat=0.f,l_reg=0.f;f32x16 o[2];o[0]=f32x16{};o[1]=f32x16{};f32x16 negm=f32x16{};asm volatile("":"+v"(negm));
  const int qrel=wid*QBLK+r32;
  #define CMASK(P0,P1,t) do{}while(0)
  bool resc=false;
  #define START(P0,P1) do{ const float rm=rowmax(P0,P1); resc=false; \
    { const float dl=rm; mhat=fadd_s(mhat,dl); \
      _Pragma("unroll") for(int r=0;r<16;++r){P0[r]=fsub_s(P0[r],dl);P1[r]=fsub_s(P1[r],dl);} \
      _Pragma("unroll") for(int r=0;r<16;++r)negm[r]=-mhat; asm volatile("":"+v"(negm)); } \
    _Pragma("unroll") for(int r=0;r<16;++r)P0[r]=__builtin_amdgcn_exp2f(P0[r]); }while(0)
  #define RESC() do{ if(resc){ asm volatile("s_waitcnt lgkmcnt(0)":::"memory"); \
      _Pragma("unroll") for(int d_=0;d_<2;++d_) _Pragma("unroll") for(int r=0;r<16;++r)o[d_][r]*=wsf[crow(r,hi)]; } }while(0)
  f32x16 pA0,pA1,pB0,pB1;
  int sl_prev=0,sl_cur=0,sl_next=SLOTB;
  #define ROT() do{sl_prev=sl_cur;sl_cur=sl_next;sl_next=(sl_next==(NSLOT-1)*SLOTB)?0:sl_next+SLOTB;}while(0)
  DMA_K(2,2*SLOTB);
  WAIT_BAR(3);
  qkt(pA0,pA1,Kbase,qr,negm,r32,hi);asm volatile("s_nop 15\n\ts_nop 7":"+v"(pA0),"+v"(pA1));CMASK(pA0,pA1,0);
  START(pA0,pA1);
  _Pragma("unroll") for(int r=0;r<16;++r)pA1[r]=__builtin_amdgcn_exp2f(pA1[r]);
  WAIT_BAR(0);
  DMA_K(3,0);DMA_V(1,SLOTB);
  ROT();
  kload8(kf,kp0+sl_cur);
  WAIT_BAR(2);
  s16x4 vlo[8],vhi[8]; u32x4 pw0,pw1,pw2,pw3;
  #define PKW(P,B) cvtpk_s(P[B],P[B+1])
  #define PAF(k) __builtin_bit_cast(bf16x8,pw##k)
  #define VFR(i) (bf16x8){vlo[i][0],vlo[i][1],vlo[i][2],vlo[i][3],vhi[i][0],vhi[i][1],vhi[i][2],vhi[i][3]}
  #define PIN(x) asm volatile("":"+v"(x))
  #define MX3(a,b,c) __builtin_fmaxf(__builtin_fmaxf((a),(b)),(c))
  #define GAPA(MF,A0,A1,A2,A3,W0,W1,PW) do{ MF; sacc+=A0; sacc+=A1; sacc+=A2; sacc+=A3; PIN(sacc); W0; W1; PIN(PW); SBAR(); }while(0)
  #define EX(v) __builtin_amdgcn_exp2f(v)
  #define GAPB(MF,X,B) do{ MF; X[B]=EX(X[B]); X[B+1]=EX(X[B+1]); X[B+2]=EX(X[B+2]); X[B+3]=EX(X[B+3]); PIN(X); SBAR(); }while(0)
  #define VRD(i) do{ vlo[i]=vtr(vp_+(((i)>>2)*4096+((i)&3)*1024)); vhi[i]=vtr(vp_+(((i)>>2)*4096+((i)&3)*1024+512)); }while(0)
  #define KRD(G,j) do{ if(G){ kload2(kf,kp0+sl_next,j); SBAR(); } }while(0)
  #define STEP(C0,C1,P0,P1,t,GK,GV,GL) do{ SBAR(); \
    const lds_cptr vp_=vp0+sl_prev; \
    VRD(0); SBAR(); float sacc=(P0[0]+P0[1]); \
    GAPA(C0=__builtin_amdgcn_mfma_f32_32x32x16_bf16(kf[0],qr[0],negm,0,0,0), P0[2],P0[3],P0[4],P0[5],     pw0[0]=PKW(P0,0), pw0[1]=PKW(P0,2), pw0); \
    VRD(4); SBAR(); GAPA(C1=__builtin_amdgcn_mfma_f32_32x32x16_bf16(kf[1],qr[0],negm,0,0,0), P0[6],P0[7],P0[8],P0[9],     pw0[2]=PKW(P0,4), pw0[3]=PKW(P0,6), pw0); \
    VRD(1); SBAR(); GAPA(C0=__builtin_amdgcn_mfma_f32_32x32x16_bf16(kf[2],qr[1],C0,0,0,0),   P0[10],P0[11],P0[12],P0[13], pw1[0]=PKW(P0,8), pw1[1]=PKW(P0,10), pw1); \
    VRD(5); SBAR(); GAPA(C1=__builtin_amdgcn_mfma_f32_32x32x16_bf16(kf[3],qr[1],C1,0,0,0),   P0[14],P0[15],P1[0],P1[1],   pw1[2]=PKW(P0,12),pw1[3]=PKW(P0,14), pw1); \
    VRD(2); SBAR(); GAPA(C0=__builtin_amdgcn_mfma_f32_32x32x16_bf16(kf[4],qr[2],C0,0,0,0),   P1[2],P1[3],P1[4],P1[5],     pw2[0]=PKW(P1,0), pw2[1]=PKW(P1,2), pw2); \
    VRD(6); SBAR(); GAPA(C1=__builtin_amdgcn_mfma_f32_32x32x16_bf16(kf[5],qr[2],C1,0,0,0),   P1[6],P1[7],P1[8],P1[9],     pw2[2]=PKW(P1,4), pw2[3]=PKW(P1,6), pw2); \
    VRD(3); SBAR(); GAPA(C0=__builtin_amdgcn_mfma_f32_32x32x16_bf16(kf[6],qr[3],C0,0,0,0),   P1[10],P1[11],P1[12],P1[13], pw3[0]=PKW(P1,8), pw3[1]=PKW(P1,10), pw3); \
    VRD(7); SBAR(); GAPA(C1=__builtin_amdgcn_mfma_f32_32x32x16_bf16(kf[7],qr[3],C1,0,0,0),   P1[14],P1[15],0.f,0.f,       pw3[2]=PKW(P1,12),pw3[3]=PKW(P1,14), pw3); \
    l_reg+=sacc; \
    if(GK){DMA_K((t)+3,sl_cur);} if(GV){DMA_V((t)+1,sl_next);} \
    CMASK(C0,C1,t); \
    { float a=MX3(C0[0],C0[1],C1[0]),b=MX3(C0[2],C0[3],C1[1]); a=MX3(a,C1[2],C1[3]); \
      _Pragma("unroll") for(int r=4;r<16;r+=4){a=MX3(a,C0[r],C0[r+1]);b=MX3(b,C0[r+2],C0[r+3]);a=MX3(a,C1[r],C1[r+1]);b=MX3(b,C1[r+2],C1[r+3]);} \
      float rm=__builtin_fmaxf(a,b); { auto rr=__builtin_amdgcn_permlane32_swap(__float_as_uint(rm),__float_as_uint(rm),false,false); rm=__builtin_fmaxf(__uint_as_float(rr[0]),__uint_as_float(rr[1])); } \
      resc=false; \
      if(__builtin_expect(__any(rm>(float)THRL),0)){ const float dl=__builtin_fmaxf(rm,0.f); mhat+=dl; \
        _Pragma("unroll") for(int r=0;r<16;++r){C0[r]-=dl;C1[r]-=dl;} \
        _Pragma("unroll") for(int r=0;r<16;++r)negm[r]=-mhat; asm volatile("":"+v"(negm)); \
        const float f=__builtin_amdgcn_exp2f(-dl); l_reg*=f; if(hi==0)wsf[r32]=f; resc=true; } } \
    SBAR(); \
    GAPB(o[0]=__builtin_amdgcn_mfma_f32_32x32x16_bf16(PAF(0),VFR(0),o[0],0,0,0), C0,0); \
    GAPB(o[1]=__builtin_amdgcn_mfma_f32_32x32x16_bf16(PAF(0),VFR(4),o[1],0,0,0), C0,4); \
    KRD(GL,0); GAPB(o[0]=__builtin_amdgcn_mfma_f32_32x32x16_bf16(PAF(1),VFR(1),o[0],0,0,0), C0,8); \
    KRD(GL,1); GAPB(o[1]=__builtin_amdgcn_mfma_f32_32x32x16_bf16(PAF(1),VFR(5),o[1],0,0,0), C0,12); \
    KRD(GL,2); GAPB(o[0]=__builtin_amdgcn_mfma_f32_32x32x16_bf16(PAF(2),VFR(2),o[0],0,0,0), C1,0); \
    KRD(GL,3); GAPB(o[1]=__builtin_amdgcn_mfma_f32_32x32x16_bf16(PAF(2),VFR(6),o[1],0,0,0), C1,4); \
    GAPB(o[0]=__builtin_amdgcn_mfma_f32_32x32x16_bf16(PAF(3),VFR(3),o[0],0,0,0), C1,8); \
    GAPB(o[1]=__builtin_amdgcn_mfma_f32_32x32x16_bf16(PAF(3),VFR(7),o[1],0,0,0), C1,12); \
    }while(0)
  int t=1;
  #undef CMASK
  #define CMASK(P0,P1,t) do{}while(0)
  for(;t+5<NT;t+=2){
    STEP(pB0,pB1,pA0,pA1,t,true,true,true);     WAIT_BAR(2); RESC(); ROT();
    STEP(pA0,pA1,pB0,pB1,t+1,true,true,true);   WAIT_BAR(2); RESC(); ROT();
  }
  #undef CMASK
  #define CMASK(P0,P1,t) do{}while(0)
  #define ENDW(tt) do{ if((tt)+3<NT){WAIT_BAR(2);} else if((tt)+2<NT){WAIT_BAR(1);} else {WAIT_BAR(0);} }while(0)
  for(;t+1<NT;t+=2){
    STEP(pB0,pB1,pA0,pA1,t,(t+3<NT),(t+1<NT),(t+1<NT));       ENDW(t);   RESC(); ROT();
    STEP(pA0,pA1,pB0,pB1,t+1,(t+4<NT),(t+2<NT),(t+2<NT));     ENDW(t+1); RESC(); ROT();
  }
  STEP(pB0,pB1,pA0,pA1,NT-1,false,false,false); RESC();
  { float sacc=pB0[0]+pB0[1]; _Pragma("unroll") for(int r=2;r<16;++r)sacc+=pB0[r]; _Pragma("unroll") for(int r=0;r<16;++r)sacc+=pB1[r]; l_reg+=sacc;
    pw0=(u32x4){PKW(pB0,0),PKW(pB0,2),PKW(pB0,4),PKW(pB0,6)};pw1=(u32x4){PKW(pB0,8),PKW(pB0,10),PKW(pB0,12),PKW(pB0,14)};pw2=(u32x4){PKW(pB1,0),PKW(pB1,2),PKW(pB1,4),PKW(pB1,6)};pw3=(u32x4){PKW(pB1,8),PKW(pB1,10),PKW(pB1,12),PKW(pB1,14)};
    SBAR(); pv(o,vb0+sl_cur,PAF(0),PAF(1),PAF(2),PAF(3)); }
  #undef PKW
  #undef PAF
  #undef VFR
  #undef PIN
  #undef MX3
  #undef GAPA
  #undef GAPB
  #undef EX
  #undef VRD
  #undef KRD
  #undef STEP
  #undef ENDW
  {auto rr=__builtin_amdgcn_permlane32_swap(__float_as_uint(l_reg),__float_as_uint(l_reg),false,false);l_reg=__uint_as_float(rr[0])+__uint_as_float(rr[1]);}
  if(hi==0)wsf[32+r32]=l_reg;asm volatile("s_waitcnt lgkmcnt(0)":::"memory");
  float rli[16];
  #pragma unroll
  for(int r=0;r<16;++r)rli[r]=__builtin_amdgcn_rcpf(wsf[32+crow(r,hi)]);
  bf16*Ow=O+(rowbase+q0+wid*QBLK)*OP+OCOL+h*D;
  { bf16*stg=(bf16*)(shm+LDS_OST)+wid*2048;
    #pragma unroll
    for(int r=0;r<16;++r){const int orow=crow(r,hi);
      #pragma unroll
      for(int d0=0;d0<2;++d0)stg[orow*64+d0*32+r32]=__float2bfloat16(o[d0][r]*rli[r]);}
    asm volatile("s_waitcnt lgkmcnt(0)":::"memory");
    #pragma unroll
    for(int i=0;i<4;++i){const int row=i*8+(lane>>3),ch=lane&7; const u32x4 v=*(const u32x4*)(stg+row*64+ch*8); ATTN_STORE16(Ow+(long)row*OP+ch*8,v);} }
  asm volatile("s_waitcnt lgkmcnt(0)\n\ts_barrier":::"memory");
  #undef DMA_K
  #undef DMA_V
  #undef CMASK
  #undef START
  #undef RESC
  #undef ROT
}
constexpr int ATTN_LDS_BYTES=LDS_BYTES;
struct AttnTensors { const bf16* Q; const bf16* K; const bf16* V; bf16* O; };
struct AttnUnit { int b, h, qb; };
struct AttnOrder {
  int vcu, G;
  __device__ __forceinline__ AttnOrder(int grid,int v):vcu(v),G(grid){}
  __device__ __forceinline__ bool next(int i,AttnUnit&u)const{ const int L=i*G+vcu; if(L>=1024)return false; const int hq=L>>8, rem=L&255, grp=rem>>3; u.qb=rem&7; u.b=grp>>1; u.h=(grp&1)*4+hq; return true; }
  __device__ __forceinline__ void a_ready(const AttnUnit&)const{}
  __device__ __forceinline__ void done(const AttnUnit&)const{}
};
template<class Sched,int THRL=8> __device__ __forceinline__ void attn_phase(char*lds,const AttnTensors&T,const Sched&S){
  AttnUnit u;
  for(int i=0;S.next(i,u);++i){ S.a_ready(u); attn_unit<THRL>(u.b,u.h,u.qb,T.Q,T.K,T.V,T.O,lds); S.done(u); }
}
#undef SBAR
#undef WAIT_BAR
}
#define GAS __attribute__((address_space(1)))
#define LAS __attribute__((address_space(3)))
typedef unsigned short bf16;
typedef unsigned v4u __attribute__((ext_vector_type(4)));
typedef float f32x4 __attribute__((ext_vector_type(4)));
typedef short bf16x8 __attribute__((ext_vector_type(8)));
typedef GAS unsigned gu32;
typedef GAS unsigned long long gu64;
#define RLX_AGENT __ATOMIC_RELAXED, __HIP_MEMORY_SCOPE_AGENT
#define LDS_WAIT() asm volatile("s_waitcnt lgkmcnt(0)" ::: "memory")
#define VM_WAIT() asm volatile("s_waitcnt vmcnt(0)" ::: "memory")
__device__ __forceinline__ unsigned long long rt() { return __builtin_amdgcn_s_memrealtime(); }
__device__ __forceinline__ unsigned f2bf(float f) { unsigned u = __builtin_bit_cast(unsigned, f); return (u + 0x7fffu + ((u >> 16) & 1u)) >> 16; }
__device__ __forceinline__ unsigned pk2(float lo, float hi) { return f2bf(lo) | (f2bf(hi) << 16); }

#define XB_TMO      128
#define XB_XCNT(j)  (256  + 64 * (j))
#define XB_XSUB(j)  (1280 + 64 * (j))
#define XB_XGEN(j)  (2304 + 64 * (j))
#define XB_TOP      3328
#define XB_TOPGEN   3392
#define XCD_BAR_WORDS 3456
#define XB_SPIN_CAP (1u << 18)

__device__ __forceinline__ unsigned xb_ld(unsigned* p)              { return __hip_atomic_load(p, __ATOMIC_RELAXED, __HIP_MEMORY_SCOPE_AGENT); }
__device__ __forceinline__ unsigned xb_add(unsigned* p, unsigned v) { return __hip_atomic_fetch_add(p, v, __ATOMIC_RELAXED, __HIP_MEMORY_SCOPE_AGENT); }
__device__ __forceinline__ unsigned xb_xcc_id() { return (unsigned)__builtin_amdgcn_s_getreg((3 << 11) | 20) & 0xFu; }
#define XB_SPIN(cond, bar) do { unsigned _sp = 0; while (cond) { __builtin_amdgcn_s_sleep(1); \
    if ((++_sp & 255u) == 0u) { if (xb_ld(&(bar)[XB_TMO])) break; if (_sp > XB_SPIN_CAP) { atomicAdd(&(bar)[XB_TMO], 1u); break; } } } } while (0)

struct XcdBarrier {
    unsigned* bar; unsigned x;
    volatile LAS unsigned* st;
};

__device__ __forceinline__ XcdBarrier xcd_barrier_post(unsigned* bar, volatile LAS unsigned* st) {
    XcdBarrier b; b.bar = bar; b.x = xb_xcc_id(); b.st = st;
    if (threadIdx.x == 0) (void)xb_add(&bar[XB_XCNT(b.x)], 1u);
    return b;
}
__device__ __forceinline__ void xcd_barrier_complete(unsigned* bar, unsigned x, unsigned& nloc, unsigned& nx) {
    const unsigned G = gridDim.x * gridDim.y * gridDim.z;
    unsigned sum, cnt, mine, sp = 0u;
    for (;;) {
        sum = 0u; cnt = 0u; mine = 0u;
#pragma unroll
        for (unsigned j = 0; j < 16; ++j) { const unsigned c = xb_ld(&bar[XB_XCNT(j)]); sum += c; cnt += (c > 0u) ? 1u : 0u; mine = (j == x) ? c : mine; }
        if (sum == G) break;
        __builtin_amdgcn_s_sleep(1);
        if ((++sp & 255u) == 0u) { if (xb_ld(&bar[XB_TMO])) break; if (sp > XB_SPIN_CAP) { atomicAdd(&bar[XB_TMO], 1u); break; } }
    }
    nloc = mine > 0u ? mine : 1u; nx = cnt > 0u ? cnt : 1u;
}

__device__ __forceinline__ void xcd_barrier(const XcdBarrier& b) {
    asm volatile("s_waitcnt vmcnt(0)" ::: "memory");
    __syncthreads();
    if (threadIdx.x == 0) {
        unsigned* bar = b.bar;
        __builtin_amdgcn_s_waitcnt(0);
        unsigned nloc = b.st[0], nx = b.st[1];
        if (nloc == 0u) { xcd_barrier_complete(bar, b.x, nloc, nx); b.st[0] = nloc; b.st[1] = nx; }
        const unsigned old = xb_add(&bar[XB_XSUB(b.x)], 1u);
        const unsigned gen = old / nloc;
        if (old + 1u == (gen + 1u) * nloc) {
            __builtin_amdgcn_fence(__ATOMIC_RELEASE, "agent");
            asm volatile("s_waitcnt vmcnt(0)" ::: "memory");
            const unsigned og = xb_add(&bar[XB_TOP], 1u);
            const unsigned tg = og / nx;
            if (og + 1u == (tg + 1u) * nx) xb_add(&bar[XB_TOPGEN], 1u);
            else XB_SPIN(xb_ld(&bar[XB_TOPGEN]) == tg, bar);
            __builtin_amdgcn_fence(__ATOMIC_ACQUIRE, "agent");
            xb_add(&bar[XB_XGEN(b.x)], 1u);
            asm volatile("s_waitcnt vmcnt(0)" ::: "memory");
        } else {
            XB_SPIN(xb_ld(&bar[XB_XGEN(b.x)]) == gen, bar);
            __builtin_amdgcn_fence(__ATOMIC_ACQUIRE, "agent");
            asm volatile("s_waitcnt vmcnt(0)" ::: "memory");
        }
    }
    __syncthreads();
}

constexpr int NWAVES = 8;
#ifndef MK_N_LAUNCHES
#define MK_N_LAUNCHES 1
#endif
#ifndef PHASE_MASK
#define PHASE_MASK 0x1ff
#endif
#define PH_ON(k) ((PHASE_MASK >> (k)) & 1)
constexpr int N_PHASES = 9;
constexpr int N_LAUNCHES = MK_N_LAUNCHES;
static_assert(N_LAUNCHES == 1 || N_LAUNCHES == N_PHASES, "MK_N_LAUNCHES is 1 or 9");

constexpr int BATCH = 16, SEQ = 2048, DM = 1024, M = BATCH * SEQ, DFF = 2752, DFFP = 2816, NGU = 2 * DFFP, NIN = 1792, INW = 1280;
constexpr size_t MiB = 1u << 20;
constexpr size_t WS_CTL = 0, CTL_ZERO_BYTES = 1 * MiB;
constexpr size_t WS_W1 = 2 * MiB, WS_WD1 = 13 * MiB, WS_W2 = 19 * MiB, WS_WD2 = 30 * MiB, WS_WIN = 36 * MiB, WS_WOUT = 40 * MiB, WS_DFT = 42 * MiB;
constexpr size_t WS_MISC = 58 * MiB;
constexpr size_t WS_STATS = 59 * MiB;
constexpr size_t WS_XB = 67 * MiB;
constexpr size_t WS_ACT = 131 * MiB;
constexpr size_t WS_XT = 131 * MiB, WS_Q = 195 * MiB, WS_K = 227 * MiB, WS_V = 235 * MiB, WS_MIX = 243 * MiB;
constexpr size_t WS_X1 = 307 * MiB;
constexpr size_t WS_END = 435 * MiB;
static_assert(WS_W1 + (size_t)NGU * DM * 2 <= WS_WD1 && WS_WD1 + (size_t)DM * DFFP * 2 <= WS_W2 && WS_W2 + (size_t)NGU * DM * 2 <= WS_WD2 && WS_WD2 + (size_t)DM * DFFP * 2 <= WS_WIN, "ws map 1");
static_assert(WS_WIN + (size_t)NIN * DM * 2 <= WS_WOUT && WS_WOUT + (size_t)DM * DM * 2 <= WS_DFT && WS_DFT + (size_t)2048 * 4096 * 2 <= WS_MISC && WS_STATS + 4 * (size_t)M * 16 * 4 <= WS_XB, "ws map 2");
static_assert(WS_XB + (size_t)M * DM * 2 <= WS_ACT && WS_ACT + (size_t)M * DFFP * 2 <= WS_X1 && WS_XT + (size_t)BATCH * 512 * 4096 * 2 <= WS_Q && WS_Q + (size_t)M * 512 * 2 <= WS_K, "ws map 3");
static_assert(WS_K + (size_t)M * 128 * 2 <= WS_V && WS_V + (size_t)M * 128 * 2 <= WS_MIX && WS_MIX + (size_t)M * DM * 2 <= WS_X1 && WS_X1 + (size_t)M * DM * 4 <= WS_END, "ws map 4");
constexpr int CW_BAR = 4096;
constexpr int RING_BYTES = 131072;
constexpr int EPI_STAGE_BYTES = 8 * 2560;
constexpr int LDSCTL_OFF = RING_BYTES + EPI_STAGE_BYTES, MISC_OFF = LDSCTL_OFF + 320;
constexpr int LDS_BYTES = 155648;
static_assert(MISC_OFF + 128 <= LDS_BYTES && pg8::STAGE_BYTES == RING_BYTES && attn_body::ATTN_LDS_BYTES <= RING_BYTES, "LDS map");

__device__ __forceinline__ float wave_sum(float v) {
#pragma unroll
    for (int o = 1; o < 64; o <<= 1) v += __shfl_xor(v, o);
    return v;
}
__device__ __forceinline__ void p0_transpose_item(const float* __restrict__ W, int N, int k0, int n0, bf16* __restrict__ dst, int ldk, const float* __restrict__ gain, LAS float* scr, int lane) {
#pragma unroll 8
    for (int i = 0; i < 32; ++i) { const int kk = 2 * i + (lane >> 5); float v = W[(size_t)(k0 + kk) * N + n0 + (lane & 31)]; if (gain) v *= gain[k0 + kk]; scr[kk * 33 + (lane & 31)] = v; }
    LDS_WAIT(); asm volatile("" ::: "memory");
    const int c = lane & 7;
#pragma unroll
    for (int j = 0; j < 4; ++j) { const int n = (lane >> 3) + 8 * j; const LAS float* s = scr + (8 * c) * 33 + n;
        v4u o; o.x = pk2(s[0 * 33], s[1 * 33]); o.y = pk2(s[2 * 33], s[3 * 33]); o.z = pk2(s[4 * 33], s[5 * 33]); o.w = pk2(s[6 * 33], s[7 * 33]);
        *(v4u*)(dst + (size_t)n * ldk + k0 + 8 * c) = o; }
    LDS_WAIT(); asm volatile("" ::: "memory");
}

struct Args { const float* in[17]; float* out; unsigned char* ws; int ph_lo, ph_hi, li, pad; };

__global__ void __launch_bounds__(NWAVES * 64, 2) mk_fwd(Args args) {
    extern __shared__ __attribute__((aligned(16))) unsigned char lds[];
    LAS unsigned char* const ldsp = (LAS unsigned char*)lds;
    volatile LAS unsigned* const MISC = (volatile LAS unsigned*)(ldsp + MISC_OFF);
    const int tid0 = threadIdx.x;
    gu32* const ctl = (gu32*)(args.ws + WS_CTL);
    for (int u = tid0; u < (LDS_BYTES - LDSCTL_OFF) / 4; u += NWAVES * 64) ((LAS unsigned*)(ldsp + LDSCTL_OFF))[u] = 0u;
    __syncthreads();
    XcdBarrier bar; bar.bar = (unsigned*)(ctl + CW_BAR); bar.x = 0; bar.st = nullptr;
    if (N_LAUNCHES == 1) bar = xcd_barrier_post((unsigned*)(ctl + CW_BAR), MISC + 8);
#define GRID_BAR() do { if (N_LAUNCHES == 1) xcd_barrier(bar); } while (0)
    const int lo = args.ph_lo, hi = args.ph_hi;

    for (int ph = lo; ph < hi; ++ph) {
        const __attribute__((address_space(4))) Args* ap = (const __attribute__((address_space(4))) Args*)__builtin_amdgcn_kernarg_segment_ptr(); asm volatile("" : "+s"(ap));
        int tid_ = threadIdx.x; asm volatile("" : "+v"(tid_));
        int G = gridDim.x, bx = blockIdx.x; asm volatile("" : "+s"(G), "+s"(bx));
        const int vcu = (G % 8 == 0) ? (bx % 8) * (G / 8) + bx / 8 : bx, NGW = G * NWAVES;
        const int tid = tid_, lane = tid & 63, wave = __builtin_amdgcn_readfirstlane(tid >> 6), gw = vcu * NWAVES + wave;
        unsigned char* const ws = ap->ws;
        const float* const x = ap->in[0];
        const float* const g_ffn1 = ap->in[1]; const float* const w_gate1 = ap->in[2]; const float* const w_up1 = ap->in[3]; const float* const w_down1 = ap->in[4];
        const float* const g_mix = ap->in[5]; const float* const w_in = ap->in[6]; const float* const fnet_w = ap->in[7]; const float* const fnet_b = ap->in[8];
        const float* const q_norm = ap->in[9]; const float* const k_norm = ap->in[10]; const float* const w_out = ap->in[11];
        const float* const g_ffn2 = ap->in[12]; const float* const w_gate2 = ap->in[13]; const float* const w_up2 = ap->in[14]; const float* const w_down2 = ap->in[15];
        const float* const g_final = ap->in[16];
        float* const out = ap->out;
        bf16* const W1 = (bf16*)(ws + WS_W1); bf16* const WD1 = (bf16*)(ws + WS_WD1); bf16* const W2 = (bf16*)(ws + WS_W2); bf16* const WD2 = (bf16*)(ws + WS_WD2);
        bf16* const WIN = (bf16*)(ws + WS_WIN); bf16* const WOUT = (bf16*)(ws + WS_WOUT); bf16* const DFT = (bf16*)(ws + WS_DFT);
        float* const BIASP = (float*)(ws + WS_MISC); float* const ROPEC = (float*)(ws + WS_MISC + 4096); float* const ROPES = (float*)(ws + WS_MISC + 8192);
        float* const ST1 = (float*)(ws + WS_STATS); float* const ST2 = ST1 + (size_t)M * 16; float* const ST3 = ST2 + (size_t)M * 16; float* const ST4 = ST3 + (size_t)M * 16;
        bf16* const XB = (bf16*)(ws + WS_XB); bf16* const ACT = (bf16*)(ws + WS_ACT); bf16* const XT = (bf16*)(ws + WS_XT);
        bf16* const QB_ = (bf16*)(ws + WS_Q); bf16* const KB_ = (bf16*)(ws + WS_K); bf16* const VB_ = (bf16*)(ws + WS_V); bf16* const MIX = (bf16*)(ws + WS_MIX);
        float* const X1 = (float*)(ws + WS_X1);

        if (ph == 0 && PH_ON(0)) {
            LAS float* scr = (LAS float*)(ldsp + wave * 16384);
            for (int it = gw; it < 5504; it += NGW) {
                const int f = it / 2752, r = it % 2752, mat = r / 1376, r2 = r % 1376, kb = r2 / 86, nb = r2 % 86, n0 = nb * 32;
                const int drow = 256 * (n0 >> 7) + (n0 & 127) + 128 * mat;
                const float* Wsrc = f ? (mat ? w_up2 : w_gate2) : (mat ? w_up1 : w_gate1);
                p0_transpose_item(Wsrc, DFF, kb * 64, n0, (f ? W2 : W1) + (size_t)drow * DM, DM, f ? g_ffn2 : g_ffn1, scr, lane);
            }
            for (int it = gw; it < 2752; it += NGW) {
                const int f = it / 1376, r = it % 1376, kb = r / 32, nb = r % 32;
                p0_transpose_item(f ? w_down2 : w_down1, DM, kb * 64, nb * 32, (f ? WD2 : WD1) + (size_t)(nb * 32) * DFFP, DFFP, nullptr, scr, lane);
            }
            for (int it = gw; it < 384; it += NGW) {
                const int kb = it / 24, blk = it % 24, bjj = blk & 1; int drow;
                if (blk < 16) { const int head = blk >> 1; drow = 256 * (4 + (head >> 2)) + 128 * bjj + 32 * (head & 3); }
                else if (blk < 20) { drow = 1536 + 128 * bjj + 32 * ((blk - 16) >> 1); }
                else { drow = 1536 + 128 * bjj + 32 * (2 + ((blk - 20) >> 1)); }
                p0_transpose_item(w_in, INW, kb * 64, 512 + 32 * blk, WIN + (size_t)drow * DM, DM, g_mix, scr, lane);
            }
            for (int it = gw; it < 256; it += NGW) {
                const int kb = 8 + it / 32, nb = it % 32;
                p0_transpose_item(w_out, DM, kb * 64, nb * 32, WOUT + (size_t)(nb * 32) * DM, DM, nullptr, scr, lane);
            }
            for (int it = gw; it < 2 * 128 * 2; it += NGW) {
                const int f = it >> 8, r = (it >> 1) & 127, hh = it & 1; const int row = 256 * 21 + 64 + (r & 63) + 128 * (r >> 6);
                *(v4u*)((f ? W2 : W1) + (size_t)row * DM + hh * 512 + lane * 8) = (v4u){0u, 0u, 0u, 0u};
            }
            for (int it = gw; it < 2 * 128; it += NGW) {
                const int f = it >> 7, row = (it & 127) * 8 + (lane >> 3);
                *(v4u*)((f ? WD2 : WD1) + (size_t)row * DFFP + DFF + (lane & 7) * 8) = (v4u){0u, 0u, 0u, 0u};
            }
            for (int it = gw; it < 2048; it += NGW) {
                const int kb8 = it >> 4, g = (it >> 2) & 3, half = (it >> 1) & 1, c = (it & 1) * 64 + lane;
                LAS float* T = scr;
                { const float a0 = (float)lane * (1.0f / 64.0f), a1 = (float)(lane + 64) * (1.0f / 64.0f); T[lane] = half ? sinpif(a0) : cospif(a0); T[lane + 64] = half ? sinpif(a1) : cospif(a1); }
                LDS_WAIT(); asm volatile("" ::: "memory");
                float a[8];
#pragma unroll
                for (int kk = 0; kk < 8; ++kk) a[kk] = 0.f;
                const float* wp = w_in + (size_t)(kb8 * 8) * INW + g * 128;
                for (int cp = 0; cp < 128; cp += 4) {
                    float t[4];
#pragma unroll
                    for (int e = 0; e < 4; ++e) t[e] = T[((cp + e) * c) & 127];
#pragma unroll
                    for (int kk = 0; kk < 8; ++kk) { const f32x4 w4 = *(const f32x4*)(wp + (size_t)kk * INW + cp); a[kk] += (w4[0] * t[0] + w4[1] * t[1]) + (w4[2] * t[2] + w4[3] * t[3]); }
                }
                const f32x4 g0 = *(const f32x4*)(g_mix + kb8 * 8), g1 = *(const f32x4*)(g_mix + kb8 * 8 + 4);
                v4u o; o.x = pk2(a[0] * g0[0], a[1] * g0[1]); o.y = pk2(a[2] * g0[2], a[3] * g0[3]); o.z = pk2(a[4] * g1[0], a[5] * g1[1]); o.w = pk2(a[6] * g1[2], a[7] * g1[3]);
                *(v4u*)(WIN + (size_t)(g * 256 + half * 128 + c) * DM + kb8 * 8) = o;
                LDS_WAIT(); asm volatile("" ::: "memory");
            }
            for (int it = gw; it < 1024; it += NGW) {
                const int g = it >> 8, cb = (it >> 4) & 15, n = (it & 15) * 64 + lane;
                float a[8];
#pragma unroll
                for (int cc = 0; cc < 8; ++cc) a[cc] = 0.f;
                const float* fw = fnet_w + (size_t)(g * 128 + cb * 8) * 128; const float* wo = w_out + (size_t)(g * 128) * DM + n;
                for (int d = 0; d < 128; d += 4) {
                    const float b0 = wo[(size_t)d * DM], b1 = wo[(size_t)(d + 1) * DM], b2 = wo[(size_t)(d + 2) * DM], b3 = wo[(size_t)(d + 3) * DM];
#pragma unroll
                    for (int cc = 0; cc < 8; ++cc) { const f32x4 f4 = *(const f32x4*)(fw + cc * 128 + d); a[cc] += (f4[0] * b0 + f4[1] * b1) + (f4[2] * b2 + f4[3] * b3); }
                }
                v4u o; o.x = pk2(a[0], a[1]); o.y = pk2(a[2], a[3]); o.z = pk2(a[4], a[5]); o.w = pk2(a[6], a[7]);
                *(v4u*)(WOUT + (size_t)n * DM + g * 128 + cb * 8) = o;
            }
            for (int it = gw; it < 16; it += NGW) {
                const int n = it * 64 + lane; float a = 0.f;
                for (int r = 0; r < 512; ++r) a += fnet_b[r] * w_out[(size_t)r * DM + n];
                BIASP[n] = a;
            }
            for (int it = gw; it < 16384; it += NGW) {
                const int k = it >> 3, ch = it & 7, n0 = (ch & 3) * 512 + lane * 8; float v[8];
#pragma unroll
                for (int e = 0; e < 8; ++e) { const float ph_ = (float)((k * (n0 + e)) & 2047) * (1.0f / 1024.0f); v[e] = (ch < 4 ? cospif(ph_) : -sinpif(ph_)) * (1.0f / 512.0f); }
                v4u o; o.x = pk2(v[0], v[1]); o.y = pk2(v[2], v[3]); o.z = pk2(v[4], v[5]); o.w = pk2(v[6], v[7]);
                *(v4u*)(DFT + (size_t)k * 4096 + ch * 512 + lane * 8) = o;
            }
            if (gw == 0) {
#pragma unroll
                for (int e = 0; e < 16; ++e) { const float inv = powf(10000.0f, -(float)(2 * e) / 32.0f); const float ang = (float)lane * inv; ROPEC[lane * 16 + e] = cosf(ang); ROPES[lane * 16 + e] = sinf(ang); }
            }
            for (int m = gw; m < M; m += NGW) {
                const f32x4* xr = (const f32x4*)(x + (size_t)m * DM) + lane; f32x4 v[4]; float s = 0.f;
#pragma unroll
                for (int j = 0; j < 4; ++j) { v[j] = xr[64 * j]; s += (v[j][0] * v[j][0] + v[j][1] * v[j][1]) + (v[j][2] * v[j][2] + v[j][3] * v[j][3]); }
                s = wave_sum(s);
                unsigned long long* o8 = (unsigned long long*)(XB + (size_t)m * DM) + lane;
#pragma unroll
                for (int j = 0; j < 4; ++j) o8[64 * j] = (unsigned long long)pk2(v[j][0], v[j][1]) | ((unsigned long long)pk2(v[j][2], v[j][3]) << 32);
                if (lane < 16) ST1[(size_t)m * 16 + lane] = s * (1.0f / 16.0f);
            }
            __syncthreads();
        } else if ((ph == 1 || ph == 6) && PH_ON(1)) {
            pg8::Gemm g{XB, ph == 1 ? W1 : W2, M, NGU, DM}; pg8::StaticOrder S; S.init(M, NGU, G, bx);
            pg8::EpiSwiGLU E{ACT, ph == 1 ? ST1 : ST3};
            pg8::gemm_phase<pg8::EpiSwiGLU, pg8::StaticOrder, true, true>(ldsp, g, S, E);
        } else if ((ph == 2 || ph == 5 || ph == 7) && PH_ON(2)) {
            pg8::Gemm g{ph == 5 ? MIX : ACT, ph == 2 ? WD1 : (ph == 5 ? WOUT : WD2), M, DM, ph == 5 ? DM : DFFP}; pg8::StaticOrder S; S.init(M, DM, G, bx);
            pg8::EpiResid E{ph == 2 ? x : (ph == 5 ? X1 : out), ph == 2 ? X1 : (ph == 5 ? out : X1), ph == 7 ? (bf16*)nullptr : XB, ph == 2 ? ST2 : (ph == 5 ? ST3 : ST4), ph == 5 ? BIASP : (const float*)nullptr, ph == 5 ? 1.0f : 0.5f};
            pg8::gemm_phase<pg8::EpiResid, pg8::StaticOrder, true, true>(ldsp, g, S, E);
        } else if (ph == 3 && PH_ON(3)) {
            pg8::Gemm g{XB, WIN, M, NIN, DM}; pg8::StaticOrder S; S.init(M, NIN, G, bx);
            pg8::EpiWin E{ST2, XT, QB_, KB_, VB_, q_norm, k_norm, ROPEC, ROPES};
            pg8::gemm_phase<pg8::EpiWin, pg8::StaticOrder, true, true>(ldsp, g, S, E);
        } else if (ph == 4 && PH_ON(4)) {
#ifndef NO_DFT
            {
                pg8::Gemm g{DFT, XT, M, 512, 4096}; pg8::StaticOrder S; S.init(M, 512, G, bx); S.dft = 1;
                pg8::EpiBf16Plain E{MIX, DM};
                pg8::gemm_phase<pg8::EpiBf16Plain, pg8::StaticOrder, true, true>(ldsp, g, S, E);
            }
#endif
#ifndef NO_ATTN
            {
                const attn_body::AttnTensors AT{(const attn_body::bf16*)QB_, (const attn_body::bf16*)KB_, (const attn_body::bf16*)VB_, (attn_body::bf16*)MIX};
                const attn_body::AttnOrder S(G, vcu);
                attn_body::attn_phase<attn_body::AttnOrder>((char*)lds, AT, S);
            }
#endif
        } else if (ph == 8 && PH_ON(8)) {
            unsigned poison = 0u;
            if (N_LAUNCHES == 1) poison = __hip_atomic_load((gu32*)(ctl + CW_BAR + XB_TMO), RLX_AGENT);
            f32x4 gf[4];
#pragma unroll
            for (int j = 0; j < 4; ++j) gf[j] = ((const f32x4*)g_final)[64 * j + lane];
            const float qnan = __builtin_nanf("");
            for (int m = gw; m < M; m += NGW) {
                const f32x4* xr = (const f32x4*)(X1 + (size_t)m * DM) + lane; f32x4 v[4];
#pragma unroll
                for (int j = 0; j < 4; ++j) v[j] = xr[64 * j];
                float s = (lane < 16) ? ST4[(size_t)m * 16 + lane] : 0.f; s = wave_sum(s);
                float rstd = rsqrtf(s * (1.0f / DM) + 1e-6f); if (poison) rstd = qnan;
                f32x4* o = (f32x4*)(out + (size_t)m * DM) + lane;
#pragma unroll
                for (int j = 0; j < 4; ++j) o[64 * j] = v[j] * rstd * gf[j];
            }
        }
        if (ph + 1 < hi) GRID_BAR();
    }
#undef GRID_BAR
}

extern "C" void kernel_launch(void* const* d_in, const int* in_sizes, int n_in, void* d_out, int out_size, void* d_ws, size_t ws_size, hipStream_t stream) {
    static int grid = 0;
    if (grid == 0) {
        if (n_in != 17 || in_sizes[0] != M * DM || out_size != M * DM || ws_size < WS_END) { fprintf(stderr, "kernel_launch: unexpected shapes (n_in %d, in0 %d, out %d, ws %zu); nothing launched\n", n_in, n_in > 0 ? in_sizes[0] : -1, out_size, ws_size); grid = -1; return; }
        int dev = 0, cus = 0, per_cu = 0;
        if (hipGetDevice(&dev) != hipSuccess || hipDeviceGetAttribute(&cus, hipDeviceAttributeMultiprocessorCount, dev) != hipSuccess) { fprintf(stderr, "kernel_launch: device query failed\n"); grid = -1; return; }
        if (hipFuncSetAttribute((const void*)mk_fwd, hipFuncAttributeMaxDynamicSharedMemorySize, LDS_BYTES) != hipSuccess) { fprintf(stderr, "kernel_launch: hipFuncSetAttribute failed\n"); grid = -1; return; }
        if (hipOccupancyMaxActiveBlocksPerMultiprocessor(&per_cu, (const void*)mk_fwd, NWAVES * 64, LDS_BYTES) != hipSuccess || per_cu < 1) { fprintf(stderr, "kernel_launch: occupancy query reports %d workgroups per CU\n", per_cu); per_cu = 1; }
        (void)hipGetLastError();
        grid = cus;
    }
    if (grid < 0) return;
    if (hipMemsetAsync((char*)d_ws + WS_CTL, 0, CTL_ZERO_BYTES, stream) != hipSuccess) { fprintf(stderr, "kernel_launch: hipMemsetAsync failed\n"); return; }
    Args a{};
    for (int i = 0; i < 17; ++i) a.in[i] = (const float*)d_in[i];
    a.out = (float*)d_out; a.ws = (unsigned char*)d_ws;
    for (int li = 0; li < N_LAUNCHES; ++li) {
        a.ph_lo = (N_LAUNCHES == 1) ? 0 : li; a.ph_hi = (N_LAUNCHES == 1) ? N_PHASES : li + 1; a.li = li;
        hipLaunchKernelGGL(mk_fwd, dim3(grid), dim3(NWAVES * 64), LDS_BYTES, stream, a);
        const hipError_t le = hipPeekAtLastError();
        if (le != hipSuccess) { fprintf(stderr, "kernel_launch: launch %d failed: %s\n", li, hipGetErrorName(le)); break; }
    }
}
```

```cpp
#ifndef ATTN_RUNNING_MAX
#define ATTN_NOMAX 1
#endif
#include <hip/hip_runtime.h>
#include <hip/hip_bf16.h>
#include <cstdio>
#include <cstdint>
#include <cmath>
#define ZFIRST_SWIGLU true
namespace pg8 {
#define PG8_LAS __attribute__((address_space(3)))
typedef unsigned short bf16_t;
typedef short bf16x8 __attribute__((ext_vector_type(8)));
typedef float f32x4 __attribute__((ext_vector_type(4)));
typedef unsigned u32x4 __attribute__((ext_vector_type(4)));
constexpr int BM = 256, BK = 64, HALF = 128, HTB = HALF * BK * 2  , STAGE_BYTES = 8 * HTB, NXCD = 8;
#ifndef WGM_OVERRIDE
#define WGM_OVERRIDE 8
#endif
constexpr int WGM = WGM_OVERRIDE;

__host__ __device__ __forceinline__ int lds_byte(int r, int c) { const int st = (r >> 4) * 2 + (c >> 5), rr = r & 15, cc = c & 31, ob = rr * 64 + cc * 2; return st * 1024 + (ob ^ (((ob >> 9) & 1) << 5)); }
__host__ __device__ __forceinline__ void stage_rc(int b, int& R, int& C) { const int st = b / 1024, sb = b % 1024, swz = sb ^ (((sb >> 9) & 1) << 5); R = (st >> 1) * 16 + swz / 64; C = (st & 1) * 32 + (swz % 64) / 2; }
__host__ __device__ __forceinline__ int perm32(int rho) { const int n = rho >> 4, i = rho & 15; return 8 * (i >> 2) + 4 * n + (i & 3); }

struct Unit { int pm, pn, a0row, a1row, brow, spec; };
struct Gemm { const bf16_t* A; const bf16_t* Bt; int M, N, K; };

struct StaticOrder {
    int rev;
    int nM, nN, nwg, G, c, mode, rot;
    __host__ __device__ void init(int M, int N, int G_, int c_) { nM = M / BM; nN = N / BM; nwg = nM * nN; G = G_; c = c_; mode = 0; rot = 0; rev = 0; }
    __host__ __device__ bool next(int i, Unit& u) const {
        const long L = (long)i * G + c; if (L >= nwg) return false;
        int wgid = (int)L; { const int q = nwg / NXCD, r = nwg % NXCD, xcd = wgid % NXCD, off = wgid / NXCD; const int cntx = (xcd < r) ? q + 1 : q; wgid = (xcd < r ? xcd * (q + 1) : r * (q + 1) + (xcd - r) * q) + (rev ? cntx - 1 - off : off); }
        const int nig = WGM * nN, gid = wgid / nig, fm = gid * WGM, gsz = (nM - fm) < WGM ? (nM - fm) : WGM;
        u.pm = fm + ((wgid % nig) % gsz); u.pn = (wgid % nig) / gsz;
        if (mode == 1) { const int b = u.pm >> 3, sb = u.pm & 7; u.a0row = b * 2048 + 128 * sb; u.a1row = b * 2048 + 1024 - 128 * sb; u.brow = u.pn; u.spec = (sb == 0); }
        else if (mode == 2) { u.a0row = 256 * (u.pm & 7); u.a1row = u.a0row + 128; u.brow = (u.pm >> 3) * 2 + u.pn; u.spec = 0; }
        else { u.a0row = 256 * u.pm; u.a1row = u.a0row + 128; u.brow = u.pn; u.spec = 0; }
        return true;
    }
    __device__ __forceinline__ int krot(int nt) const { if (!rot) return 0; const int j = c >> 3; return (((j & 7) + (j >> 3)) & 1) ? ((nt >> 1) & ~1) : 0; }
    __device__ __forceinline__ void a_ready(const Unit&) const {}
    __device__ __forceinline__ void done(const Unit&) const {}
};


typedef float f32x2_t __attribute__((ext_vector_type(2))); typedef __bf16 bf16x2_t __attribute__((ext_vector_type(2)));
typedef unsigned u32x2 __attribute__((ext_vector_type(2)));
__device__ __forceinline__ unsigned cvt_pk_bf16(float lo, float hi) { f32x2_t v = {lo, hi}; bf16x2_t b = __builtin_convertvector(v, bf16x2_t); return __builtin_bit_cast(unsigned, b); }
__device__ __forceinline__ float xsum16(float v) { const auto r = __builtin_amdgcn_permlane16_swap(__float_as_uint(v), __float_as_uint(v), false, false); const unsigned r0 = r[0], r1 = r[1]; return __uint_as_float(r0) + __uint_as_float(r1); }
__device__ __forceinline__ float xsum32(float v) { const auto r = __builtin_amdgcn_permlane32_swap(__float_as_uint(v), __float_as_uint(v), false, false); const unsigned r0 = r[0], r1 = r[1]; return __uint_as_float(r0) + __uint_as_float(r1); }
#ifndef ZFIRST_SWIGLU
#define ZFIRST_SWIGLU false
#endif
#ifndef ZFIRST_RESID
#define ZFIRST_RESID false
#endif
#ifndef ZFIRST_OTHER
#define ZFIRST_OTHER false
#endif
constexpr int DM_ = 1024, M_ = 32768;
constexpr int WIN_TBL_OFF = STAGE_BYTES + 8 * 2560 + 512;
constexpr float EPS_ = 1e-6f;
__device__ __forceinline__ float row_rstd(const float* __restrict__ stats, int row, int fq) {
    const f32x4 v = *(const f32x4*)((const char*)stats + ((unsigned)row * 64u + 16u * (unsigned)fq));
    float s = (v[0] + v[1]) + (v[2] + v[3]);
    s = xsum32(xsum16(s));
    return __builtin_amdgcn_rsqf(s * (1.0f / DM_) + EPS_);
}

__device__ __forceinline__ void row_rstd8(const float* __restrict__ stats, const int (&rows)[2][4], int fq, float (&rs)[2][4]) {
    f32x4 v[2][4];
#pragma unroll
    for (int ai = 0; ai < 2; ++ai)
#pragma unroll
        for (int m = 0; m < 4; ++m) v[ai][m] = *(const f32x4*)((const char*)stats + ((unsigned)rows[ai][m] * 64u + 16u * (unsigned)fq));
    asm volatile("" : "+v"(v[0][0]), "+v"(v[0][1]), "+v"(v[0][2]), "+v"(v[0][3]), "+v"(v[1][0]), "+v"(v[1][1]), "+v"(v[1][2]), "+v"(v[1][3]));
#pragma unroll
    for (int ai = 0; ai < 2; ++ai)
#pragma unroll
        for (int m = 0; m < 4; ++m) { float s = (v[ai][m][0] + v[ai][m][1]) + (v[ai][m][2] + v[ai][m][3]); s = xsum32(xsum16(s)); rs[ai][m] = __builtin_amdgcn_rsqf(s * (1.0f / DM_) + EPS_); }
}

__device__ __forceinline__ unsigned stat_idx(int row, int slot) { return ((unsigned)row & ~15u) * 16u + (unsigned)slot * 16u + ((unsigned)row & 15u); }
__device__ __forceinline__ void row_rstd8t(const float* __restrict__ stats, const int (&rows)[2][4], int fq, float (&rs)[2][4]) {
#pragma unroll
    for (int ai = 0; ai < 2; ++ai) {
        float v[4][4];
#pragma unroll
        for (int m = 0; m < 4; ++m) { const char* sp = (const char*)stats + stat_idx(rows[ai][m], 4 * fq) * 4u;
#pragma unroll
            for (int i = 0; i < 4; ++i) v[m][i] = *(const float*)(sp + 64 * i); }
        asm volatile("" : "+v"(v[0][0]), "+v"(v[0][1]), "+v"(v[0][2]), "+v"(v[0][3]), "+v"(v[1][0]), "+v"(v[1][1]), "+v"(v[1][2]), "+v"(v[1][3]),
                          "+v"(v[2][0]), "+v"(v[2][1]), "+v"(v[2][2]), "+v"(v[2][3]), "+v"(v[3][0]), "+v"(v[3][1]), "+v"(v[3][2]), "+v"(v[3][3]));
#pragma unroll
        for (int m = 0; m < 4; ++m) { float s = (v[m][0] + v[m][1]) + (v[m][2] + v[m][3]); s = xsum32(xsum16(s)); rs[ai][m] = __builtin_amdgcn_rsqf(s * (1.0f / DM_) + EPS_); }
    }
}

struct EpiSwiGLU {
    #ifndef PROBE_EPI_SWIGLU
#define PROBE_EPI_SWIGLU false
#endif
    static constexpr bool PERM = true, AFTER_DRAIN = false, PROBE_TWICE = PROBE_EPI_SWIGLU, ZFIRST = ZFIRST_SWIGLU;
    __device__ __forceinline__ EpiSwiGLU second() const { return *this; }
    bf16_t* __restrict__ O; const float* __restrict__ stats; bool tr;
    __device__ __forceinline__ void operator()(const f32x4 (&acc)[2][2][4][2], const Unit& u, int wr, int wc, int fr_in, int fq_in, PG8_LAS unsigned char* lds) const {
        int fr = fr_in, fq = fq_in; asm volatile("" : "+v"(fr), "+v"(fq));
        const int row0 = u.pm * BM + wr * 64 + fr, col0 = u.pn * 128 + wc * 32 + 8 * fq;
#if defined(ACT_WT)
        const __amdgpu_buffer_rsrc_t orsrc = __builtin_amdgcn_make_buffer_rsrc((void*)O, 0, 0x7fffffff, 0x00020000);
#endif
        const unsigned ob0 = ((unsigned)row0 * 2816u + (unsigned)col0) * 2u;
        float rsv[2][4]; int rws[2][4];
#pragma unroll
        for (int ai = 0; ai < 2; ++ai)
#pragma unroll
            for (int m = 0; m < 4; ++m) rws[ai][m] = row0 + ai * HALF + m * 16;
        { PG8_LAS float* rc = (PG8_LAS float*)(lds + WIN_TBL_OFF + (wr * 4 + wc) * 512) + fr * 8;
          PG8_LAS unsigned* tg = (PG8_LAS unsigned*)(lds + WIN_TBL_OFF + 4096 + (wr * 4 + wc) * 4);
          const unsigned want = (unsigned)u.pm + 1u;
          if ((unsigned)__builtin_amdgcn_readfirstlane((int)*tg) == want) {
              const f32x4 c0 = *(const PG8_LAS f32x4*)rc, c1 = *(const PG8_LAS f32x4*)(rc + 4);
              rsv[0][0] = c0[0]; rsv[0][1] = c0[1]; rsv[0][2] = c0[2]; rsv[0][3] = c0[3]; rsv[1][0] = c1[0]; rsv[1][1] = c1[1]; rsv[1][2] = c1[2]; rsv[1][3] = c1[3];
          } else {
              if (tr) row_rstd8t(stats, rws, fq, rsv); else row_rstd8(stats, rws, fq, rsv);
              if (fq == 0) { *(PG8_LAS f32x4*)rc = (f32x4){rsv[0][0], rsv[0][1], rsv[0][2], rsv[0][3]}; *(PG8_LAS f32x4*)(rc + 4) = (f32x4){rsv[1][0], rsv[1][1], rsv[1][2], rsv[1][3]}; }
              *tg = want;
          } }
#pragma unroll
        for (int ai = 0; ai < 2; ++ai)
#pragma unroll
            for (int m = 0; m < 4; ++m) {
                const int row = row0 + ai * HALF + m * 16;
                const float rs = rsv[ai][m];
                const float k1 = rs * -1.4426950408889634f, ik2 = __builtin_amdgcn_rcpf(rs * rs);
                float a[8];
#pragma unroll
                for (int n = 0; n < 2; ++n)
#pragma unroll
                    for (int jj = 0; jj < 2; ++jj) {
                        const f32x2_t g = {acc[ai][0][m][n][2 * jj], acc[ai][0][m][n][2 * jj + 1]}, up = {acc[ai][1][m][n][2 * jj], acc[ai][1][m][n][2 * jj + 1]};
                        const f32x2_t t = g * k1; f32x2_t e; e.x = __builtin_amdgcn_exp2f(t.x); e.y = __builtin_amdgcn_exp2f(t.y);
                        const f32x2_t d = e * ik2 + ik2; f32x2_t r; r.x = __builtin_amdgcn_rcpf(d.x); r.y = __builtin_amdgcn_rcpf(d.y);
                        const f32x2_t o = (g * up) * r;
                        a[n * 4 + 2 * jj] = o.x; a[n * 4 + 2 * jj + 1] = o.y;
                    }
                u32x4 w; w.x = cvt_pk_bf16(a[0], a[1]); w.y = cvt_pk_bf16(a[2], a[3]); w.z = cvt_pk_bf16(a[4], a[5]); w.w = cvt_pk_bf16(a[6], a[7]);
#if defined(ACT_WT)
                __builtin_amdgcn_raw_buffer_store_b128(w, orsrc, ((unsigned)row * 2816u + (unsigned)col0) * 2u, 0, 16);
#elif defined(ACT_NT)
                __builtin_nontemporal_store(w, (u32x4*)(O + (size_t)row * 2816 + col0));
#else
                *(u32x4*)((char*)O + (ob0 + (unsigned)((ai * HALF + m * 16) * 2816 * 2))) = w;
#endif
            }
    }
};

#ifndef PROBE_EPI_RESID
#define PROBE_EPI_RESID false
#endif
struct EpiResid {
    static constexpr bool PERM = true, AFTER_DRAIN = false, PROBE_TWICE = PROBE_EPI_RESID, ZFIRST = ZFIRST_RESID;
    __device__ __forceinline__ EpiResid second() const { EpiResid e = *this; e.alpha = 0.f; e.bias = nullptr; return e; }
    bf16_t* xb; float* __restrict__ stats_out; const float* __restrict__ bias; float alpha; bool trs;
    __device__ __forceinline__ void operator()(const f32x4 (&acc)[2][2][4][2], const Unit& u, int wr, int wc, int fr_in, int fq_in, PG8_LAS unsigned char*) const {
        int fr = fr_in, fq = fq_in; asm volatile("" : "+v"(fr), "+v"(fq));
        const int row0 = u.pm * BM + wr * 64 + fr, col0 = u.pn * BM + wc * 32 + 8 * fq;
        const unsigned ob0 = ((unsigned)row0 * DM_ + (unsigned)col0) * 2u;
        u32x4 rv[2][4][2];
#pragma unroll
        for (int ai = 0; ai < 2; ++ai)
#pragma unroll
            for (int m = 0; m < 4; ++m)
#pragma unroll
                for (int bj = 0; bj < 2; ++bj) rv[ai][m][bj] = *(const u32x4*)(((const char*)xb + (size_t)((ai * HALF + m * 16) * DM_ + bj * HALF) * 2u) + ob0);
        f32x4 bv[2][2];
#pragma unroll
        for (int bj = 0; bj < 2; ++bj)
#pragma unroll
            for (int n = 0; n < 2; ++n) bv[bj][n] = bias ? *(const f32x4*)(bias + col0 + bj * HALF + n * 4) : (f32x4){0.f, 0.f, 0.f, 0.f};
        asm volatile("" ::: "memory");
#pragma unroll
        for (int ai = 0; ai < 2; ++ai)
#pragma unroll
            for (int m = 0; m < 4; ++m) {
                float ss = 0.f;
#pragma unroll
                for (int bj = 0; bj < 2; ++bj) {
                    const u32x4 r = rv[ai][m][bj];
                    const f32x4 r0 = {__uint_as_float(r.x << 16), __uint_as_float(r.x & 0xffff0000u), __uint_as_float(r.y << 16), __uint_as_float(r.y & 0xffff0000u)};
                    const f32x4 r1 = {__uint_as_float(r.z << 16), __uint_as_float(r.z & 0xffff0000u), __uint_as_float(r.w << 16), __uint_as_float(r.w & 0xffff0000u)};
                    const f32x4 o0 = r0 + acc[ai][bj][m][0] * alpha + bv[bj][0], o1 = r1 + acc[ai][bj][m][1] * alpha + bv[bj][1];
                    ss += ((o0[0] * o0[0] + o0[1] * o0[1]) + (o0[2] * o0[2] + o0[3] * o0[3])) + ((o1[0] * o1[0] + o1[1] * o1[1]) + (o1[2] * o1[2] + o1[3] * o1[3]));
                    u32x4 w; w.x = cvt_pk_bf16(o0[0], o0[1]); w.y = cvt_pk_bf16(o0[2], o0[3]); w.z = cvt_pk_bf16(o1[0], o1[1]); w.w = cvt_pk_bf16(o1[2], o1[3]);
                    *(u32x4*)(((char*)xb + (size_t)((ai * HALF + m * 16) * DM_ + bj * HALF) * 2u) + ob0) = w;
                }
                ss = xsum32(xsum16(ss));
                if (stats_out && fq == 0) *(float*)((char*)stats_out + 4u * (trs ? stat_idx(row0 + ai * HALF + m * 16, u.pn * 4 + wc) : (unsigned)(row0 + ai * HALF + m * 16) * 16u + (unsigned)(u.pn * 4 + wc))) = ss;
            }
    }
};

struct EpiFinal {
    static constexpr bool PERM = true, AFTER_DRAIN = false, PROBE_TWICE = false, ZFIRST = ZFIRST_OTHER;
    __device__ __forceinline__ EpiFinal second() const { return *this; }
    const bf16_t* __restrict__ xb; float* stats; unsigned* cnt; const float* __restrict__ gfin; float* __restrict__ out; float alpha;
    __device__ __forceinline__ void operator()(f32x4 (&acc)[2][2][4][2], const Unit& u, int wr, int wc, int fr_in, int fq_in, PG8_LAS unsigned char* lds) const {
        int fr = fr_in, fq = fq_in; asm volatile("" : "+v"(fr), "+v"(fq));
        const int row0 = u.pm * BM + wr * 64 + fr, col0 = u.pn * BM + wc * 32 + 8 * fq;
        const unsigned ob0 = ((unsigned)row0 * DM_ + (unsigned)col0) * 2u;
        u32x4 rv[2][4][2];
#pragma unroll
        for (int ai = 0; ai < 2; ++ai)
#pragma unroll
            for (int m = 0; m < 4; ++m)
#pragma unroll
                for (int bj = 0; bj < 2; ++bj) rv[ai][m][bj] = *(const u32x4*)(((const char*)xb + (size_t)((ai * HALF + m * 16) * DM_ + bj * HALF) * 2u) + ob0);
#pragma unroll
        for (int ai = 0; ai < 2; ++ai)
#pragma unroll
            for (int m = 0; m < 4; ++m) {
                float ss = 0.f;
#pragma unroll
                for (int bj = 0; bj < 2; ++bj) {
                    const u32x4 r = rv[ai][m][bj];
                    const f32x4 r0 = {__uint_as_float(r.x << 16), __uint_as_float(r.x & 0xffff0000u), __uint_as_float(r.y << 16), __uint_as_float(r.y & 0xffff0000u)};
                    const f32x4 r1 = {__uint_as_float(r.z << 16), __uint_as_float(r.z & 0xffff0000u), __uint_as_float(r.w << 16), __uint_as_float(r.w & 0xffff0000u)};
                    const f32x4 o0 = r0 + acc[ai][bj][m][0] * alpha, o1 = r1 + acc[ai][bj][m][1] * alpha;
                    acc[ai][bj][m][0] = o0; acc[ai][bj][m][1] = o1;
                    ss += ((o0[0] * o0[0] + o0[1] * o0[1]) + (o0[2] * o0[2] + o0[3] * o0[3])) + ((o1[0] * o1[0] + o1[1] * o1[1]) + (o1[2] * o1[2] + o1[3] * o1[3]));
                }
                ss = xsum32(xsum16(ss));
                if (fq == 0) __hip_atomic_store((float*)((char*)stats + 4u * stat_idx(row0 + ai * HALF + m * 16, u.pn * 4 + wc)), ss, __ATOMIC_RELAXED, __HIP_MEMORY_SCOPE_AGENT);
            }
        asm volatile("s_waitcnt vmcnt(0)" ::: "memory");
        if (fq == 0 && fr == 0) __hip_atomic_fetch_add(cnt + 64 * u.pm, 1u, __ATOMIC_RELAXED, __HIP_MEMORY_SCOPE_AGENT);
        if (wr == 0 && wc == 0) {
            unsigned spins = 0;
            while ((unsigned)__builtin_amdgcn_readfirstlane(__hip_atomic_load(cnt + 64 * u.pm, __ATOMIC_RELAXED, __HIP_MEMORY_SCOPE_AGENT)) < 32u) { __builtin_amdgcn_s_sleep(2); if (++spins > (1u << 22)) break; }
        }
        asm volatile("s_waitcnt vmcnt(0) lgkmcnt(0)" ::: "memory"); __builtin_amdgcn_s_barrier(); asm volatile("" ::: "memory");
        float rstd[2][4];
        { f32x4 pv[2][4];
#pragma unroll
          for (int ai = 0; ai < 2; ++ai)
#pragma unroll
              for (int m = 0; m < 4; ++m) { const float* sp = (const float*)((const char*)stats + 4u * stat_idx(row0 + ai * HALF + m * 16, 4 * fq));
                  pv[ai][m] = (f32x4){__hip_atomic_load(sp, __ATOMIC_RELAXED, __HIP_MEMORY_SCOPE_AGENT), __hip_atomic_load(sp + 16, __ATOMIC_RELAXED, __HIP_MEMORY_SCOPE_AGENT),
                                       __hip_atomic_load(sp + 32, __ATOMIC_RELAXED, __HIP_MEMORY_SCOPE_AGENT), __hip_atomic_load(sp + 48, __ATOMIC_RELAXED, __HIP_MEMORY_SCOPE_AGENT)}; }
          asm volatile("" : "+v"(pv[0][0]), "+v"(pv[0][1]), "+v"(pv[0][2]), "+v"(pv[0][3]), "+v"(pv[1][0]), "+v"(pv[1][1]), "+v"(pv[1][2]), "+v"(pv[1][3]));
#pragma unroll
          for (int ai = 0; ai < 2; ++ai)
#pragma unroll
              for (int m = 0; m < 4; ++m) { float s = (pv[ai][m][0] + pv[ai][m][1]) + (pv[ai][m][2] + pv[ai][m][3]); s = xsum32(xsum16(s)); rstd[ai][m] = __builtin_amdgcn_rsqf(s * (1.0f / DM_) + EPS_); } }
        asm volatile("" : "+v"(rstd[0][0]), "+v"(rstd[0][1]), "+v"(rstd[0][2]), "+v"(rstd[0][3]), "+v"(rstd[1][0]), "+v"(rstd[1][1]), "+v"(rstd[1][2]), "+v"(rstd[1][3]));
        const bool hi8 = (fr & 8) != 0; const int row8 = row0 - (fr & 8), col8 = col0 + (hi8 ? 4 : 0); const unsigned oo8 = ((unsigned)row8 * DM_ + (unsigned)col8) * 4u;
#pragma unroll
        for (int bj = 0; bj < 2; ++bj) {
            const f32x4 g0 = *(const f32x4*)(gfin + col0 + bj * HALF), g1 = *(const f32x4*)(gfin + col0 + bj * HALF + 4);
#pragma unroll
            for (int ai = 0; ai < 2; ++ai)
#pragma unroll
                for (int m = 0; m < 4; ++m) {
                    const f32x4 x0 = acc[ai][bj][m][0] * rstd[ai][m] * g0, x1 = acc[ai][bj][m][1] * rstd[ai][m] * g1;
                    f32x4 ya, yb;
#pragma unroll
                    for (int j = 0; j < 4; ++j) {
                        const float a0 = x0[j], a1 = x1[j];
                        const float r0 = __uint_as_float((unsigned)__builtin_amdgcn_update_dpp(0, (int)__float_as_uint(a0), 0x128, 0xf, 0xf, false));
                        const float r1 = __uint_as_float((unsigned)__builtin_amdgcn_update_dpp(0, (int)__float_as_uint(a1), 0x128, 0xf, 0xf, false));
                        ya[j] = hi8 ? r1 : a0; yb[j] = hi8 ? a1 : r0; }
                    char* op = (char*)out + (oo8 + (unsigned)(((ai * HALF + m * 16) * DM_ + bj * HALF) * 4));
                    *(f32x4*)(op) = ya; *(f32x4*)(op + 8 * DM_ * 4) = yb; }
        }
    }
};

struct EpiBf16Plain {
    static constexpr bool PERM = true, AFTER_DRAIN = false, PROBE_TWICE = false, ZFIRST = ZFIRST_OTHER;
    __device__ __forceinline__ EpiBf16Plain second() const { return *this; }
    bf16_t* __restrict__ O; int ldc;
    __device__ __forceinline__ void operator()(const f32x4 (&acc)[2][2][4][2], const Unit& u, int wr, int wc, int fr_in, int fq_in, PG8_LAS unsigned char*) const {
        int fr = fr_in, fq = fq_in; asm volatile("" : "+v"(fr), "+v"(fq));
        const int row0 = u.pm * BM + wr * 64 + fr, col0 = u.pn * BM + wc * 32 + 8 * fq;
#pragma unroll
        for (int ai = 0; ai < 2; ++ai)
#pragma unroll
            for (int m = 0; m < 4; ++m) { bf16_t* rowp = O + (size_t)(row0 + ai * HALF + m * 16) * ldc + col0;
#pragma unroll
                for (int bj = 0; bj < 2; ++bj) { const f32x4 v0 = acc[ai][bj][m][0], v1 = acc[ai][bj][m][1];
                    u32x4 w; w.x = cvt_pk_bf16(v0[0], v0[1]); w.y = cvt_pk_bf16(v0[2], v0[3]); w.z = cvt_pk_bf16(v1[0], v1[1]); w.w = cvt_pk_bf16(v1[2], v1[3]);
                    *(u32x4*)(rowp + bj * HALF) = w; } }
    }
};

#ifndef PROBE_EPI_WIN
#define PROBE_EPI_WIN false
#endif
struct EpiWin {
    static constexpr bool PERM = false, AFTER_DRAIN = false, PROBE_TWICE = PROBE_EPI_WIN, ZFIRST = false;
    __device__ __forceinline__ EpiWin second() const { return *this; }
    const float* __restrict__ stats; bf16_t* __restrict__ XT2; float* __restrict__ Tv; float* __restrict__ ALTP; bf16_t* __restrict__ Qb; bf16_t* __restrict__ Kb; bf16_t* __restrict__ Vb;
    const float* __restrict__ qn; const float* __restrict__ kn; const float* __restrict__ ropeC; const float* __restrict__ ropeS;
    template <int TY> __device__ __forceinline__ void head_path(const f32x4 (&acc)[2][2][4][2], bf16_t* __restrict__ dst, unsigned pitchb, PG8_LAS const unsigned char* tbl, unsigned gnoff, const float (&rs)[2][4], const int (&pos)[2][4], int brow0, int fq) const {
        const float qs = (TY == 0) ? 0.125f * 1.4426950408889634f : 1.0f;
        const unsigned fqb = 16u * (unsigned)fq;
#pragma unroll
        for (int ai = 0; ai < 2; ++ai)
#pragma unroll
            for (int m = 0; m < 4; ++m) {
                const int s = pos[ai][m];
                f32x4 v[2][2];
#pragma unroll
                for (int bj = 0; bj < 2; ++bj)
#pragma unroll
                    for (int n = 0; n < 2; ++n) v[bj][n] = acc[ai][bj][m][n] * rs[ai][m];
                if (TY != 2) {
                    float ss = 0.f;
#pragma unroll
                    for (int bj = 0; bj < 2; ++bj)
#pragma unroll
                        for (int n = 0; n < 2; ++n) ss += (v[bj][n][0] * v[bj][n][0] + v[bj][n][1] * v[bj][n][1]) + (v[bj][n][2] * v[bj][n][2] + v[bj][n][3] * v[bj][n][3]);
                    ss = xsum32(xsum16(ss));
                    const float r = __builtin_amdgcn_rsqf(ss * (1.0f / 64.0f) + EPS_);
#pragma unroll
                    for (int bj = 0; bj < 2; ++bj) {
                        const unsigned p = bj ? (unsigned)(s & 63) : (unsigned)(s >> 6);
                        const f32x4 c = *(const PG8_LAS f32x4*)(tbl + (p * 64u + fqb)), sn = *(const PG8_LAS f32x4*)(tbl + (4096u + p * 64u + fqb));
                        const f32x4 g1 = *(const PG8_LAS f32x4*)(tbl + (gnoff + 128u * bj + fqb)), g2 = *(const PG8_LAS f32x4*)(tbl + (gnoff + 128u * bj + 64u + fqb));
                        const f32x4 x1 = v[bj][0] * r * g1, x2 = v[bj][1] * r * g2;
                        v[bj][0] = (x1 * c - x2 * sn) * qs; v[bj][1] = (x1 * sn + x2 * c) * qs;
                    }
                }
                const unsigned ob = (unsigned)(brow0 + s) * pitchb + 8u * (unsigned)fq;
#pragma unroll
                for (int bj = 0; bj < 2; ++bj)
#pragma unroll
                    for (int n = 0; n < 2; ++n) { u32x2 w; w.x = cvt_pk_bf16(v[bj][n][0], v[bj][n][1]); w.y = cvt_pk_bf16(v[bj][n][2], v[bj][n][3]); *(u32x2*)((char*)dst + (ob + 64u * bj + 32u * n)) = w; }
                if (m & 1) { asm volatile("" ::: "memory"); __builtin_amdgcn_sched_barrier(0); }
            }
    }
    __device__ __forceinline__ void operator()(const f32x4 (&acc)[2][2][4][2], const Unit& u, int wr_in, int wc_in, int fr_in, int fq_in, PG8_LAS unsigned char* lds) const {
        int fr = fr_in, fq = fq_in; asm volatile("" : "+v"(fr), "+v"(fq));
        int wr = wr_in, wc = wc_in; asm volatile("" : "+s"(wr), "+s"(wc));
        const int b = u.pm >> 3, sb = u.pm & 7, i0 = wr * 64 + fr, brow0 = b * 2048;
        int pos[2][4]; float rs[2][4];
#pragma unroll
        for (int m = 0; m < 4; ++m) { pos[0][m] = 128 * sb + i0 + 16 * m; const int q = 2048 - 128 * sb - i0 - 16 * m; pos[1][m] = (q == 2048) ? 1024 : q; }
        { int rws[2][4];
#pragma unroll
          for (int ai = 0; ai < 2; ++ai)
#pragma unroll
              for (int m = 0; m < 4; ++m) rws[ai][m] = brow0 + pos[ai][m];
          row_rstd8(stats, rws, fq, rs); }
        if (u.pn < 2) {
            const int lane = fq * 16 + fr, g = 2 * u.pn + (wc >> 1), ch0 = 32 * (wc & 1);
            const bool special = (sb == 0) && (i0 == 0);
            const bool spec_col = (ch0 == 0) && (fq == 0);
            PG8_LAS unsigned short* stg = (PG8_LAS unsigned short*)(lds + STAGE_BYTES + (wr * 4 + wc) * 2560);
            bf16_t* xt = XT2 + ((size_t)((b * 2 + u.pn) * 256 + 32 * wc) * 1024 + 128 * sb + wr * 64 + (lane & 7) * 8);
            float* tvg = Tv + (b * 512 + g * 128);
            f32x4 alt[2]; float alt64 = 0.f;
#pragma unroll
            for (int bj = 0; bj < 2; ++bj)
#pragma unroll
                for (int n = 0; n < 2; ++n) {
                    if (bj == 0) alt[n] = (f32x4){0.f, 0.f, 0.f, 0.f};
                    const bool sc = (bj == 1) && (n == 0) && spec_col;
                    const int cq = ch0 + 16 * n + 4 * fq;
#pragma unroll
                    for (int m = 0; m < 4; ++m) { const f32x4 a0 = acc[0][bj][m][n] * rs[0][m], a1 = acc[1][bj][m][n] * rs[1][m];
                        f32x4 v = (bj == 0) ? a0 + a1 : a0 - a1;
                        if (sc) v[0] = a0[0] + a1[0];
                        if (m == 0) { if (special) {
                            if (bj == 0) { *(f32x4*)(tvg + cq) = a1; v = a0; }
                            else { const float s0 = a0[0]; v = (f32x4){0.f, 0.f, 0.f, 0.f}; if (sc) { tvg[64] = a1[0]; v[0] = s0; } } } }
                        if (bj == 0) alt[n] += v; else if (sc) alt64 += v[0];
                        const unsigned w0 = cvt_pk_bf16(v[0], v[1]), w1 = cvt_pk_bf16(v[2], v[3]);
                        PG8_LAS unsigned short* p = stg + (4 * fq) * 80 + 16 * m + fr;
                        p[0] = (unsigned short)w0; p[80] = (unsigned short)(w0 >> 16); p[160] = (unsigned short)w1; p[240] = (unsigned short)(w1 >> 16); }
#pragma unroll
                    for (int i = 0; i < 2; ++i) { const int col = i * 8 + (lane >> 3);
                        const u32x4 w = *(const PG8_LAS u32x4*)(stg + col * 80 + (lane & 7) * 8);
                        *(u32x4*)(xt + (size_t)(bj * 128 + 16 * n + col) * 1024) = w; }
                    asm volatile("" ::: "memory"); __builtin_amdgcn_sched_barrier(0);
                }
            const float sg = (fr & 1) ? -1.0f : 1.0f;
            float* altg = ALTP + ((b * 16 + sb * 2 + wr) * 512 + g * 128);
#pragma unroll
            for (int n = 0; n < 3; ++n) { f32x4 a = (n < 2) ? alt[n < 2 ? n : 0] * sg : (f32x4){alt64 * sg, 0.f, 0.f, 0.f};
#pragma unroll
                for (int j = 0; j < 4; ++j) { float t = a[j];
                    t += __builtin_bit_cast(float, __builtin_amdgcn_update_dpp(0, __builtin_bit_cast(int, t), 0xB1, 0xf, 0xf, false));
                    t += __builtin_bit_cast(float, __builtin_amdgcn_update_dpp(0, __builtin_bit_cast(int, t), 0x4E, 0xf, 0xf, false));
                    t += __builtin_bit_cast(float, __builtin_amdgcn_update_dpp(0, __builtin_bit_cast(int, t), 0x141, 0xf, 0xf, false));
                    t += __builtin_bit_cast(float, __builtin_amdgcn_update_dpp(0, __builtin_bit_cast(int, t), 0x140, 0xf, 0xf, false));
                    a[j] = t; }
                if (fr == 0) {
                    if (n < 2) { const int cq = ch0 + 16 * n + 4 * fq; *(f32x4*)(altg + cq) = a; }
                    else if (spec_col) altg[64] = a[0]; } }
        } else { PG8_LAS const unsigned char* tbl = lds + WIN_TBL_OFF;
            if (u.pn < 4)      { head_path<0>(acc, Qb + (size_t)((u.pn - 2) * 4 + wc) * 64, 1024u, tbl, 8192u, rs, pos, brow0, fq); }
            else if (wc < 2)   { head_path<1>(acc, Kb + (size_t)wc * 64, 256u, tbl, 8448u, rs, pos, brow0, fq); }
            else               { head_path<2>(acc, Vb + (size_t)(wc - 2) * 64, 256u, tbl, 8448u, rs, pos, brow0, fq); } }
    }
};

struct EpiDft {
    static constexpr bool PERM = true, AFTER_DRAIN = false, PROBE_TWICE = false, ZFIRST = ZFIRST_OTHER;
    __device__ __forceinline__ EpiDft second() const { return *this; }
    bf16_t* __restrict__ O; const float* __restrict__ Tv; const float* __restrict__ ALTP;
    __device__ __forceinline__ void operator()(const f32x4 (&acc)[2][2][4][2], const Unit& u, int wr, int wc, int fr_in, int fq_in, PG8_LAS unsigned char*) const {
        int fr = fr_in, fq = fq_in; asm volatile("" : "+v"(fr), "+v"(fq));
        const int b = u.pm >> 3, kb = u.pm & 7, g = 2 * u.pn + (wc >> 1), c0 = 32 * (wc & 1) + 8 * fq, cc = g * 128 + c0;
        const bool sp = (c0 == 0);
        const float sc = 1.0f / 512.0f;
        const f32x4 t0 = *(const f32x4*)(Tv + b * 512 + cc) * sc, t1 = *(const f32x4*)(Tv + b * 512 + cc + 4) * sc;
        const float t64 = Tv[b * 512 + g * 128 + 64] * sc;
        const float sg = (fr & 1) ? -1.0f : 1.0f;
#pragma unroll
        for (int m = 0; m < 4; ++m) {
            const int k = 128 * kb + 64 * wr + 16 * m + fr;
            f32x4 q0 = acc[1][1][m][0]; const f32x4 q1 = acc[1][1][m][1];
            if (sp) q0[0] = 0.f;
            const f32x4 b0 = acc[0][0][m][0] + t0 * sg, b1 = acc[0][0][m][1] + t1 * sg;
            const f32x4 x0 = b0 - q0, x1 = b1 - q1, y0 = b0 + q0, y1 = b1 + q1;
            const float s64 = acc[0][1][m][0][0] + t64 * sg;
            f32x4 mk0 = y0, m20 = x0;
            if (sp) { mk0[0] = s64; m20[0] = s64; }
            f32x4 p20 = y0, p21 = y1, m21 = x1;
            int k2 = 2048 - k;
            if (k == 0) { k2 = 1024; f32x4 s0 = t0, s1 = t1; float sa = t64;
                for (int p = 0; p < 16; ++p) { s0 += *(const f32x4*)(ALTP + (b * 16 + p) * 512 + cc) * sc; s1 += *(const f32x4*)(ALTP + (b * 16 + p) * 512 + cc + 4) * sc; sa += ALTP[(b * 16 + p) * 512 + g * 128 + 64] * sc; }
                p20 = s0; p21 = s1; m20 = s0; m21 = s1; if (sp) m20[0] = sa; }
            u32x4 w; bf16_t* o1 = (bf16_t*)((char*)O + ((unsigned)(b * 2048 + k) * DM_ + (unsigned)cc) * 2u); bf16_t* o2 = (bf16_t*)((char*)O + ((unsigned)(b * 2048 + k2) * DM_ + (unsigned)cc) * 2u);
            w.x = cvt_pk_bf16(x0[0], x0[1]); w.y = cvt_pk_bf16(x0[2], x0[3]); w.z = cvt_pk_bf16(x1[0], x1[1]); w.w = cvt_pk_bf16(x1[2], x1[3]);
            *(u32x4*)o1 = w;
            w.x = cvt_pk_bf16(mk0[0], mk0[1]); w.y = cvt_pk_bf16(mk0[2], mk0[3]); w.z = cvt_pk_bf16(y1[0], y1[1]); w.w = cvt_pk_bf16(y1[2], y1[3]);
            *(u32x4*)(o1 + 64) = w;
            w.x = cvt_pk_bf16(p20[0], p20[1]); w.y = cvt_pk_bf16(p20[2], p20[3]); w.z = cvt_pk_bf16(p21[0], p21[1]); w.w = cvt_pk_bf16(p21[2], p21[3]);
            *(u32x4*)o2 = w;
            w.x = cvt_pk_bf16(m20[0], m20[1]); w.y = cvt_pk_bf16(m20[2], m20[3]); w.z = cvt_pk_bf16(m21[0], m21[1]); w.w = cvt_pk_bf16(m21[2], m21[3]);
            *(u32x4*)(o2 + 64) = w;
        }
    }
};

__device__ __forceinline__ void pg8_glds(const void* sbase, unsigned voff, unsigned lds_dst) {
#ifdef GLDS_M0_CLOBBER
    asm volatile("s_mov_b32 m0, %2\n\ts_nop 0\n\tglobal_load_lds_dwordx4 %0, %1" : : "v"(voff), "s"(sbase), "s"(lds_dst) : "memory", "m0");
#else
    unsigned keep; asm volatile("s_mov_b32 %0, m0\n\ts_mov_b32 m0, %3\n\ts_nop 0\n\tglobal_load_lds_dwordx4 %1, %2\n\ts_mov_b32 m0, %0" : "=&s"(keep) : "v"(voff), "s"(sbase), "s"(lds_dst) : "memory");
#endif
}
template <class Epi, class Sched, bool ALIGN_EPI = false, bool SP2 = false, bool AREV = false, int DIAG = 0, bool IMM = false, bool PF = false, int AAUX = 0>
__device__ __forceinline__ void gemm_phase(PG8_LAS unsigned char* lds, const Gemm g, const Sched& S, const Epi& E) {
    int tid_ = threadIdx.x; asm volatile("" : "+v"(tid_));
    const int tid = tid_, wid = __builtin_amdgcn_readfirstlane(tid >> 6), lane = tid & 63, wr = wid >> 2, wc = wid & 3, fr = lane & 15, fq = lane >> 4;
    const int K = g.K, nt = K / BK;
    unsigned voffA[2], voffB[2], voffA1[2];
#pragma unroll
    for (int i = 0; i < 2; ++i) { int R, C; stage_rc(tid * 16 + i * 8192, R, C); const int Rb = Epi::PERM ? ((R & ~31) + perm32(R & 31)) : R;
        voffA[i] = (unsigned)(R * K + C) * 2u; voffB[i] = (unsigned)(Rb * K + C) * 2u; voffA1[i] = AREV ? (unsigned)((1024 - R) * K + C) * 2u : voffA[i]; }
    const unsigned arev_th = 1024u * (unsigned)K * 2u;
    static_assert(!PF || (!AREV && !IMM && SP2), "PF: plain SP2 loop only");
    unsigned pf_dummy = 0u; const unsigned pf_voff = (unsigned)(((wid & 3) * 64 + lane) * K) * 2u;
    const bool pf_isB = wid >= 4;
    const size_t kstep = (size_t)(BK * 2);
    const int kr = S.krot(nt);
#define PG8_KO(t) ((size_t)(((t) + kr) >= nt ? ((t) + kr) - nt : ((t) + kr)) * kstep)
    const size_t hstep = (size_t)HALF * K * 2;
    const size_t tstep = 2 * hstep;
    const unsigned ldsw = (unsigned)wid * 1024u;
    const int aoff = lds_byte(wr * 64 + fr, fq * 8), boff = lds_byte(wc * 32 + fr, fq * 8);
#define PG8_SA(b, h) (((b) * 2 + (h)) * HTB)
#define PG8_SB(b, h) ((4 + (b) * 2 + (h)) * HTB)
#define PG8_STAGE(bufoff, gbase, voff) do { _Pragma("unroll") for (int _i = 0; _i < 2; ++_i) \
        pg8_glds((const void*)(gbase), (voff)[_i], (unsigned)(unsigned long)(lds + (bufoff) + ldsw + _i * 8192)); } while (0)
#define PG8_STAGE_A1(bufoff, gbase, spec) do { _Pragma("unroll") for (int _i = 0; _i < 2; ++_i) { unsigned _vo = voffA1[_i]; if (AREV) { if (spec) _vo = (_vo >= arev_th) ? _vo - arev_th : _vo; } \
        pg8_glds((const void*)(gbase), _vo, (unsigned)(unsigned long)(lds + (bufoff) + ldsw + _i * 8192)); } } while (0)
#define PG8_STAGEA(bufoff, gbase, voff) do { _Pragma("unroll") for (int _i = 0; _i < 2; ++_i) \
        pg8_glds((const void*)(gbase), (voff)[_i], (unsigned)(unsigned long)(lds + (bufoff) + ldsw + _i * 8192)); } while (0)
#ifndef B_AUX
#define B_AUX 0
#endif
#define PG8_STAGEB(bufoff, gbase, voff) do { _Pragma("unroll") for (int _i = 0; _i < 2; ++_i) \
        pg8_glds((const void*)(gbase), (voff)[_i], (unsigned)(unsigned long)(lds + (bufoff) + ldsw + _i * 8192)); } while (0)
#define PG8_LDA(dst, b, h) do { _Pragma("unroll") for (int m = 0; m < 4; ++m) _Pragma("unroll") for (int k = 0; k < 2; ++k) dst[m][k] = *(const PG8_LAS bf16x8*)(lds + PG8_SA(b, h) + aoff + m * 2048 + k * 1024); } while (0)
#define PG8_LDB(dst, b, h) do { _Pragma("unroll") for (int n = 0; n < 2; ++n) _Pragma("unroll") for (int k = 0; k < 2; ++k) dst[n][k] = *(const PG8_LAS bf16x8*)(lds + PG8_SB(b, h) + boff + n * 2048 + k * 1024); } while (0)
#define PG8_MMA(ai, bj, At, Bt) do { __builtin_amdgcn_s_setprio(1); _Pragma("unroll") for (int m = 0; m < 4; ++m) _Pragma("unroll") for (int n = 0; n < 2; ++n) _Pragma("unroll") for (int k = 0; k < 2; ++k) \
        acc[ai][bj][m][n] = __builtin_amdgcn_mfma_f32_16x16x32_bf16(Bt[n][k], At[m][k], acc[ai][bj][m][n], 0, 0, 0); __builtin_amdgcn_s_setprio(0); } while (0)
#define PG8_MMAZ(ai, bj, At, Bt) do { if (zf_) { __builtin_amdgcn_s_setprio(1); _Pragma("unroll") for (int m = 0; m < 4; ++m) _Pragma("unroll") for (int n = 0; n < 2; ++n) { \
        acc[ai][bj][m][n] = __builtin_amdgcn_mfma_f32_16x16x32_bf16(Bt[n][0], At[m][0], (f32x4){0.f, 0.f, 0.f, 0.f}, 0, 0, 0); acc[ai][bj][m][n] = __builtin_amdgcn_mfma_f32_16x16x32_bf16(Bt[n][1], At[m][1], acc[ai][bj][m][n], 0, 0, 0); } __builtin_amdgcn_s_setprio(0); } else PG8_MMA(ai, bj, At, Bt); } while (0)
#define PG8_STAGE1(bufoff, gbase, voff, i) pg8_glds((const void*)(gbase), (voff)[i], (unsigned)(unsigned long)(lds + (bufoff) + ldsw + (i) * 8192))
#define PG8_STAGE1_A1(bufoff, gbase, spec, i) do { unsigned _vo = voffA1[i]; if (AREV) { if (spec) _vo = (_vo >= arev_th) ? _vo - arev_th : _vo; } \
        pg8_glds((const void*)(gbase), _vo, (unsigned)(unsigned long)(lds + (bufoff) + ldsw + (i) * 8192)); } while (0)
#define PG8_MMA_H(ai, bj, At, Bt, HOOK) do { __builtin_amdgcn_s_setprio(1); _Pragma("unroll") for (int m = 0; m < 4; ++m) { _Pragma("unroll") for (int n = 0; n < 2; ++n) _Pragma("unroll") for (int k = 0; k < 2; ++k) \
        acc[ai][bj][m][n] = __builtin_amdgcn_mfma_f32_16x16x32_bf16(Bt[n][k], At[m][k], acc[ai][bj][m][n], 0, 0, 0); HOOK(m); __builtin_amdgcn_sched_barrier(0); } __builtin_amdgcn_s_setprio(0); } while (0)
#define PG8_WAIT_V(n) asm volatile("s_waitcnt vmcnt(" #n ")" ::: "memory")
#define PG8_WAIT_L(n) asm volatile("s_waitcnt lgkmcnt(" #n ")" ::: "memory")
#define PG8_BAR __builtin_amdgcn_s_barrier()
#define PG8_SCHED __builtin_amdgcn_sched_barrier(0)
    Unit cur, nxt; int ui = 0;
    if (!S.next(0, cur)) return;
    f32x4 acc[2][2][4][2];
#pragma unroll
    for (int a = 0; a < 2; ++a)
#pragma unroll
        for (int b = 0; b < 2; ++b)
#pragma unroll
            for (int m = 0; m < 4; ++m)
#pragma unroll
                for (int n = 0; n < 2; ++n) acc[a][b][m][n] = (f32x4){0.f, 0.f, 0.f, 0.f};
    bf16x8 At[4][2], B0[2][2], B1[2][2]; bool zl_ = false;
    const size_t rstep = (size_t)K * 2;
    const char* cA = (const char*)g.A + (size_t)cur.a0row * rstep; const char* cA1 = (const char*)g.A + (size_t)cur.a1row * rstep; const char* cB = (const char*)g.Bt + (size_t)cur.brow * tstep; int cspec = cur.spec;
    S.a_ready(cur);
    if constexpr (SP2) {
        PG8_STAGEB(PG8_SB(0, 0), cB + PG8_KO(0), voffB); PG8_STAGEB(PG8_SB(0, 1), cB + hstep + PG8_KO(0), voffB); PG8_STAGEA(PG8_SA(0, 0), cA + PG8_KO(0), voffA); PG8_STAGE_A1(PG8_SA(0, 1), cA1 + PG8_KO(0), cspec);
        if (wr == 1) PG8_BAR;
        PG8_WAIT_V(2); PG8_BAR;
        PG8_STAGEB(PG8_SB(1, 0), cB + PG8_KO(1), voffB); PG8_STAGEA(PG8_SA(1, 0), cA + PG8_KO(1), voffA); PG8_STAGEB(PG8_SB(1, 1), cB + hstep + PG8_KO(1), voffB);
        PG8_WAIT_V(6); PG8_BAR;
    } else {
        PG8_STAGEB(PG8_SB(0, 0), cB, voffB); PG8_STAGEA(PG8_SA(0, 0), cA, voffA); PG8_STAGEB(PG8_SB(0, 1), cB + hstep, voffB); PG8_STAGEA(PG8_SA(0, 1), cA + hstep, voffA);
        if (wr == 1) PG8_BAR;
        PG8_WAIT_V(4); PG8_BAR;
        PG8_STAGEB(PG8_SB(1, 0), cB + kstep, voffB); PG8_STAGEA(PG8_SA(1, 0), cA + kstep, voffA); PG8_STAGEB(PG8_SB(1, 1), cB + hstep + kstep, voffB);
        PG8_WAIT_V(6); PG8_BAR;
    }
    for (;;) {
        const bool has_next = S.next(ui + 1, nxt);
        const char* nA = has_next ? (const char*)g.A + (size_t)nxt.a0row * rstep : cA; const char* nA1 = has_next ? (const char*)g.A + (size_t)nxt.a1row * rstep : cA1; const char* nB = has_next ? (const char*)g.Bt + (size_t)nxt.brow * tstep : cB; const int nspec = has_next ? nxt.spec : cspec;
        for (int t = 0; t < nt; t += 2) {
            const bool last = (t == nt - 2); const bool zf_ = Epi::ZFIRST && (t == 0);
            const char* a1 = cA + PG8_KO(t + 1);
            const char* a2 = last ? nA + PG8_KO(0) : cA + PG8_KO(t + 2); const char* b2 = last ? nB + PG8_KO(0) : cB + PG8_KO(t + 2);
            const char* a3 = last ? nA + PG8_KO(1) : cA + PG8_KO(t + 3); const char* b3 = last ? nB + PG8_KO(1) : cB + PG8_KO(t + 3);
            const char* a1h = cA1 + PG8_KO(t + 1); const char* a2h = last ? nA1 + PG8_KO(0) : cA1 + PG8_KO(t + 2); const int spec2 = last ? nspec : cspec;
            if (last && has_next) S.a_ready(nxt);
            if constexpr (SP2 && IMM) {
#define H_NONE(m) do {} while (0)
#define H_SP1_A(m) do { if ((m) < 2) PG8_STAGE1_A1(PG8_SA(1, 1), a1h, cspec, (m)); } while (0)
#define H_SP1_B(m) do { if ((m) < 2) PG8_STAGE1_A1(PG8_SA(0, 1), a2h, spec2, (m)); } while (0)
#define H_SP2_A0(m) do { if ((m) < 2) PG8_STAGE1(PG8_SB(0, 0), b2, voffB, (m)); else PG8_STAGE1(PG8_SB(0, 1), b2 + hstep, voffB, (m) - 2); } while (0)
#define H_SP2_A1(m) do { if ((m) < 2) PG8_STAGE1(PG8_SA(0, 0), a2, voffA, (m)); } while (0)
#define H_SP2_B0(m) do { if ((m) < 2) PG8_STAGE1(PG8_SB(1, 0), b3, voffB, (m)); else PG8_STAGE1(PG8_SB(1, 1), b3 + hstep, voffB, (m) - 2); } while (0)
#define H_SP2_B1(m) do { if ((m) < 2) PG8_STAGE1(PG8_SA(1, 0), a3, voffA, (m)); } while (0)
#define H_SP2_AD(m) do { if ((m) == 0) { PG8_STAGE1(PG8_SB(0, 0), b2, voffB, 0); PG8_STAGE1(PG8_SB(0, 0), b2, voffB, 1); } else if ((m) == 1) { PG8_STAGE1(PG8_SB(0, 1), b2 + hstep, voffB, 0); PG8_STAGE1(PG8_SB(0, 1), b2 + hstep, voffB, 1); } else PG8_STAGE1(PG8_SA(0, 0), a2, voffA, (m) - 2); } while (0)
#define H_SP2_BD(m) do { if ((m) == 0) { PG8_STAGE1(PG8_SB(1, 0), b3, voffB, 0); PG8_STAGE1(PG8_SB(1, 0), b3, voffB, 1); } else if ((m) == 1) { PG8_STAGE1(PG8_SB(1, 1), b3 + hstep, voffB, 0); PG8_STAGE1(PG8_SB(1, 1), b3 + hstep, voffB, 1); } else PG8_STAGE1(PG8_SA(1, 0), a3, voffA, (m) - 2); } while (0)
            PG8_LDB(B0, 0, 0); PG8_LDB(B1, 0, 1); PG8_SCHED; PG8_LDA(At, 0, 0);
            PG8_WAIT_V(6); PG8_WAIT_L(0); PG8_BAR; PG8_MMA_H(0, 0, At, B0, H_SP1_A); if constexpr (!DIAG) PG8_MMA(0, 1, At, B1); PG8_BAR; PG8_SCHED;
            PG8_LDA(At, 0, 1);
            PG8_WAIT_V(2); PG8_WAIT_L(0); PG8_BAR; if constexpr (!DIAG) { PG8_MMA_H(1, 0, At, B0, H_SP2_A0); PG8_MMA_H(1, 1, At, B1, H_SP2_A1); } else { PG8_MMA_H(1, 1, At, B1, H_SP2_AD); } PG8_BAR; PG8_SCHED;
            PG8_LDB(B0, 1, 0); PG8_LDB(B1, 1, 1); PG8_SCHED; PG8_LDA(At, 1, 0);
            PG8_WAIT_V(6); PG8_WAIT_L(0); PG8_BAR; PG8_MMA_H(0, 0, At, B0, H_SP1_B); if constexpr (!DIAG) PG8_MMA(0, 1, At, B1); PG8_BAR; PG8_SCHED;
            PG8_LDA(At, 1, 1);
            PG8_WAIT_V(2); PG8_WAIT_L(0); PG8_BAR; if constexpr (!DIAG) { PG8_MMA_H(1, 0, At, B0, H_SP2_B0); PG8_MMA_H(1, 1, At, B1, H_SP2_B1); } else { PG8_MMA_H(1, 1, At, B1, H_SP2_BD); } PG8_BAR; PG8_SCHED;
            } else
            if constexpr (SP2) {
            if constexpr (PF) { const int t4 = t + 4; const char* pb = (t4 < nt) ? (pf_isB ? cB : cA) + PG8_KO(t4) : (pf_isB ? nB : nA) + PG8_KO(t4 - nt);
                asm volatile("s_nop 4\n\tglobal_load_dword %0, %1, %2" : "+v"(pf_dummy) : "v"(pf_voff), "s"(pb) : "memory"); }
            PG8_LDB(B0, 0, 0); PG8_LDB(B1, 0, 1); PG8_SCHED; PG8_LDA(At, 0, 0); PG8_STAGE_A1(PG8_SA(1, 1), a1h, cspec);
            if constexpr (!Epi::ZFIRST) { if (zl_) { zl_ = false;
                _Pragma("unroll") for (int a = 0; a < 2; ++a) _Pragma("unroll") for (int b = 0; b < 2; ++b) _Pragma("unroll") for (int m = 0; m < 4; ++m) _Pragma("unroll") for (int n = 0; n < 2; ++n) acc[a][b][m][n] = (f32x4){0.f, 0.f, 0.f, 0.f}; } }
            if constexpr (PF) PG8_WAIT_V(9); else PG8_WAIT_V(8); PG8_WAIT_L(0); PG8_BAR; PG8_MMAZ(0, 0, At, B0); if constexpr (DIAG != 1) PG8_MMAZ(0, 1, At, B1); PG8_BAR; PG8_SCHED;
            PG8_LDA(At, 0, 1); PG8_STAGEB(PG8_SB(0, 0), b2, voffB); PG8_STAGEB(PG8_SB(0, 1), b2 + hstep, voffB); PG8_STAGEA(PG8_SA(0, 0), a2, voffA);
            if constexpr (PF) PG8_WAIT_V(9); else PG8_WAIT_V(8); PG8_WAIT_L(0); PG8_BAR; if constexpr (DIAG == 0) PG8_MMAZ(1, 0, At, B0); PG8_MMAZ(1, 1, At, B1); PG8_BAR; PG8_SCHED;
            if constexpr (PF) { const int t5 = t + 5; const char* pb = (t5 < nt) ? (pf_isB ? cB : cA) + PG8_KO(t5) : (pf_isB ? nB : nA) + PG8_KO(t5 - nt);
                asm volatile("s_nop 4\n\tglobal_load_dword %0, %1, %2" : "+v"(pf_dummy) : "v"(pf_voff), "s"(pb) : "memory"); }
            PG8_LDB(B0, 1, 0); PG8_LDB(B1, 1, 1); PG8_SCHED; PG8_LDA(At, 1, 0); PG8_STAGE_A1(PG8_SA(0, 1), a2h, spec2);
            if constexpr (PF) PG8_WAIT_V(9); else PG8_WAIT_V(8); PG8_WAIT_L(0); PG8_BAR; PG8_MMA(0, 0, At, B0); if constexpr (DIAG != 1) PG8_MMA(0, 1, At, B1); PG8_BAR; PG8_SCHED;
            PG8_LDA(At, 1, 1); PG8_STAGEB(PG8_SB(1, 0), b3, voffB); PG8_STAGEB(PG8_SB(1, 1), b3 + hstep, voffB); PG8_STAGEA(PG8_SA(1, 0), a3, voffA);
            if constexpr (PF) PG8_WAIT_V(9); else PG8_WAIT_V(8); PG8_WAIT_L(0); PG8_BAR; if constexpr (DIAG == 0) PG8_MMA(1, 0, At, B0); PG8_MMA(1, 1, At, B1); PG8_BAR; PG8_SCHED;
            } else {
            PG8_LDB(B0, 0, 0); PG8_SCHED; PG8_LDA(At, 0, 0); PG8_STAGEA(PG8_SA(1, 1), a1 + hstep, voffA);
            PG8_WAIT_L(8); PG8_BAR; PG8_WAIT_L(0); PG8_MMA(0, 0, At, B0); PG8_BAR; PG8_SCHED;
            PG8_LDB(B1, 0, 1); PG8_STAGEB(PG8_SB(0, 0), b2, voffB);
            PG8_BAR; PG8_WAIT_L(0); PG8_MMA(0, 1, At, B1); PG8_BAR;
            PG8_LDA(At, 0, 1); PG8_STAGEA(PG8_SA(0, 0), a2, voffA);
            PG8_BAR; PG8_WAIT_L(0); PG8_MMA(1, 0, At, B0); PG8_BAR; PG8_SCHED;
            PG8_STAGEB(PG8_SB(0, 1), b2 + hstep, voffB);
            PG8_WAIT_V(6); PG8_BAR; PG8_MMA(1, 1, At, B1); PG8_BAR;
            PG8_LDB(B0, 1, 0); PG8_SCHED; PG8_LDA(At, 1, 0); PG8_STAGEA(PG8_SA(0, 1), a2 + hstep, voffA);
            PG8_WAIT_L(8); PG8_BAR; PG8_WAIT_L(0); PG8_MMA(0, 0, At, B0); PG8_BAR; PG8_SCHED;
            PG8_LDB(B1, 1, 1); PG8_STAGEB(PG8_SB(1, 0), b3, voffB);
            PG8_BAR; PG8_WAIT_L(0); PG8_MMA(0, 1, At, B1); PG8_BAR;
            PG8_LDA(At, 1, 1); PG8_STAGEA(PG8_SA(1, 0), a3, voffA);
            PG8_BAR; PG8_WAIT_L(0); PG8_MMA(1, 0, At, B0); PG8_BAR; PG8_SCHED;
            PG8_STAGEB(PG8_SB(1, 1), b3 + hstep, voffB);
            PG8_WAIT_V(6); PG8_BAR; PG8_MMA(1, 1, At, B1); PG8_BAR;
            }
        }
        if constexpr (ALIGN_EPI) { if (wr == 0) PG8_BAR; }
        if constexpr (!Epi::AFTER_DRAIN) { E(acc, cur, wr, wc, fr, fq, lds); if constexpr (Epi::PROBE_TWICE) { auto E2 = E.second(); E2(acc, cur, wr, wc, fr, fq, lds); } S.done(cur); }
        if (!has_next) break;
        zl_ = true;
        if constexpr (!(SP2 && !IMM))
#pragma unroll
        for (int a = 0; a < 2; ++a)
#pragma unroll
            for (int b = 0; b < 2; ++b)
#pragma unroll
                for (int m = 0; m < 4; ++m)
#pragma unroll
                    for (int n = 0; n < 2; ++n) acc[a][b][m][n] = (f32x4){0.f, 0.f, 0.f, 0.f};
        cur = nxt; cA = nA; cA1 = nA1; cB = nB; cspec = nspec; ++ui;
        if constexpr (ALIGN_EPI) { if (wr == 1) PG8_BAR; }
    }
    PG8_WAIT_V(0); asm volatile("" :: "v"(pf_dummy));
    if constexpr (!ALIGN_EPI) { if (wr == 0) PG8_BAR; }
    PG8_BAR;
    if constexpr (Epi::AFTER_DRAIN) { E.fused(acc, cur, wr, wc, fr, fq, lds, wid, lane); S.done(cur); }
#undef PG8_SA
#undef PG8_SB
#undef PG8_STAGE
#undef PG8_STAGE_A1
#undef PG8_KO
#undef PG8_LDA
#undef PG8_LDB
#undef PG8_MMA
#undef PG8_WAIT_V
#undef PG8_WAIT_L
#undef PG8_BAR
#undef PG8_SCHED
}
}
namespace attn_body {
using bf16=__hip_bfloat16;
using bf16x8=__attribute__((ext_vector_type(8)))short;
using s16x4=__attribute__((ext_vector_type(4)))short;
using f32x16=__attribute__((ext_vector_type(16)))float;
using u32x4=__attribute__((ext_vector_type(4)))unsigned;
constexpr int BATCH=16,NHEAD=8,SEQ=2048,D=64; constexpr int QP=512,KP=128,VP=128,OP=1024,OCOL=512;
constexpr int NW=8,QBLK=32,QB=QBLK*NW,KVBLK=64,NQB=SEQ/QB;
constexpr int ATTN_UNIT_ROWS=QB;
__device__ __forceinline__ int crow(int r,int hi){return (r&3)+8*(r>>2)+4*hi;}
#define SBAR() __builtin_amdgcn_sched_barrier(0)
__device__ __forceinline__ void cmask(f32x16&p0,f32x16&p1,int jb,int qrel,int hi){
  const float NEG=-INFINITY; int kb=64*jb+4*hi;
  #pragma unroll
  for(int r=0;r<16;++r){int kv=kb+(r&3)+8*(r>>2); if(kv>qrel)p0[r]=NEG; if(kv+32>qrel)p1[r]=NEG;}
}

constexpr int NSLOT=3, SLOTB=8192;
constexpr int LDS_K=0, LDS_V=NSLOT*SLOTB, LDS_WS=2*NSLOT*SLOTB, LDS_OST=LDS_WS+NW*64*4, LDS_BYTES=LDS_OST+NW*4096;
constexpr float C2=0.125f*1.4426950408889634f;
__device__ __forceinline__ void glds16(const void*gsrc,unsigned lds_dst){unsigned keep;
  asm volatile("s_mov_b32 %0, m0\n\ts_mov_b32 m0, %2\n\ts_nop 0\n\tglobal_load_lds_dwordx4 %1, off\n\ts_mov_b32 m0, %0":"=&s"(keep):"v"(gsrc),"s"(lds_dst):"memory");}
__device__ __forceinline__ float max3f(float a,float b,float c){float r;asm("v_max3_f32 %0, %1, %2, %3":"=v"(r):"v"(a),"v"(b),"v"(c));return r;}
__device__ __forceinline__ float max2f(float a,float b){float r;asm("v_max_f32_e32 %0, %1, %2":"=v"(r):"v"(a),"v"(b));return r;}
__device__ __forceinline__ float fadd_s(float a,float b){float r;asm("v_add_f32_e32 %0, %1, %2":"=v"(r):"v"(a),"v"(b));return r;}
__device__ __forceinline__ float fsub_s(float a,float b){float r;asm("v_sub_f32_e32 %0, %1, %2":"=v"(r):"v"(a),"v"(b));return r;}
typedef float f32x2_t __attribute__((ext_vector_type(2))); typedef __bf16 bf16x2_t __attribute__((ext_vector_type(2)));
__device__ __forceinline__ unsigned cvtpk_s(float lo,float hi){f32x2_t v={lo,hi};bf16x2_t b=__builtin_convertvector(v,bf16x2_t);return __builtin_bit_cast(unsigned,b);}
#define WAIT_BAR(N) asm volatile("s_waitcnt vmcnt(" #N ") lgkmcnt(0)\n\ts_barrier":::"memory")

__device__ __forceinline__ void qkt(f32x16&p0,f32x16&p1,const char*Kslot,const bf16x8*qr,const f32x16&negm,int r32,int hi){
  const char*kb=Kslot+hi*1024+r32*16;
  #pragma unroll
  for(int d0=0;d0<4;++d0){
    const bf16x8 b0=*reinterpret_cast<const bf16x8*>(kb+d0*2048);
    const bf16x8 b1=*reinterpret_cast<const bf16x8*>(kb+d0*2048+512);
    if(d0==0){p0=__builtin_amdgcn_mfma_f32_32x32x16_bf16(b0,qr[0],negm,0,0,0);p1=__builtin_amdgcn_mfma_f32_32x32x16_bf16(b1,qr[0],negm,0,0,0);}
    else{p0=__builtin_amdgcn_mfma_f32_32x32x16_bf16(b0,qr[d0],p0,0,0,0);p1=__builtin_amdgcn_mfma_f32_32x32x16_bf16(b1,qr[d0],p1,0,0,0);}}
}
typedef __attribute__((address_space(3))) const char* lds_cptr;
typedef short v4i16_t __attribute__((ext_vector_type(4)));
__device__ __forceinline__ void kload8(bf16x8*kf,lds_cptr kp){
  kf[0]=*(const __attribute__((address_space(3))) bf16x8*)(kp);      kf[1]=*(const __attribute__((address_space(3))) bf16x8*)(kp+512);
  kf[2]=*(const __attribute__((address_space(3))) bf16x8*)(kp+2048); kf[3]=*(const __attribute__((address_space(3))) bf16x8*)(kp+2560);
  kf[4]=*(const __attribute__((address_space(3))) bf16x8*)(kp+4096); kf[5]=*(const __attribute__((address_space(3))) bf16x8*)(kp+4608);
  kf[6]=*(const __attribute__((address_space(3))) bf16x8*)(kp+6144); kf[7]=*(const __attribute__((address_space(3))) bf16x8*)(kp+6656);
}
__device__ __forceinline__ void kload2(bf16x8*kf,lds_cptr kp,int j){ kf[2*j]=*(const __attribute__((address_space(3))) bf16x8*)(kp+j*2048); kf[2*j+1]=*(const __attribute__((address_space(3))) bf16x8*)(kp+j*2048+512); }
__device__ __forceinline__ s16x4 vtr(lds_cptr p){ return __builtin_bit_cast(s16x4,__builtin_amdgcn_ds_read_tr16_b64_v4i16((__attribute__((address_space(3))) v4i16_t*)p)); }
__device__ __forceinline__ float rowmax(const f32x16&p0,const f32x16&p1){
  float a=max3f(p0[0],p0[1],p1[0]),b=max3f(p0[2],p0[3],p1[1]);a=max3f(a,p1[2],p1[3]);
  #pragma unroll
  for(int r=4;r<16;r+=4){a=max3f(a,p0[r],p0[r+1]);b=max3f(b,p0[r+2],p0[r+3]);a=max3f(a,p1[r],p1[r+1]);b=max3f(b,p1[r+2],p1[r+3]);}
  const float m=max2f(a,b);
  auto rr=__builtin_amdgcn_permlane32_swap(__float_as_uint(m),__float_as_uint(m),false,false);
  return max2f(__uint_as_float(rr[0]),__uint_as_float(rr[1]));
}
__device__ __forceinline__ void pv(f32x16*o,int vb,bf16x8 pa0,bf16x8 pa1,bf16x8 pa2,bf16x8 pa3){
  #pragma unroll
  for(int d0=0;d0<2;++d0){s16x4 lo[4],hi[4];
    #pragma unroll
    for(int ks=0;ks<4;++ks){
      asm volatile("ds_read_b64_tr_b16 %0,%1 offset:%c2":"=&v"(lo[ks]):"v"(vb),"i"(d0*4096+ks*1024):"memory");
      asm volatile("ds_read_b64_tr_b16 %0,%1 offset:%c2":"=&v"(hi[ks]):"v"(vb),"i"(d0*4096+ks*1024+512):"memory");}
    asm volatile("s_waitcnt lgkmcnt(0)":::"memory");SBAR();
    #define PK(k) (bf16x8){lo[k][0],lo[k][1],lo[k][2],lo[k][3],hi[k][0],hi[k][1],hi[k][2],hi[k][3]}
    o[d0]=__builtin_amdgcn_mfma_f32_32x32x16_bf16(pa0,PK(0),o[d0],0,0,0);
    o[d0]=__builtin_amdgcn_mfma_f32_32x32x16_bf16(pa1,PK(1),o[d0],0,0,0);
    o[d0]=__builtin_amdgcn_mfma_f32_32x32x16_bf16(pa2,PK(2),o[d0],0,0,0);
    o[d0]=__builtin_amdgcn_mfma_f32_32x32x16_bf16(pa3,PK(3),o[d0],0,0,0);
    #undef PK
  }
}

#ifndef ATTN_STORE16
#define ATTN_STORE16(p,v) (*(u32x4*)(p)=(v))
#endif
template<int THRL> __device__ __forceinline__ void attn_unit(float coff,int b,int h,int qb,const bf16*Q,const bf16*__restrict__ K,const bf16*__restrict__ V,bf16*O,char*shm){
  int tid_=threadIdx.x; asm volatile("":"+v"(tid_)); const int tid=tid_,lane=tid&63,r32=lane&31,hi=lane>>5; const int wid=__builtin_amdgcn_readfirstlane(tid>>6);
  const long rowbase=(long)b*SEQ; const int q0=qb*QB;
  const bf16*Qw=Q+(rowbase+q0+wid*QBLK)*QP+h*D;
  const int kvh=h>>2; const bf16*Kh=K+rowbase*KP+kvh*D,*Vh=V+rowbase*VP+kvh*D;
  const unsigned lds0=(unsigned)(uintptr_t)shm;
  float*wsf=(float*)(shm+LDS_WS)+wid*64;
  const bf16*ksrc=Kh+(long)lane*KP+wid*8;
  const bf16*vsrc=Vh+(long)(16*(wid&3)+(lane>>2))*VP+(wid>>2)*32+(lane&3)*8;
  const unsigned kdst=lds0+LDS_K+wid*1024, vdst=lds0+LDS_V+wid*1024;
  #define DMA_K(t,slot) glds16(ksrc+(long)(t)*KVBLK*KP,(unsigned)__builtin_amdgcn_readfirstlane(kdst+(slot)))
  #define DMA_V(t,slot) glds16(vsrc+(long)(t)*KVBLK*VP,(unsigned)__builtin_amdgcn_readfirstlane(vdst+(slot)))
  const int vb0=(int)(lds0+LDS_V)+((lane>>4)&1)*32+(lane&3)*8+(4*hi+((lane&15)>>2))*64;
  const char*Kbase=shm+LDS_K; bf16x8 kf[8];
  const lds_cptr shm3=(lds_cptr)shm; const lds_cptr kp0=shm3+LDS_K+hi*1024+r32*16; const lds_cptr vp0=shm3+LDS_V+((lane>>4)&1)*32+(lane&3)*8+(4*hi+((lane&15)>>2))*64;
  const int NT=SEQ/KVBLK;
  DMA_K(0,0);DMA_V(0,0);DMA_K(1,SLOTB);
  bf16x8 qr[4];
  #pragma unroll
  for(int d0=0;d0<4;++d0)qr[d0]=*reinterpret_cast<const bf16x8*>(&Qw[(long)r32*QP+d0*16+hi*8]);
  float mhat=0.f,l_reg=0.f;f32x16 o[2];o[0]=f32x16{};o[1]=f32x16{};f32x16 negm=f32x16{};
#ifdef ATTN_NOMAX
  _Pragma("unroll") for(int r=0;r<16;++r)negm[r]=-coff;
#endif
  asm volatile("":"+v"(negm));
  const int qrel=wid*QBLK+r32;
  #define CMASK(P0,P1,t) do{}while(0)
  bool resc=false;
#ifdef ATTN_NOMAX
  #define START(P0,P1) do{ resc=false; _Pragma("unroll") for(int r=0;r<16;++r)P0[r]=__builtin_amdgcn_exp2f(P0[r]); }while(0)
#else
  #define START(P0,P1) do{ const float rm=rowmax(P0,P1); resc=false; \
    { const float dl=rm; mhat=fadd_s(mhat,dl); \
      _Pragma("unroll") for(int r=0;r<16;++r){P0[r]=fsub_s(P0[r],dl);P1[r]=fsub_s(P1[r],dl);} \
      _Pragma("unroll") for(int r=0;r<16;++r)negm[r]=-mhat; asm volatile("":"+v"(negm)); } \
    _Pragma("unroll") for(int r=0;r<16;++r)P0[r]=__builtin_amdgcn_exp2f(P0[r]); }while(0)
#endif
  #define RESC() do{ if(resc){ asm volatile("s_waitcnt lgkmcnt(0)":::"memory"); \
      _Pragma("unroll") for(int d_=0;d_<2;++d_) _Pragma("unroll") for(int r=0;r<16;++r)o[d_][r]*=wsf[crow(r,hi)]; } }while(0)
  f32x16 pA0,pA1,pB0,pB1;
  int sl_prev=0,sl_cur=0,sl_next=SLOTB;
  #define ROT() do{sl_prev=sl_cur;sl_cur=sl_next;sl_next=(sl_next==(NSLOT-1)*SLOTB)?0:sl_next+SLOTB;}while(0)
  DMA_K(2,2*SLOTB);
  WAIT_BAR(3);
  qkt(pA0,pA1,Kbase,qr,negm,r32,hi);asm volatile("s_nop 15\n\ts_nop 7":"+v"(pA0),"+v"(pA1));CMASK(pA0,pA1,0);
  START(pA0,pA1);
  _Pragma("unroll") for(int r=0;r<16;++r)pA1[r]=__builtin_amdgcn_exp2f(pA1[r]);
  WAIT_BAR(0);
  DMA_K(3,0);DMA_V(1,SLOTB);
  ROT();
  kload8(kf,kp0+sl_cur);
  WAIT_BAR(2);
  s16x4 vlo[8],vhi[8]; u32x4 pw0,pw1,pw2,pw3;
  #define PKW(P,B) cvtpk_s(P[B],P[B+1])
  #define PAF(k) __builtin_bit_cast(bf16x8,pw##k)
  #define VFR(i) (bf16x8){vlo[i][0],vlo[i][1],vlo[i][2],vlo[i][3],vhi[i][0],vhi[i][1],vhi[i][2],vhi[i][3]}
  #define PIN(x) asm volatile("":"+v"(x))
  #define MX3(a,b,c) __builtin_fmaxf(__builtin_fmaxf((a),(b)),(c))
  #define GAPA(MF,A0,A1,A2,A3,W0,W1,PW) do{ MF; sacc+=A0; sacc+=A1; sacc+=A2; sacc+=A3; PIN(sacc); W0; W1; PIN(PW); SBAR(); }while(0)
  #define EX(v) __builtin_amdgcn_exp2f(v)
  #define GAPB(MF,X,B) do{ MF; X[B]=EX(X[B]); X[B+1]=EX(X[B+1]); X[B+2]=EX(X[B+2]); X[B+3]=EX(X[B+3]); PIN(X); SBAR(); }while(0)
  #define VRD(i) do{ vlo[i]=vtr(vp_+(((i)>>2)*4096+((i)&3)*1024)); vhi[i]=vtr(vp_+(((i)>>2)*4096+((i)&3)*1024+512)); }while(0)
  #define KRD(G,j) do{ if(G){ kload2(kf,kp0+sl_next,j); SBAR(); } }while(0)
#ifdef ATTN_NOMAX
  #define MAXBLOCK(C0,C1) do{}while(0)
#else
  #define MAXBLOCK(C0,C1) do{ \
    { float a=MX3(C0[0],C0[1],C1[0]),b=MX3(C0[2],C0[3],C1[1]); a=MX3(a,C1[2],C1[3]); \
      _Pragma("unroll") for(int r=4;r<16;r+=4){a=MX3(a,C0[r],C0[r+1]);b=MX3(b,C0[r+2],C0[r+3]);a=MX3(a,C1[r],C1[r+1]);b=MX3(b,C1[r+2],C1[r+3]);} \
      float rm=__builtin_fmaxf(a,b); { auto rr=__builtin_amdgcn_permlane32_swap(__float_as_uint(rm),__float_as_uint(rm),false,false); rm=__builtin_fmaxf(__uint_as_float(rr[0]),__uint_as_float(rr[1])); } \
      resc=false; \
      if(__builtin_expect(__any(rm>(float)THRL),0)){ const float dl=__builtin_fmaxf(rm,0.f); mhat+=dl; \
        _Pragma("unroll") for(int r=0;r<16;++r){C0[r]-=dl;C1[r]-=dl;} \
        _Pragma("unroll") for(int r=0;r<16;++r)negm[r]=-mhat; asm volatile("":"+v"(negm)); \
        const float f=__builtin_amdgcn_exp2f(-dl); l_reg*=f; if(hi==0)wsf[r32]=f; resc=true; } } \
  }while(0)
#endif
  #define STEP(C0,C1,P0,P1,t,GK,GV,GL) do{ SBAR(); \
    const lds_cptr vp_=vp0+sl_prev; \
    VRD(0); SBAR(); float sacc=(P0[0]+P0[1]); \
    GAPA(C0=__builtin_amdgcn_mfma_f32_32x32x16_bf16(kf[0],qr[0],negm,0,0,0), P0[2],P0[3],P0[4],P0[5],     pw0[0]=PKW(P0,0), pw0[1]=PKW(P0,2), pw0); \
    VRD(4); SBAR(); GAPA(C1=__builtin_amdgcn_mfma_f32_32x32x16_bf16(kf[1],qr[0],negm,0,0,0), P0[6],P0[7],P0[8],P0[9],     pw0[2]=PKW(P0,4), pw0[3]=PKW(P0,6), pw0); \
    VRD(1); SBAR(); GAPA(C0=__builtin_amdgcn_mfma_f32_32x32x16_bf16(kf[2],qr[1],C0,0,0,0),   P0[10],P0[11],P0[12],P0[13], pw1[0]=PKW(P0,8), pw1[1]=PKW(P0,10), pw1); \
    VRD(5); SBAR(); GAPA(C1=__builtin_amdgcn_mfma_f32_32x32x16_bf16(kf[3],qr[1],C1,0,0,0),   P0[14],P0[15],P1[0],P1[1],   pw1[2]=PKW(P0,12),pw1[3]=PKW(P0,14), pw1); \
    VRD(2); SBAR(); GAPA(C0=__builtin_amdgcn_mfma_f32_32x32x16_bf16(kf[4],qr[2],C0,0,0,0),   P1[2],P1[3],P1[4],P1[5],     pw2[0]=PKW(P1,0), pw2[1]=PKW(P1,2), pw2); \
    VRD(6); SBAR(); GAPA(C1=__builtin_amdgcn_mfma_f32_32x32x16_bf16(kf[5],qr[2],C1,0,0,0),   P1[6],P1[7],P1[8],P1[9],     pw2[2]=PKW(P1,4), pw2[3]=PKW(P1,6), pw2); \
    VRD(3); SBAR(); GAPA(C0=__builtin_amdgcn_mfma_f32_32x32x16_bf16(kf[6],qr[3],C0,0,0,0),   P1[10],P1[11],P1[12],P1[13], pw3[0]=PKW(P1,8), pw3[1]=PKW(P1,10), pw3); \
    VRD(7); SBAR(); GAPA(C1=__builtin_amdgcn_mfma_f32_32x32x16_bf16(kf[7],qr[3],C1,0,0,0),   P1[14],P1[15],0.f,0.f,       pw3[2]=PKW(P1,12),pw3[3]=PKW(P1,14), pw3); \
    l_reg+=sacc; \
    if(GK){DMA_K((t)+3,sl_cur);} if(GV){DMA_V((t)+1,sl_next);} \
    CMASK(C0,C1,t); \
    MAXBLOCK(C0,C1); \
    SBAR(); \
    GAPB(o[0]=__builtin_amdgcn_mfma_f32_32x32x16_bf16(PAF(0),VFR(0),o[0],0,0,0), C0,0); \
    GAPB(o[1]=__builtin_amdgcn_mfma_f32_32x32x16_bf16(PAF(0),VFR(4),o[1],0,0,0), C0,4); \
    KRD(GL,0); GAPB(o[0]=__builtin_amdgcn_mfma_f32_32x32x16_bf16(PAF(1),VFR(1),o[0],0,0,0), C0,8); \
    KRD(GL,1); GAPB(o[1]=__builtin_amdgcn_mfma_f32_32x32x16_bf16(PAF(1),VFR(5),o[1],0,0,0), C0,12); \
    KRD(GL,2); GAPB(o[0]=__builtin_amdgcn_mfma_f32_32x32x16_bf16(PAF(2),VFR(2),o[0],0,0,0), C1,0); \
    KRD(GL,3); GAPB(o[1]=__builtin_amdgcn_mfma_f32_32x32x16_bf16(PAF(2),VFR(6),o[1],0,0,0), C1,4); \
    GAPB(o[0]=__builtin_amdgcn_mfma_f32_32x32x16_bf16(PAF(3),VFR(3),o[0],0,0,0), C1,8); \
    GAPB(o[1]=__builtin_amdgcn_mfma_f32_32x32x16_bf16(PAF(3),VFR(7),o[1],0,0,0), C1,12); \
    }while(0)
  int t=1;
  #undef CMASK
  #define CMASK(P0,P1,t) do{}while(0)
  for(;t+5<NT;t+=2){
    STEP(pB0,pB1,pA0,pA1,t,true,true,true);     WAIT_BAR(2); RESC(); ROT();
    STEP(pA0,pA1,pB0,pB1,t+1,true,true,true);   WAIT_BAR(2); RESC(); ROT();
  }
  #undef CMASK
  #define CMASK(P0,P1,t) do{}while(0)
  #define ENDW(tt) do{ if((tt)+3<NT){WAIT_BAR(2);} else if((tt)+2<NT){WAIT_BAR(1);} else {WAIT_BAR(0);} }while(0)
  for(;t+1<NT;t+=2){
    STEP(pB0,pB1,pA0,pA1,t,(t+3<NT),(t+1<NT),(t+1<NT));       ENDW(t);   RESC(); ROT();
    STEP(pA0,pA1,pB0,pB1,t+1,(t+4<NT),(t+2<NT),(t+2<NT));     ENDW(t+1); RESC(); ROT();
  }
  STEP(pB0,pB1,pA0,pA1,NT-1,false,false,false); RESC();
  { float sacc=pB0[0]+pB0[1]; _Pragma("unroll") for(int r=2;r<16;++r)sacc+=pB0[r]; _Pragma("unroll") for(int r=0;r<16;++r)sacc+=pB1[r]; l_reg+=sacc;
    pw0=(u32x4){PKW(pB0,0),PKW(pB0,2),PKW(pB0,4),PKW(pB0,6)};pw1=(u32x4){PKW(pB0,8),PKW(pB0,10),PKW(pB0,12),PKW(pB0,14)};pw2=(u32x4){PKW(pB1,0),PKW(pB1,2),PKW(pB1,4),PKW(pB1,6)};pw3=(u32x4){PKW(pB1,8),PKW(pB1,10),PKW(pB1,12),PKW(pB1,14)};
    SBAR(); pv(o,vb0+sl_cur,PAF(0),PAF(1),PAF(2),PAF(3)); }
  #undef PKW
  #undef PAF
  #undef VFR
  #undef PIN
  #undef MX3
  #undef GAPA
  #undef GAPB
  #undef EX
  #undef VRD
  #undef KRD
  #undef STEP
  #undef ENDW
  {auto rr=__builtin_amdgcn_permlane32_swap(__float_as_uint(l_reg),__float_as_uint(l_reg),false,false);l_reg=__uint_as_float(rr[0])+__uint_as_float(rr[1]);}
  if(hi==0)wsf[32+r32]=l_reg;asm volatile("s_waitcnt lgkmcnt(0)":::"memory");
  float rli[16];
  #pragma unroll
  for(int r=0;r<16;++r)rli[r]=__builtin_amdgcn_rcpf(wsf[32+crow(r,hi)]);
  bf16*Ow=O+(rowbase+q0+wid*QBLK)*OP+OCOL+h*D;
  { bf16*stg=(bf16*)(shm+LDS_OST)+wid*2048;
    #pragma unroll
    for(int r=0;r<16;++r){const int orow=crow(r,hi);
      #pragma unroll
      for(int d0=0;d0<2;++d0)stg[orow*64+d0*32+r32]=__float2bfloat16(o[d0][r]*rli[r]);}
    asm volatile("s_waitcnt lgkmcnt(0)":::"memory");
    #pragma unroll
    for(int i=0;i<4;++i){const int row=i*8+(lane>>3),ch=lane&7; const u32x4 v=*(const u32x4*)(stg+row*64+ch*8); ATTN_STORE16(Ow+(long)row*OP+ch*8,v);} }
  asm volatile("s_waitcnt lgkmcnt(0)\n\ts_barrier":::"memory");
  #undef DMA_K
  #undef DMA_V
  #undef CMASK
  #undef START
  #undef RESC
  #undef ROT
}
constexpr int ATTN_LDS_BYTES=LDS_BYTES;
struct AttnTensors { const bf16* Q; const bf16* K; const bf16* V; bf16* O; };
struct AttnUnit { int b, h, qb; };
struct AttnOrder {
  int vcu, G;
  __device__ __forceinline__ AttnOrder(int grid,int v):vcu(v),G(grid){}
  __device__ __forceinline__ bool next(int i,AttnUnit&u)const{ const int L=i*G+vcu; if(L>=1024)return false; const int hq=L>>8, rem=L&255, grp=rem>>3; u.qb=rem&7; u.b=grp>>1; u.h=(grp&1)*4+hq; return true; }
  __device__ __forceinline__ void a_ready(const AttnUnit&)const{}
  __device__ __forceinline__ void done(const AttnUnit&)const{}
};
template<class Sched,int THRL=8> __device__ __forceinline__ void attn_phase(char*lds,const AttnTensors&T,const Sched&S,float coff){
  AttnUnit u;
  for(int i=0;S.next(i,u);++i){ S.a_ready(u); attn_unit<THRL>(coff,u.b,u.h,u.qb,T.Q,T.K,T.V,T.O,lds); S.done(u); }
}
#undef SBAR
#undef WAIT_BAR
}
#define GAS __attribute__((address_space(1)))
#define LAS __attribute__((address_space(3)))
typedef unsigned short bf16;
typedef unsigned v4u __attribute__((ext_vector_type(4)));
typedef float f32x4 __attribute__((ext_vector_type(4)));
typedef short bf16x8 __attribute__((ext_vector_type(8)));
typedef GAS unsigned gu32;
typedef GAS unsigned long long gu64;
#define RLX_AGENT __ATOMIC_RELAXED, __HIP_MEMORY_SCOPE_AGENT
#define LDS_WAIT() asm volatile("s_waitcnt lgkmcnt(0)" ::: "memory")
#define VM_WAIT() asm volatile("s_waitcnt vmcnt(0)" ::: "memory")
__device__ __forceinline__ unsigned long long rt() { return __builtin_amdgcn_s_memrealtime(); }
__device__ __forceinline__ unsigned f2bf(float f) { unsigned u = __builtin_bit_cast(unsigned, f); return (u + 0x7fffu + ((u >> 16) & 1u)) >> 16; }
__device__ __forceinline__ unsigned pk2(float lo, float hi) { return f2bf(lo) | (f2bf(hi) << 16); }

#define XB_TMO      128
#define XB_XCNT(j)  (256  + 64 * (j))
#define XB_XSUB(j)  (1280 + 64 * (j))
#define XB_XGEN(j)  (2304 + 64 * (j))
#define XB_TOP      3328
#define XB_TOPGEN   3392
#define XCD_BAR_WORDS 3456
#define XB_SPIN_CAP (1u << 18)

__device__ __forceinline__ unsigned xb_ld(unsigned* p)              { return __hip_atomic_load(p, __ATOMIC_RELAXED, __HIP_MEMORY_SCOPE_AGENT); }
__device__ __forceinline__ unsigned xb_add(unsigned* p, unsigned v) { return __hip_atomic_fetch_add(p, v, __ATOMIC_RELAXED, __HIP_MEMORY_SCOPE_AGENT); }
__device__ __forceinline__ unsigned xb_xcc_id() { return (unsigned)__builtin_amdgcn_s_getreg((3 << 11) | 20) & 0xFu; }
#define XB_SPIN(cond, bar) do { unsigned _sp = 0; while (cond) { __builtin_amdgcn_s_sleep(1); \
    if ((++_sp & 255u) == 0u) { if (xb_ld(&(bar)[XB_TMO])) break; if (_sp > XB_SPIN_CAP) { atomicAdd(&(bar)[XB_TMO], 1u); break; } } } } while (0)

struct XcdBarrier {
    unsigned* bar; unsigned x;
    volatile LAS unsigned* st;
};

__device__ __forceinline__ XcdBarrier xcd_barrier_post(unsigned* bar, volatile LAS unsigned* st) {
    XcdBarrier b; b.bar = bar; b.x = xb_xcc_id(); b.st = st;
    if (threadIdx.x == 0) (void)xb_add(&bar[XB_XCNT(b.x)], 1u);
    return b;
}
__device__ __forceinline__ void xcd_barrier_complete(unsigned* bar, unsigned x, unsigned& nloc, unsigned& nx) {
    const unsigned G = gridDim.x * gridDim.y * gridDim.z;
    unsigned sum, cnt, mine, sp = 0u;
    for (;;) {
        sum = 0u; cnt = 0u; mine = 0u;
#pragma unroll
        for (unsigned j = 0; j < 16; ++j) { const unsigned c = xb_ld(&bar[XB_XCNT(j)]); sum += c; cnt += (c > 0u) ? 1u : 0u; mine = (j == x) ? c : mine; }
        if (sum == G) break;
        __builtin_amdgcn_s_sleep(1);
        if ((++sp & 255u) == 0u) { if (xb_ld(&bar[XB_TMO])) break; if (sp > XB_SPIN_CAP) { atomicAdd(&bar[XB_TMO], 1u); break; } }
    }
    nloc = mine > 0u ? mine : 1u; nx = cnt > 0u ? cnt : 1u;
}

__device__ __forceinline__ void xcd_barrier(const XcdBarrier& b) {
    asm volatile("s_waitcnt vmcnt(0)" ::: "memory");
    __syncthreads();
    if (threadIdx.x == 0) {
        unsigned* bar = b.bar;
        __builtin_amdgcn_s_waitcnt(0);
        unsigned nloc = b.st[0], nx = b.st[1];
        if (nloc == 0u) { xcd_barrier_complete(bar, b.x, nloc, nx); b.st[0] = nloc; b.st[1] = nx; }
        const unsigned old = xb_add(&bar[XB_XSUB(b.x)], 1u);
        const unsigned gen = old / nloc;
        if (old + 1u == (gen + 1u) * nloc) {
            __builtin_amdgcn_fence(__ATOMIC_RELEASE, "agent");
            asm volatile("s_waitcnt vmcnt(0)" ::: "memory");
            const unsigned og = xb_add(&bar[XB_TOP], 1u);
            const unsigned tg = og / nx;
            if (og + 1u == (tg + 1u) * nx) xb_add(&bar[XB_TOPGEN], 1u);
            else XB_SPIN(xb_ld(&bar[XB_TOPGEN]) == tg, bar);
            __builtin_amdgcn_fence(__ATOMIC_ACQUIRE, "agent");
            xb_add(&bar[XB_XGEN(b.x)], 1u);
            asm volatile("s_waitcnt vmcnt(0)" ::: "memory");
        } else {
            __builtin_amdgcn_fence(__ATOMIC_ACQUIRE, "agent");
            XB_SPIN(xb_ld(&bar[XB_XGEN(b.x)]) == gen, bar);
            asm volatile("s_waitcnt vmcnt(0)" ::: "memory");
        }
    }
    __syncthreads();
}

constexpr int NWAVES = 8;
#ifndef MK_N_LAUNCHES
#define MK_N_LAUNCHES 1
#endif
#ifndef PHASE_MASK
#define PHASE_MASK 0x1ff
#endif
#define PH_ON(k) ((PHASE_MASK >> (k)) & 1)
constexpr int N_PHASES = 8;
constexpr int N_LAUNCHES = MK_N_LAUNCHES;
static_assert(N_LAUNCHES == 1 || N_LAUNCHES == N_PHASES, "MK_N_LAUNCHES is 1 or 8");

constexpr int BATCH = 16, SEQ = 2048, DM = 1024, M = BATCH * SEQ, DFF = 2752, DFFP = 2816, NGU = 2 * DFFP, NIN = 1280, INW = 1280;
constexpr size_t MiB = 1u << 20;
constexpr size_t WS_CTL = 0, CTL_ZERO_BYTES = 128 * 1024;
constexpr size_t WS_W1 = 2 * MiB, WS_WD1 = 13 * MiB, WS_W2 = 19 * MiB, WS_WD2 = 30 * MiB, WS_WIN = 36 * MiB, WS_WOUT = 40 * MiB, WS_DFT = 42 * MiB;
constexpr size_t WS_MISC = 58 * MiB;
constexpr size_t WS_STATS = 59 * MiB;
constexpr size_t WS_XB = 67 * MiB;
constexpr size_t WS_ACT = 131 * MiB;
constexpr size_t WS_XT = 131 * MiB, WS_Q = 195 * MiB, WS_K = 227 * MiB, WS_V = 235 * MiB, WS_MIX = 243 * MiB;
constexpr size_t WS_X1 = 307 * MiB;
constexpr size_t WS_END = 435 * MiB;
static_assert(WS_W1 + (size_t)NGU * DM * 2 <= WS_WD1 && WS_WD1 + (size_t)DM * DFFP * 2 <= WS_W2 && WS_W2 + (size_t)NGU * DM * 2 <= WS_WD2 && WS_WD2 + (size_t)DM * DFFP * 2 <= WS_WIN, "ws map 1");
static_assert(WS_WIN + (size_t)NIN * DM * 2 <= WS_WOUT && WS_WOUT + (size_t)DM * DM * 2 <= WS_DFT && WS_DFT + (size_t)2048 * 4096 * 2 <= WS_MISC && WS_STATS + 4 * (size_t)M * 16 * 4 <= WS_XB, "ws map 2");
static_assert(WS_XB + (size_t)M * DM * 2 <= WS_ACT && WS_ACT + (size_t)M * DFFP * 2 <= WS_X1 && WS_XT + (size_t)BATCH * 4 * 256 * 1024 * 2 <= WS_Q && WS_Q + (size_t)M * 512 * 2 <= WS_K, "ws map 3");
static_assert(WS_K + (size_t)M * 128 * 2 <= WS_V && WS_V + (size_t)M * 128 * 2 <= WS_MIX && WS_MIX + (size_t)M * DM * 2 <= WS_X1 && WS_X1 + (size_t)M * DM * 4 <= WS_END, "ws map 4");
constexpr int CW_BAR = 4096;
constexpr int CW_SEAM = 16384;
constexpr int RING_BYTES = 131072;
constexpr int EPI_STAGE_BYTES = 8 * 2560;
constexpr int LDSCTL_OFF = RING_BYTES + EPI_STAGE_BYTES, MISC_OFF = LDSCTL_OFF + 320;
constexpr int LDS_BYTES = 163840;
static_assert(MISC_OFF + 128 <= pg8::WIN_TBL_OFF && pg8::WIN_TBL_OFF + 8704 <= LDS_BYTES && pg8::STAGE_BYTES == RING_BYTES && attn_body::ATTN_LDS_BYTES <= RING_BYTES, "LDS map");

template <int CTRL> __device__ __forceinline__ float dpp_mov(float v) { return __builtin_bit_cast(float, __builtin_amdgcn_update_dpp(0, __builtin_bit_cast(int, v), CTRL, 0xf, 0xf, false)); }
__device__ __forceinline__ float wave_sum(float v) {
    v += dpp_mov<0xB1>(v);
    v += dpp_mov<0x4E>(v);
    v += dpp_mov<0x141>(v);
    v += dpp_mov<0x140>(v);
    return pg8::xsum32(pg8::xsum16(v));
}
__device__ __forceinline__ float wave_max(float v) {
    v = fmaxf(v, dpp_mov<0xB1>(v)); v = fmaxf(v, dpp_mov<0x4E>(v)); v = fmaxf(v, dpp_mov<0x141>(v)); v = fmaxf(v, dpp_mov<0x140>(v));
    { const auto r = __builtin_amdgcn_permlane16_swap(__float_as_uint(v), __float_as_uint(v), false, false); const unsigned r0 = r[0], r1 = r[1]; v = fmaxf(__uint_as_float(r0), __uint_as_float(r1)); }
    { const auto r = __builtin_amdgcn_permlane32_swap(__float_as_uint(v), __float_as_uint(v), false, false); const unsigned r0 = r[0], r1 = r[1]; v = fmaxf(__uint_as_float(r0), __uint_as_float(r1)); }
    return v;
}
__device__ __forceinline__ void p0_transpose_item(const float* __restrict__ W, int N, int k0, int n0, bf16* __restrict__ dst, int ldk, const float* __restrict__ gain, LAS float* scr, int lane) {
    const int kk = lane >> 3, nq = lane & 7;
    f32x4 v[8];
#pragma unroll
    for (int i = 0; i < 8; ++i) v[i] = __builtin_nontemporal_load((const f32x4*)(W + (size_t)(k0 + 8 * i + kk) * N + n0 + 4 * nq));
#pragma unroll
    for (int i = 0; i < 8; ++i) { const float gsc = gain ? gain[k0 + 8 * i + kk] : 1.0f; LAS float* p = scr + (8 * i + kk) * 33 + 4 * nq;
        p[0] = v[i][0] * gsc; p[1] = v[i][1] * gsc; p[2] = v[i][2] * gsc; p[3] = v[i][3] * gsc; }
    LDS_WAIT(); asm volatile("" ::: "memory");
    const int c = lane & 7;
#pragma unroll
    for (int j = 0; j < 4; ++j) { const int n = (lane >> 3) + 8 * j; const LAS float* s = scr + (8 * c) * 33 + n;
        v4u o; o.x = pk2(s[0 * 33], s[1 * 33]); o.y = pk2(s[2 * 33], s[3 * 33]); o.z = pk2(s[4 * 33], s[5 * 33]); o.w = pk2(s[6 * 33], s[7 * 33]);
        *(v4u*)(dst + (size_t)n * ldk + k0 + 8 * c) = o; }
    LDS_WAIT(); asm volatile("" ::: "memory");
}

struct Args { const float* in[17]; float* out; unsigned char* ws; int ph_lo, ph_hi, li, pad; };

__global__ void __launch_bounds__(NWAVES * 64, 2) mk_fwd(Args args) {
    extern __shared__ __attribute__((aligned(16))) unsigned char lds[];
    LAS unsigned char* const ldsp = (LAS unsigned char*)lds;
    volatile LAS unsigned* const MISC = (volatile LAS unsigned*)(ldsp + MISC_OFF);
    const int tid0 = threadIdx.x;
    gu32* const ctl = (gu32*)(args.ws + WS_CTL);
    for (int u = tid0; u < (LDS_BYTES - LDSCTL_OFF) / 4; u += NWAVES * 64) ((LAS unsigned*)(ldsp + LDSCTL_OFF))[u] = 0u;
    __syncthreads();
    XcdBarrier bar; bar.bar = (unsigned*)(ctl + CW_BAR); bar.x = 0; bar.st = nullptr;
    if (N_LAUNCHES == 1) bar = xcd_barrier_post((unsigned*)(ctl + CW_BAR), MISC + 8);
#ifndef PROBE_BAR2
#define PROBE_BAR2 0
#endif
#define GRID_BAR() do { if (N_LAUNCHES == 1) { xcd_barrier(bar); if (PROBE_BAR2) xcd_barrier(bar); } } while (0)
    const int lo = args.ph_lo, hi = args.ph_hi;

#ifndef PROBE_REPEAT
#define PROBE_REPEAT 0
#endif
    for (int ph2 = 2 * lo; ph2 < 2 * hi; ++ph2) {
        const int ph = ph2 >> 1;
        if ((ph2 & 1) && !((PROBE_REPEAT >> ph) & 1)) continue;
        const __attribute__((address_space(4))) Args* ap = (const __attribute__((address_space(4))) Args*)__builtin_amdgcn_kernarg_segment_ptr(); asm volatile("" : "+s"(ap));
        int tid_ = threadIdx.x; asm volatile("" : "+v"(tid_));
        int G = gridDim.x, bx = blockIdx.x; asm volatile("" : "+s"(G), "+s"(bx));
        const int vcu = (G % 8 == 0) ? (bx % 8) * (G / 8) + bx / 8 : bx, NGW = G * NWAVES;
        const bool late_ok = (G == 256);
        const int tid = tid_, lane = tid & 63, wave = __builtin_amdgcn_readfirstlane(tid >> 6), gw = vcu * NWAVES + wave;
        unsigned char* const ws = ap->ws;
        const float* const x = ap->in[0];
        const float* const g_ffn1 = ap->in[1]; const float* const w_gate1 = ap->in[2]; const float* const w_up1 = ap->in[3]; const float* const w_down1 = ap->in[4];
        const float* const g_mix = ap->in[5]; const float* const w_in = ap->in[6]; const float* const fnet_w = ap->in[7]; const float* const fnet_b = ap->in[8];
        const float* const q_norm = ap->in[9]; const float* const k_norm = ap->in[10]; const float* const w_out = ap->in[11];
        const float* const g_ffn2 = ap->in[12]; const float* const w_gate2 = ap->in[13]; const float* const w_up2 = ap->in[14]; const float* const w_down2 = ap->in[15];
        const float* const g_final = ap->in[16];
        float* const out = ap->out;
        bf16* const W1 = (bf16*)(ws + WS_W1); bf16* const WD1 = (bf16*)(ws + WS_WD1); bf16* const W2 = (bf16*)(ws + WS_W2); bf16* const WD2 = (bf16*)(ws + WS_WD2);
        bf16* const WIN = (bf16*)(ws + WS_WIN); bf16* const WOUT = (bf16*)(ws + WS_WOUT); bf16* const DFT = (bf16*)(ws + WS_DFT);
        float* const BIASP = (float*)(ws + WS_MISC); float* const ROPEC = (float*)(ws + WS_MISC + 4096); float* const ROPES = (float*)(ws + WS_MISC + 8192); float* const TV = (float*)(ws + WS_MISC + 16384); float* const ALTP = (float*)(ws + WS_MISC + 65536);
        float* const ST1 = (float*)(ws + WS_STATS); float* const ST2 = ST1 + (size_t)M * 16; float* const ST3 = ST2 + (size_t)M * 16; float* const ST4 = ST3 + (size_t)M * 16;
        bf16* const XB = (bf16*)(ws + WS_XB); bf16* const ACT = (bf16*)(ws + WS_ACT); bf16* const XT = (bf16*)(ws + WS_XT);
        bf16* const QB_ = (bf16*)(ws + WS_Q); bf16* const KB_ = (bf16*)(ws + WS_K); bf16* const VB_ = (bf16*)(ws + WS_V); bf16* const MIX = (bf16*)(ws + WS_MIX);
        float* const X1 = (float*)(ws + WS_X1);

#ifdef PROBE_CLOCK
        unsigned long long pc_t0 = 0, pc_r0 = 0;
        if (ph == PROBE_CLOCK) { pc_t0 = __builtin_amdgcn_s_memtime(); pc_r0 = __builtin_amdgcn_s_memrealtime(); }
#endif
        if (ph == 0 && PH_ON(0)) {
            LAS float* scr = (LAS float*)(ldsp + wave * 16384);
            const int gw0 = wave * G + bx;
            const int n1_ = 2752 * (late_ok ? 1 : 2), n2_ = 1376 * (late_ok ? 1 : 2);
            const int o2_ = n1_ % NGW, o3_ = (o2_ + n2_) % NGW, o4_ = (o3_ + 384) % NGW, o5_ = (o4_ + 1024) % NGW;
#define ROT_START(off) ((gw0 + NGW - (off)) % NGW)
            for (int it = 2752 * 0 + gw0; it < 2752 * (late_ok ? 1 : 2); it += NGW) {
                const int f = it / 2752, r = it % 2752, mat = r / 1376, r2 = r % 1376, kb = r2 / 86, nb = r2 % 86, n0 = nb * 32;
                const int drow = 256 * (n0 >> 7) + (n0 & 127) + 128 * mat;
                const float* Wsrc = f ? (mat ? w_up2 : w_gate2) : (mat ? w_up1 : w_gate1);
                p0_transpose_item(Wsrc, DFF, kb * 64, n0, (f ? W2 : W1) + (size_t)drow * DM, DM, f ? g_ffn2 : g_ffn1, scr, lane);
            }
            for (int it = ROT_START(o2_); it < 1376 * (late_ok ? 1 : 2); it += NGW) {
                const int f = it / 1376, r = it % 1376, kb = r / 32, nb = r % 32;
                p0_transpose_item(f ? w_down2 : w_down1, DM, kb * 64, nb * 32, (f ? WD2 : WD1) + (size_t)(nb * 32) * DFFP, DFFP, nullptr, scr, lane);
            }
            unsigned zz = 0u; asm volatile("" : "+v"(zz)); const v4u zero4 = {zz, zz, zz, zz};
            for (int it = ROT_START(o5_); it < 256 * (late_ok ? 1 : 2); it += NGW) {
                const int f = it >> 8, r = (it >> 1) & 127, hh = it & 1; const int row = 256 * 21 + 64 + (r & 63) + 128 * (r >> 6);
                *(v4u*)((f ? W2 : W1) + (size_t)row * DM + hh * 512 + lane * 8) = zero4;
            }
            for (int it = ROT_START(o5_); it < 128 * (late_ok ? 1 : 2); it += NGW) {
                const int f = it >> 7, row = (it & 127) * 8 + (lane >> 3);
                *(v4u*)((f ? WD2 : WD1) + (size_t)row * DFFP + DFF + (lane & 7) * 8) = zero4;
            }
            for (int it = ROT_START(o3_); it < 384; it += NGW) {
                const int kb = it / 24, blk = it % 24, bjj = blk & 1; int drow;
                if (blk < 16) { const int head = blk >> 1; drow = 256 * (2 + (head >> 2)) + 128 * bjj + 32 * (head & 3); }
                else if (blk < 20) { drow = 1024 + 128 * bjj + 32 * ((blk - 16) >> 1); }
                else { drow = 1024 + 128 * bjj + 32 * (2 + ((blk - 20) >> 1)); }
                p0_transpose_item(w_in, INW, kb * 64, 512 + 32 * blk, WIN + (size_t)drow * DM, DM, g_mix, scr, lane);
            }
            if (!late_ok) {
            for (int it = gw0; it < 256; it += NGW) {
                const int kb = 8 + it / 32, nb = it % 32;
                p0_transpose_item(w_out, DM, kb * 64, nb * 32, WOUT + (size_t)(nb * 32) * DM, DM, nullptr, scr, lane);
            }
            for (int it = gw0; it < 1024; it += NGW) {
                const int g = it >> 8, cb = (it >> 4) & 15, n = (it & 15) * 64 + lane;
                LAS float* Fl = scr;
                { const int r = lane >> 3, d0 = (lane & 7) * 16, ps = cb * 8 + r; const float* fp = fnet_w + (size_t)(g * 128 + (ps <= 64 ? ps : 192 - ps) - r) * 128;
                  f32x4 f4[4];
#pragma unroll
                  for (int e = 0; e < 4; ++e) f4[e] = *(const f32x4*)(fp + r * 128 + d0 + 4 * e);
#pragma unroll
                  for (int e = 0; e < 4; ++e)
#pragma unroll
                      for (int j = 0; j < 4; ++j) Fl[(d0 + 4 * e + j) * 8 + r] = f4[e][j]; }
                LDS_WAIT(); asm volatile("" ::: "memory");
                float a[8];
#pragma unroll
                for (int cc = 0; cc < 8; ++cc) a[cc] = 0.f;
                const float* wo = w_out + (size_t)(g * 128) * DM + n;
                for (int d = 0; d < 128; d += 16) {
                    float bq[16];
#pragma unroll
                    for (int e = 0; e < 16; ++e) bq[e] = wo[(size_t)(d + e) * DM];
#pragma unroll
                    for (int e = 0; e < 16; ++e) { const f32x4 fa = *(const LAS f32x4*)(Fl + (d + e) * 8), fb = *(const LAS f32x4*)(Fl + (d + e) * 8 + 4);
#pragma unroll
                        for (int cc = 0; cc < 4; ++cc) { a[cc] += fa[cc] * bq[e]; a[4 + cc] += fb[cc] * bq[e]; } }
                }
                v4u o; o.x = pk2(a[0], a[1]); o.y = pk2(a[2], a[3]); o.z = pk2(a[4], a[5]); o.w = pk2(a[6], a[7]);
                *(v4u*)(WOUT + (size_t)n * DM + g * 128 + cb * 8) = o;
                LDS_WAIT(); asm volatile("" ::: "memory");
            }
            for (int it = gw0; it < 128; it += NGW) {
                f32x4 p0 = {0.f, 0.f, 0.f, 0.f}, p1 = {0.f, 0.f, 0.f, 0.f}; f32x4 wv[8][2]; float fb[8];
#pragma unroll
                for (int i = 0; i < 8; ++i) { const int r = lane + 64 * i; fb[i] = fnet_b[r]; wv[i][0] = *(const f32x4*)(w_out + (size_t)r * DM + it * 8); wv[i][1] = *(const f32x4*)(w_out + (size_t)r * DM + it * 8 + 4); }
#pragma unroll
                for (int i = 0; i < 8; ++i) { p0 += wv[i][0] * fb[i]; p1 += wv[i][1] * fb[i]; }
                float o8[8];
#pragma unroll
                for (int j = 0; j < 4; ++j) { o8[j] = wave_sum(p0[j]); o8[4 + j] = wave_sum(p1[j]); }
                if (lane == 0) { *(f32x4*)(BIASP + it * 8) = (f32x4){o8[0], o8[1], o8[2], o8[3]}; *(f32x4*)(BIASP + it * 8 + 4) = (f32x4){o8[4], o8[5], o8[6], o8[7]}; }
            }
            }
            for (int it = ROT_START(o4_); it < 1024; it += NGW) {
                const int kb8 = it >> 3, g = (it >> 1) & 3, q = it & 1, c = lane; const bool spec = q && (lane == 0);
                LAS float* T = scr;
                LAS float* Wl = scr + 256;
                { const float a0 = (float)lane * (1.0f / 64.0f), a1 = (float)(lane + 64) * (1.0f / 64.0f); T[lane] = q ? sinpif(a0) : cospif(a0); T[lane + 64] = q ? sinpif(a1) : cospif(a1); }
                { const int r = lane >> 3, c0 = (lane & 7) * 16; const float* wp = w_in + (size_t)(kb8 * 8 + r) * INW + g * 128 + c0; const float gk = g_mix[kb8 * 8 + r];
                  f32x4 w4[4];
#pragma unroll
                  for (int e = 0; e < 4; ++e) w4[e] = *(const f32x4*)(wp + 4 * e);
#pragma unroll
                  for (int e = 0; e < 4; ++e)
#pragma unroll
                      for (int j = 0; j < 4; ++j) Wl[(c0 + 4 * e + j) * 8 + r] = w4[e][j] * gk; }
                LDS_WAIT(); asm volatile("" ::: "memory");
                float ac[8];
#pragma unroll
                for (int kk = 0; kk < 8; ++kk) ac[kk] = 0.f;
#pragma unroll 4
                for (int cp = 0; cp < 128; ++cp) {
                    const f32x4 wa = *(const LAS f32x4*)(Wl + cp * 8), wb = *(const LAS f32x4*)(Wl + cp * 8 + 4);
                    const float tt = T[(cp * c) & 127]; const float t = spec ? ((cp & 1) ? -1.0f : 1.0f) : tt;
#pragma unroll
                    for (int kk = 0; kk < 4; ++kk) { ac[kk] += wa[kk] * t; ac[4 + kk] += wb[kk] * t; }
                }
                v4u o; o.x = pk2(ac[0], ac[1]); o.y = pk2(ac[2], ac[3]); o.z = pk2(ac[4], ac[5]); o.w = pk2(ac[6], ac[7]);
                *(v4u*)(WIN + (size_t)((g >> 1) * 256 + q * 128 + (g & 1) * 64 + c) * DM + kb8 * 8) = o;
                LDS_WAIT(); asm volatile("" ::: "memory");
            }
            if (!late_ok) {
            for (int it = gw0; it < 4096; it += NGW) {
                const int row = it >> 1, hh = it & 1, kb = row >> 8, r = row & 255, k = 128 * kb + (r & 127), n0 = hh * 512 + lane * 8; float v[8];
#pragma unroll
                for (int e = 0; e < 8; ++e) { const float ph_ = (float)((k * (n0 + e)) & 2047) * (1.0f / 1024.0f); v[e] = (r < 128 ? cospif(ph_) : sinpif(ph_)) * (1.0f / 512.0f); }
                v4u o; o.x = pk2(v[0], v[1]); o.y = pk2(v[2], v[3]); o.z = pk2(v[4], v[5]); o.w = pk2(v[6], v[7]);
                *(v4u*)(DFT + (size_t)row * 1024 + n0) = o;
            }
            }
            if (gw0 == 0) {
#pragma unroll
                for (int e = 0; e < 16; ++e) { const float inv = powf(10000.0f, -(float)(2 * e) / 32.0f); const float ang = (float)lane * inv; ROPEC[lane * 16 + e] = cosf(ang); ROPES[lane * 16 + e] = sinf(ang); }
            }
            for (int m0 = gw0 * 4; m0 < M; m0 += NGW * 4) {
                f32x4 v[4][4];
#pragma unroll
                for (int r = 0; r < 4; ++r)
#pragma unroll
                    for (int j = 0; j < 4; ++j) v[r][j] = __builtin_nontemporal_load((const f32x4*)(x + (size_t)(m0 + r) * DM) + lane + 64 * j);
#pragma unroll
                for (int r = 0; r < 4; ++r) { float s = 0.f;
#pragma unroll
                    for (int j = 0; j < 4; ++j) s += (v[r][j][0] * v[r][j][0] + v[r][j][1] * v[r][j][1]) + (v[r][j][2] * v[r][j][2] + v[r][j][3] * v[r][j][3]);
                    s = wave_sum(s);
                    unsigned long long* o8 = (unsigned long long*)(XB + (size_t)(m0 + r) * DM) + lane;
#pragma unroll
                    for (int j = 0; j < 4; ++j) o8[64 * j] = (unsigned long long)pk2(v[r][j][0], v[r][j][1]) | ((unsigned long long)pk2(v[r][j][2], v[r][j][3]) << 32);
                    if (lane < 16) ST1[(size_t)(m0 + r) * 16 + lane] = s * (1.0f / 16.0f); }
            }
            __syncthreads();
        } else if ((ph == 1 || ph == 6) && PH_ON(1)) {
#ifndef GEMM_KROT
#define GEMM_KROT 0
#endif
#ifndef PROBE_HALFCU
#define PROBE_HALFCU 0
#endif
            ((LAS unsigned*)(ldsp + pg8::WIN_TBL_OFF + 4096))[tid >> 6] = 0u;
            pg8::Gemm g{XB, ph == 1 ? W1 : W2, M, NGU, DM}; pg8::StaticOrder S; S.init(M, NGU, G, bx); S.rot = GEMM_KROT;
            if (PROBE_HALFCU && ph == 1) { if ((bx >> 3) & 1) S.init(M, 0, G, bx); else S.init(M, NGU, G / 2, (bx & 7) + 8 * (bx >> 4)); }
            pg8::EpiSwiGLU E{ACT, ph == 1 ? ST1 : ST3, ph != 1};
            #ifndef SWIGLU_SP2
#define SWIGLU_SP2 true
#endif
#ifndef GEMM_IMM
#define GEMM_IMM false
#endif
            #ifndef SWIGLU_ALIGN
#define SWIGLU_ALIGN true
#endif
            #ifndef GEMM_PF
#define GEMM_PF false
#endif
            pg8::gemm_phase<pg8::EpiSwiGLU, pg8::StaticOrder, SWIGLU_ALIGN, SWIGLU_SP2, false, false, GEMM_IMM, GEMM_PF>(ldsp, g, S, E);
        } else if ((ph == 2 || ph == 5) && PH_ON(2)) {
            pg8::Gemm g{ph == 5 ? MIX : ACT, ph == 2 ? WD1 : WOUT, M, DM, ph == 5 ? DM : DFFP}; pg8::StaticOrder S; S.init(M, DM, G, bx);
#ifndef REV_MASK
#define REV_MASK 0
#endif
            S.rev = (REV_MASK >> ph) & 1;
            pg8::EpiResid E{XB, ph == 2 ? ST2 : ST3, ph == 5 ? BIASP : (const float*)nullptr, ph == 5 ? 1.0f : 0.5f, ph == 5};
            pg8::gemm_phase<pg8::EpiResid, pg8::StaticOrder, true, true>(ldsp, g, S, E);
        } else if (ph == 3 && PH_ON(3)) {
            { LAS float* tb = (LAS float*)(ldsp + pg8::WIN_TBL_OFF);
              for (int i = tid; i < 1024; i += NWAVES * 64) { tb[i] = ROPEC[i]; tb[1024 + i] = ROPES[i]; }
              if (tid < 64) tb[2048 + tid] = q_norm[tid]; else if (tid < 128) tb[2112 + tid - 64] = k_norm[tid - 64];
              __syncthreads(); }
            pg8::Gemm g{XB, WIN, M, NIN, DM}; pg8::StaticOrder S; S.init(M, NIN, G, bx); S.mode = 1;
            pg8::EpiWin E{ST2, XT, TV, ALTP, QB_, KB_, VB_, q_norm, k_norm, ROPEC, ROPES};
            pg8::gemm_phase<pg8::EpiWin, pg8::StaticOrder, true, true, true, false>(ldsp, g, S, E);
            if (late_ok && 2 * G + bx >= 640) {
                LAS float* scr = (LAS float*)(ldsp + wave * 16384);
                const int gwi = (bx - 128) * NWAVES + wave, ngwi = 128 * NWAVES;
            for (int it = gwi; it < 4096; it += ngwi) {
                const int row = it >> 1, hh = it & 1, kb = row >> 8, r = row & 255, k = 128 * kb + (r & 127), n0 = hh * 512 + lane * 8; float v[8];
#pragma unroll
                for (int e = 0; e < 8; ++e) { const float ph_ = (float)((k * (n0 + e)) & 2047) * (1.0f / 1024.0f); v[e] = (r < 128 ? cospif(ph_) : sinpif(ph_)) * (1.0f / 512.0f); }
                v4u o; o.x = pk2(v[0], v[1]); o.y = pk2(v[2], v[3]); o.z = pk2(v[4], v[5]); o.w = pk2(v[6], v[7]);
                *(v4u*)(DFT + (size_t)row * 1024 + n0) = o;
            }
            for (int it = 2752 * 1 + gwi; it < 2752 * 2; it += ngwi) {
                const int f = it / 2752, r = it % 2752, mat = r / 1376, r2 = r % 1376, kb = r2 / 86, nb = r2 % 86, n0 = nb * 32;
                const int drow = 256 * (n0 >> 7) + (n0 & 127) + 128 * mat;
                const float* Wsrc = f ? (mat ? w_up2 : w_gate2) : (mat ? w_up1 : w_gate1);
                p0_transpose_item(Wsrc, DFF, kb * 64, n0, (f ? W2 : W1) + (size_t)drow * DM, DM, f ? g_ffn2 : g_ffn1, scr, lane);
            }
            for (int it = 1376 * 1 + gwi; it < 1376 * 2; it += ngwi) {
                const int f = it / 1376, r = it % 1376, kb = r / 32, nb = r % 32;
                p0_transpose_item(f ? w_down2 : w_down1, DM, kb * 64, nb * 32, (f ? WD2 : WD1) + (size_t)(nb * 32) * DFFP, DFFP, nullptr, scr, lane);
            }
            unsigned zz = 0u; asm volatile("" : "+v"(zz)); const v4u zero4 = {zz, zz, zz, zz};
            for (int it = 256 * 1 + gwi; it < 256 * 2; it += ngwi) {
                const int f = it >> 8, r = (it >> 1) & 127, hh = it & 1; const int row = 256 * 21 + 64 + (r & 63) + 128 * (r >> 6);
                *(v4u*)((f ? W2 : W1) + (size_t)row * DM + hh * 512 + lane * 8) = zero4;
            }
            for (int it = 128 * 1 + gwi; it < 128 * 2; it += ngwi) {
                const int f = it >> 7, row = (it & 127) * 8 + (lane >> 3);
                *(v4u*)((f ? WD2 : WD1) + (size_t)row * DFFP + DFF + (lane & 7) * 8) = zero4;
            }
            for (int it = gwi; it < 256; it += ngwi) {
                const int kb = 8 + it / 32, nb = it % 32;
                p0_transpose_item(w_out, DM, kb * 64, nb * 32, WOUT + (size_t)(nb * 32) * DM, DM, nullptr, scr, lane);
            }
            for (int it = gwi; it < 1024; it += ngwi) {
                const int g = it >> 8, cb = (it >> 4) & 15, n = (it & 15) * 64 + lane;
                LAS float* Fl = scr;
                { const int r = lane >> 3, d0 = (lane & 7) * 16, ps = cb * 8 + r; const float* fp = fnet_w + (size_t)(g * 128 + (ps <= 64 ? ps : 192 - ps) - r) * 128;
                  f32x4 f4[4];
#pragma unroll
                  for (int e = 0; e < 4; ++e) f4[e] = *(const f32x4*)(fp + r * 128 + d0 + 4 * e);
#pragma unroll
                  for (int e = 0; e < 4; ++e)
#pragma unroll
                      for (int j = 0; j < 4; ++j) Fl[(d0 + 4 * e + j) * 8 + r] = f4[e][j]; }
                LDS_WAIT(); asm volatile("" ::: "memory");
                float a[8];
#pragma unroll
                for (int cc = 0; cc < 8; ++cc) a[cc] = 0.f;
                const float* wo = w_out + (size_t)(g * 128) * DM + n;
                for (int d = 0; d < 128; d += 16) {
                    float bq[16];
#pragma unroll
                    for (int e = 0; e < 16; ++e) bq[e] = wo[(size_t)(d + e) * DM];
#pragma unroll
                    for (int e = 0; e < 16; ++e) { const f32x4 fa = *(const LAS f32x4*)(Fl + (d + e) * 8), fb = *(const LAS f32x4*)(Fl + (d + e) * 8 + 4);
#pragma unroll
                        for (int cc = 0; cc < 4; ++cc) { a[cc] += fa[cc] * bq[e]; a[4 + cc] += fb[cc] * bq[e]; } }
                }
                v4u o; o.x = pk2(a[0], a[1]); o.y = pk2(a[2], a[3]); o.z = pk2(a[4], a[5]); o.w = pk2(a[6], a[7]);
                *(v4u*)(WOUT + (size_t)n * DM + g * 128 + cb * 8) = o;
                LDS_WAIT(); asm volatile("" ::: "memory");
            }
            for (int it = gwi; it < 128; it += ngwi) {
                f32x4 p0 = {0.f, 0.f, 0.f, 0.f}, p1 = {0.f, 0.f, 0.f, 0.f}; f32x4 wv[8][2]; float fb[8];
#pragma unroll
                for (int i = 0; i < 8; ++i) { const int r = lane + 64 * i; fb[i] = fnet_b[r]; wv[i][0] = *(const f32x4*)(w_out + (size_t)r * DM + it * 8); wv[i][1] = *(const f32x4*)(w_out + (size_t)r * DM + it * 8 + 4); }
#pragma unroll
                for (int i = 0; i < 8; ++i) { p0 += wv[i][0] * fb[i]; p1 += wv[i][1] * fb[i]; }
                float o8[8];
#pragma unroll
                for (int j = 0; j < 4; ++j) { o8[j] = wave_sum(p0[j]); o8[4 + j] = wave_sum(p1[j]); }
                if (lane == 0) { *(f32x4*)(BIASP + it * 8) = (f32x4){o8[0], o8[1], o8[2], o8[3]}; *(f32x4*)(BIASP + it * 8 + 4) = (f32x4){o8[4], o8[5], o8[6], o8[7]}; }
            }
            }
        } else if (ph == 4 && PH_ON(4)) {
#ifndef PROBE_SUB
#define PROBE_SUB 0
#endif
#ifndef P4_SWAP
#define P4_SWAP 0
#endif
            const bool attn_first = P4_SWAP && ((vcu >> 3) & 1);
            for (int step = 0; step < 2; ++step) {
                if ((step == 0) != attn_first) {
                    for (int rep_ = 0; rep_ < 1 + (PROBE_SUB & 1); ++rep_) {
                        pg8::Gemm g{DFT, XT, M, 512, 1024}; pg8::StaticOrder S; S.init(M, 512, G, bx); S.mode = 2;
                        pg8::EpiDft E{MIX, TV, ALTP};
                        pg8::gemm_phase<pg8::EpiDft, pg8::StaticOrder, true, true, false, 2>(ldsp, g, S, E);
                    }
                } else {
                    for (int rep_ = 0; rep_ < 1 + ((PROBE_SUB >> 1) & 1); ++rep_) {
                        const attn_body::AttnTensors AT{(const attn_body::bf16*)QB_, (const attn_body::bf16*)KB_, (const attn_body::bf16*)VB_, (attn_body::bf16*)MIX};
                        const attn_body::AttnOrder S(G, vcu);
                        float gq = fabsf(q_norm[lane]), gk = fabsf(k_norm[lane]);
                        gq = wave_max(gq); gk = wave_max(gk);
                        const float coff = 8.0f * 1.4426950408889634f * gq * gk;
                        attn_body::attn_phase<attn_body::AttnOrder>((char*)lds, AT, S, coff);
                    }
                }
            }
        } else if (ph == 7 && PH_ON(7)) {
            pg8::Gemm g{ACT, WD2, M, DM, DFFP}; pg8::StaticOrder S; S.init(M, DM, G, bx);
            S.rev = (REV_MASK >> 7) & 1;
            pg8::EpiFinal E{XB, ST4, (unsigned*)(ctl + CW_SEAM), g_final, out, 0.5f};
            pg8::gemm_phase<pg8::EpiFinal, pg8::StaticOrder, true, true>(ldsp, g, S, E);
        }
#ifdef PROBE_CLOCK
        if (ph == PROBE_CLOCK) { const unsigned long long t1 = __builtin_amdgcn_s_memtime(), r1 = __builtin_amdgcn_s_memrealtime();
            if (bx == 0 && tid == 0) { const unsigned long long mhz = (t1 - pc_t0) * 100ull / (r1 - pc_r0); MISC[16] = (unsigned)mhz; } }
#endif
#ifdef PROBE_SKEW
        if (ph == PROBE_SKEW && tid == 0) { ((unsigned long long*)(ap->ws + WS_MISC + 786432))[bx] = __builtin_amdgcn_s_memrealtime(); }
        if (ph == PROBE_SKEW + 1 && bx == 0 && tid == 0) {
#if defined(PROBE_SKEW_XCD)
            unsigned long long base = ~0ull; for (int i = 0; i < G; ++i) { const unsigned long long v = ((volatile unsigned long long*)(ap->ws + WS_MISC + 786432))[i]; base = v < base ? v : base; }
            unsigned long long mnm = ~0ull, mxm = 0ull; for (int x = 0; x < 8; ++x) { unsigned long long s = 0; for (int i = x; i < G; i += 8) s += ((volatile unsigned long long*)(ap->ws + WS_MISC + 786432))[i] - base; s /= (unsigned long long)(G / 8); mnm = s < mnm ? s : mnm; mxm = s > mxm ? s : mxm; }
#if defined(PROBE_SKEW_ID)
            { int slow = 0, fast = 0; unsigned long long smx = 0, smn = ~0ull; for (int x = 0; x < 8; ++x) { unsigned long long s = 0; for (int i = x; i < G; i += 8) s += ((volatile unsigned long long*)(ap->ws + WS_MISC + 786432))[i] - base; if (s > smx) { smx = s; slow = x; } if (s < smn) { smn = s; fast = x; } }
              MISC[16] = (unsigned)((slow * 8 + fast) * 5000) + (unsigned)((mxm - mnm) > 4999 ? 4999 : (mxm - mnm)); }
#else
            MISC[16] = (unsigned)(mxm - mnm);
#endif
#else
            unsigned long long mn = ~0ull, mx = 0ull; for (int i = 0; i < G; ++i) { const unsigned long long v = ((volatile unsigned long long*)(ap->ws + WS_MISC + 786432))[i]; mn = v < mn ? v : mn; mx = v > mx ? v : mx; } MISC[16] = (unsigned)(mx - mn);
#endif
        }
#endif
        if (ph2 + 1 < 2 * hi && !(!(ph2 & 1) && ph + 1 == hi && !((PROBE_REPEAT >> ph) & 1))) GRID_BAR();
    }
#undef GRID_BAR
#ifdef PROBE_SKEW
    if (blockIdx.x == 0 && threadIdx.x == 0) { const unsigned sk = MISC[16]; const unsigned long long r0 = __builtin_amdgcn_s_memrealtime(); const unsigned long long ticks = (unsigned long long)sk * 20ull;
        while (__builtin_amdgcn_s_memrealtime() - r0 < ticks) __builtin_amdgcn_s_sleep(8); }
#endif
#ifdef PROBE_CLOCK
    if (blockIdx.x == 0 && threadIdx.x == 0) { const unsigned mhz = MISC[16]; const unsigned long long r0 = __builtin_amdgcn_s_memrealtime(); const unsigned long long ticks = (unsigned long long)(mhz / 4u) * 100ull;
        while (__builtin_amdgcn_s_memrealtime() - r0 < ticks) __builtin_amdgcn_s_sleep(8); }
#endif
}

extern "C" void kernel_launch(void* const* d_in, const int* in_sizes, int n_in, void* d_out, int out_size, void* d_ws, size_t ws_size, hipStream_t stream) {
    static int grid = 0;
    if (grid == 0) {
        if (n_in != 17 || in_sizes[0] != M * DM || out_size != M * DM || ws_size < WS_END) { fprintf(stderr, "kernel_launch: unexpected shapes (n_in %d, in0 %d, out %d, ws %zu); nothing launched\n", n_in, n_in > 0 ? in_sizes[0] : -1, out_size, ws_size); grid = -1; return; }
        int dev = 0, cus = 0, per_cu = 0;
        if (hipGetDevice(&dev) != hipSuccess || hipDeviceGetAttribute(&cus, hipDeviceAttributeMultiprocessorCount, dev) != hipSuccess) { fprintf(stderr, "kernel_launch: device query failed\n"); grid = -1; return; }
        if (hipFuncSetAttribute((const void*)mk_fwd, hipFuncAttributeMaxDynamicSharedMemorySize, LDS_BYTES) != hipSuccess) { fprintf(stderr, "kernel_launch: hipFuncSetAttribute failed\n"); grid = -1; return; }
        if (hipOccupancyMaxActiveBlocksPerMultiprocessor(&per_cu, (const void*)mk_fwd, NWAVES * 64, LDS_BYTES) != hipSuccess || per_cu < 1) { fprintf(stderr, "kernel_launch: occupancy query reports %d workgroups per CU\n", per_cu); per_cu = 1; }
        (void)hipGetLastError();
        grid = cus;
    }
    if (grid < 0) return;
    if (hipMemsetAsync((char*)d_ws + WS_CTL, 0, CTL_ZERO_BYTES, stream) != hipSuccess) { fprintf(stderr, "kernel_launch: hipMemsetAsync failed\n"); return; }
    Args a{};
    for (int i = 0; i < 17; ++i) a.in[i] = (const float*)d_in[i];
    a.out = (float*)d_out; a.ws = (unsigned char*)d_ws;
    for (int li = 0; li < N_LAUNCHES; ++li) {
        a.ph_lo = (N_LAUNCHES == 1) ? 0 : li; a.ph_hi = (N_LAUNCHES == 1) ? N_PHASES : li + 1; a.li = li;
        hipLaunchKernelGGL(mk_fwd, dim3(grid), dim3(NWAVES * 64), LDS_BYTES, stream, a);
        const hipError_t le = hipPeekAtLastError();
        if (le != hipSuccess) { fprintf(stderr, "kernel_launch: launch %d failed: %s\n", li, hipGetErrorName(le)); break; }
    }
}
```

```cpp
#ifndef ATTN_RUNNING_MAX
#define ATTN_NOMAX 1
#endif
#include <hip/hip_runtime.h>
#include <hip/hip_bf16.h>
#include <cstdio>
#include <cstdint>
#include <cmath>
#define ZFIRST_SWIGLU true
#define REV_MASK 0x84
namespace pg8 {
#define PG8_LAS __attribute__((address_space(3)))
typedef unsigned short bf16_t;
typedef short bf16x8 __attribute__((ext_vector_type(8)));
typedef float f32x4 __attribute__((ext_vector_type(4)));
typedef unsigned u32x4 __attribute__((ext_vector_type(4)));
constexpr int BM = 256, BK = 64, HALF = 128, HTB = HALF * BK * 2  , STAGE_BYTES = 8 * HTB, NXCD = 8;
#ifndef WGM_OVERRIDE
#define WGM_OVERRIDE 8
#endif
constexpr int WGM = WGM_OVERRIDE;

__host__ __device__ __forceinline__ int lds_byte(int r, int c) { const int st = (r >> 4) * 2 + (c >> 5), rr = r & 15, cc = c & 31, ob = rr * 64 + cc * 2; return st * 1024 + (ob ^ (((ob >> 9) & 1) << 5)); }
__host__ __device__ __forceinline__ void stage_rc(int b, int& R, int& C) { const int st = b / 1024, sb = b % 1024, swz = sb ^ (((sb >> 9) & 1) << 5); R = (st >> 1) * 16 + swz / 64; C = (st & 1) * 32 + (swz % 64) / 2; }
__host__ __device__ __forceinline__ int perm32(int rho) { const int n = rho >> 4, i = rho & 15; return 8 * (i >> 2) + 4 * n + (i & 3); }

struct Unit { int pm, pn, a0row, a1row, brow, spec; };
struct Gemm { const bf16_t* A; const bf16_t* Bt; int M, N, K; };

struct StaticOrder {
    int rev;
    int nM, nN, nwg, G, c, mode, rot;
    __host__ __device__ void init(int M, int N, int G_, int c_) { nM = M / BM; nN = N / BM; nwg = nM * nN; G = G_; c = c_; mode = 0; rot = 0; rev = 0; }
    __host__ __device__ bool next(int i, Unit& u) const {
        const long L = (long)i * G + c; if (L >= nwg) return false;
        int wgid = (int)L; { const int q = nwg / NXCD, r = nwg % NXCD, xcd = wgid % NXCD, off = wgid / NXCD; const int cntx = (xcd < r) ? q + 1 : q; wgid = (xcd < r ? xcd * (q + 1) : r * (q + 1) + (xcd - r) * q) + (rev ? cntx - 1 - off : off); }
        const int nig = WGM * nN, gid = wgid / nig, fm = gid * WGM, gsz = (nM - fm) < WGM ? (nM - fm) : WGM;
        u.pm = fm + ((wgid % nig) % gsz); u.pn = (wgid % nig) / gsz;
        if (mode == 1) { const int b = u.pm >> 3, sb = u.pm & 7; u.a0row = b * 2048 + 128 * sb; u.a1row = b * 2048 + 1024 - 128 * sb; u.brow = u.pn; u.spec = (sb == 0); }
        else if (mode == 2) { u.a0row = 256 * (u.pm & 7); u.a1row = u.a0row + 128; u.brow = (u.pm >> 3) * 2 + u.pn; u.spec = 0; }
        else { u.a0row = 256 * u.pm; u.a1row = u.a0row + 128; u.brow = u.pn; u.spec = 0; }
        return true;
    }
    __device__ __forceinline__ int krot(int nt) const { if (!rot) return 0; const int j = c >> 3; return (((j & 7) + (j >> 3)) & 1) ? ((nt >> 1) & ~1) : 0; }
    __device__ __forceinline__ void a_ready(const Unit&) const {}
    __device__ __forceinline__ void done(const Unit&) const {}
};


typedef float f32x2_t __attribute__((ext_vector_type(2))); typedef __bf16 bf16x2_t __attribute__((ext_vector_type(2)));
typedef unsigned u32x2 __attribute__((ext_vector_type(2)));
__device__ __forceinline__ unsigned cvt_pk_bf16(float lo, float hi) { f32x2_t v = {lo, hi}; bf16x2_t b = __builtin_convertvector(v, bf16x2_t); return __builtin_bit_cast(unsigned, b); }
__device__ __forceinline__ float xsum16(float v) { const auto r = __builtin_amdgcn_permlane16_swap(__float_as_uint(v), __float_as_uint(v), false, false); const unsigned r0 = r[0], r1 = r[1]; return __uint_as_float(r0) + __uint_as_float(r1); }
__device__ __forceinline__ float xsum32(float v) { const auto r = __builtin_amdgcn_permlane32_swap(__float_as_uint(v), __float_as_uint(v), false, false); const unsigned r0 = r[0], r1 = r[1]; return __uint_as_float(r0) + __uint_as_float(r1); }
#ifndef ZFIRST_SWIGLU
#define ZFIRST_SWIGLU false
#endif
#ifndef ZFIRST_RESID
#define ZFIRST_RESID false
#endif
#ifndef ZFIRST_OTHER
#define ZFIRST_OTHER false
#endif
constexpr int DM_ = 1024, M_ = 32768;
constexpr int WIN_TBL_OFF = STAGE_BYTES + 8 * 2560 + 512;
constexpr float EPS_ = 1e-6f;
__device__ __forceinline__ float row_rstd(const float* __restrict__ stats, int row, int fq) {
    const f32x4 v = *(const f32x4*)((const char*)stats + ((unsigned)row * 64u + 16u * (unsigned)fq));
    float s = (v[0] + v[1]) + (v[2] + v[3]);
    s = xsum32(xsum16(s));
    return __builtin_amdgcn_rsqf(s * (1.0f / DM_) + EPS_);
}

__device__ __forceinline__ void row_rstd8(const float* __restrict__ stats, const int (&rows)[2][4], int fq, float (&rs)[2][4]) {
    f32x4 v[2][4];
#pragma unroll
    for (int ai = 0; ai < 2; ++ai)
#pragma unroll
        for (int m = 0; m < 4; ++m) v[ai][m] = *(const f32x4*)((const char*)stats + ((unsigned)rows[ai][m] * 64u + 16u * (unsigned)fq));
    asm volatile("" : "+v"(v[0][0]), "+v"(v[0][1]), "+v"(v[0][2]), "+v"(v[0][3]), "+v"(v[1][0]), "+v"(v[1][1]), "+v"(v[1][2]), "+v"(v[1][3]));
#pragma unroll
    for (int ai = 0; ai < 2; ++ai)
#pragma unroll
        for (int m = 0; m < 4; ++m) { float s = (v[ai][m][0] + v[ai][m][1]) + (v[ai][m][2] + v[ai][m][3]); s = xsum32(xsum16(s)); rs[ai][m] = __builtin_amdgcn_rsqf(s * (1.0f / DM_) + EPS_); }
}

__device__ __forceinline__ unsigned stat_idx(int row, int slot) { return ((unsigned)row & ~15u) * 16u + (unsigned)slot * 16u + ((unsigned)row & 15u); }
__device__ __forceinline__ void row_rstd8t(const float* __restrict__ stats, const int (&rows)[2][4], int fq, float (&rs)[2][4]) {
#pragma unroll
    for (int ai = 0; ai < 2; ++ai) {
        float v[4][4];
#pragma unroll
        for (int m = 0; m < 4; ++m) { const char* sp = (const char*)stats + stat_idx(rows[ai][m], 4 * fq) * 4u;
#pragma unroll
            for (int i = 0; i < 4; ++i) v[m][i] = *(const float*)(sp + 64 * i); }
        asm volatile("" : "+v"(v[0][0]), "+v"(v[0][1]), "+v"(v[0][2]), "+v"(v[0][3]), "+v"(v[1][0]), "+v"(v[1][1]), "+v"(v[1][2]), "+v"(v[1][3]),
                          "+v"(v[2][0]), "+v"(v[2][1]), "+v"(v[2][2]), "+v"(v[2][3]), "+v"(v[3][0]), "+v"(v[3][1]), "+v"(v[3][2]), "+v"(v[3][3]));
#pragma unroll
        for (int m = 0; m < 4; ++m) { float s = (v[m][0] + v[m][1]) + (v[m][2] + v[m][3]); s = xsum32(xsum16(s)); rs[ai][m] = __builtin_amdgcn_rsqf(s * (1.0f / DM_) + EPS_); }
    }
}

struct EpiSwiGLU {
    #ifndef PROBE_EPI_SWIGLU
#define PROBE_EPI_SWIGLU false
#endif
    static constexpr bool PERM = true, AFTER_DRAIN = false, PROBE_TWICE = PROBE_EPI_SWIGLU, ZFIRST = ZFIRST_SWIGLU;
    __device__ __forceinline__ EpiSwiGLU second() const { return *this; }
    bf16_t* __restrict__ O; const float* __restrict__ stats; bool tr;
    __device__ __forceinline__ void operator()(const f32x4 (&acc)[2][2][4][2], const Unit& u, int wr, int wc, int fr_in, int fq_in, PG8_LAS unsigned char* lds) const {
        int fr = fr_in, fq = fq_in; asm volatile("" : "+v"(fr), "+v"(fq));
        const int row0 = u.pm * BM + wr * 64 + fr, col0 = u.pn * 128 + wc * 32 + 8 * fq;
#if defined(ACT_WT)
        const __amdgpu_buffer_rsrc_t orsrc = __builtin_amdgcn_make_buffer_rsrc((void*)O, 0, 0x7fffffff, 0x00020000);
#endif
        const unsigned ob0 = ((unsigned)row0 * 2816u + (unsigned)col0) * 2u;
        float rsv[2][4]; int rws[2][4];
#pragma unroll
        for (int ai = 0; ai < 2; ++ai)
#pragma unroll
            for (int m = 0; m < 4; ++m) rws[ai][m] = row0 + ai * HALF + m * 16;
        { PG8_LAS float* rc = (PG8_LAS float*)(lds + WIN_TBL_OFF + (wr * 4 + wc) * 512) + fr * 8;
          PG8_LAS unsigned* tg = (PG8_LAS unsigned*)(lds + WIN_TBL_OFF + 4096 + (wr * 4 + wc) * 4);
          const unsigned want = (unsigned)u.pm + 1u;
          if ((unsigned)__builtin_amdgcn_readfirstlane((int)*tg) == want) {
              const f32x4 c0 = *(const PG8_LAS f32x4*)rc, c1 = *(const PG8_LAS f32x4*)(rc + 4);
              rsv[0][0] = c0[0]; rsv[0][1] = c0[1]; rsv[0][2] = c0[2]; rsv[0][3] = c0[3]; rsv[1][0] = c1[0]; rsv[1][1] = c1[1]; rsv[1][2] = c1[2]; rsv[1][3] = c1[3];
          } else {
              if (tr) row_rstd8t(stats, rws, fq, rsv); else row_rstd8(stats, rws, fq, rsv);
              if (fq == 0) { *(PG8_LAS f32x4*)rc = (f32x4){rsv[0][0], rsv[0][1], rsv[0][2], rsv[0][3]}; *(PG8_LAS f32x4*)(rc + 4) = (f32x4){rsv[1][0], rsv[1][1], rsv[1][2], rsv[1][3]}; }
              *tg = want;
          } }
#pragma unroll
        for (int ai = 0; ai < 2; ++ai)
#pragma unroll
            for (int m = 0; m < 4; ++m) {
                const int row = row0 + ai * HALF + m * 16;
                const float rs = rsv[ai][m];
                const float k1 = rs * -1.4426950408889634f, ik2 = __builtin_amdgcn_rcpf(rs * rs);
                float a[8];
#pragma unroll
                for (int n = 0; n < 2; ++n)
#pragma unroll
                    for (int jj = 0; jj < 2; ++jj) {
                        const f32x2_t g = {acc[ai][0][m][n][2 * jj], acc[ai][0][m][n][2 * jj + 1]}, up = {acc[ai][1][m][n][2 * jj], acc[ai][1][m][n][2 * jj + 1]};
                        const f32x2_t t = g * k1; f32x2_t e; e.x = __builtin_amdgcn_exp2f(t.x); e.y = __builtin_amdgcn_exp2f(t.y);
                        const f32x2_t d = e * ik2 + ik2; f32x2_t r; r.x = __builtin_amdgcn_rcpf(d.x); r.y = __builtin_amdgcn_rcpf(d.y);
                        const f32x2_t o = (g * up) * r;
                        a[n * 4 + 2 * jj] = o.x; a[n * 4 + 2 * jj + 1] = o.y;
                    }
                u32x4 w; w.x = cvt_pk_bf16(a[0], a[1]); w.y = cvt_pk_bf16(a[2], a[3]); w.z = cvt_pk_bf16(a[4], a[5]); w.w = cvt_pk_bf16(a[6], a[7]);
#if defined(ACT_WT)
                __builtin_amdgcn_raw_buffer_store_b128(w, orsrc, ((unsigned)row * 2816u + (unsigned)col0) * 2u, 0, 16);
#elif defined(ACT_NT)
                __builtin_nontemporal_store(w, (u32x4*)(O + (size_t)row * 2816 + col0));
#else
                *(u32x4*)((char*)O + (ob0 + (unsigned)((ai * HALF + m * 16) * 2816 * 2))) = w;
#endif
            }
    }
};

#ifndef PROBE_EPI_RESID
#define PROBE_EPI_RESID false
#endif
struct EpiResid {
    static constexpr bool PERM = true, AFTER_DRAIN = false, PROBE_TWICE = PROBE_EPI_RESID, ZFIRST = ZFIRST_RESID;
    __device__ __forceinline__ EpiResid second() const { EpiResid e = *this; e.alpha = 0.f; e.bias = nullptr; return e; }
    bf16_t* xb; float* __restrict__ stats_out; const float* __restrict__ bias; float alpha; bool trs;
    __device__ __forceinline__ void operator()(const f32x4 (&acc)[2][2][4][2], const Unit& u, int wr, int wc, int fr_in, int fq_in, PG8_LAS unsigned char*) const {
        int fr = fr_in, fq = fq_in; asm volatile("" : "+v"(fr), "+v"(fq));
        const int row0 = u.pm * BM + wr * 64 + fr, col0 = u.pn * BM + wc * 32 + 8 * fq;
        const unsigned ob0 = ((unsigned)row0 * DM_ + (unsigned)col0) * 2u;
        u32x4 rv[2][4][2];
#pragma unroll
        for (int ai = 0; ai < 2; ++ai)
#pragma unroll
            for (int m = 0; m < 4; ++m)
#pragma unroll
                for (int bj = 0; bj < 2; ++bj) rv[ai][m][bj] = *(const u32x4*)(((const char*)xb + (size_t)((ai * HALF + m * 16) * DM_ + bj * HALF) * 2u) + ob0);
        f32x4 bv[2][2];
#pragma unroll
        for (int bj = 0; bj < 2; ++bj)
#pragma unroll
            for (int n = 0; n < 2; ++n) bv[bj][n] = bias ? *(const f32x4*)(bias + col0 + bj * HALF + n * 4) : (f32x4){0.f, 0.f, 0.f, 0.f};
        asm volatile("" ::: "memory");
#pragma unroll
        for (int ai = 0; ai < 2; ++ai)
#pragma unroll
            for (int m = 0; m < 4; ++m) {
                float ss = 0.f;
#pragma unroll
                for (int bj = 0; bj < 2; ++bj) {
                    const u32x4 r = rv[ai][m][bj];
                    const f32x4 r0 = {__uint_as_float(r.x << 16), __uint_as_float(r.x & 0xffff0000u), __uint_as_float(r.y << 16), __uint_as_float(r.y & 0xffff0000u)};
                    const f32x4 r1 = {__uint_as_float(r.z << 16), __uint_as_float(r.z & 0xffff0000u), __uint_as_float(r.w << 16), __uint_as_float(r.w & 0xffff0000u)};
                    const f32x4 o0 = r0 + acc[ai][bj][m][0] * alpha + bv[bj][0], o1 = r1 + acc[ai][bj][m][1] * alpha + bv[bj][1];
                    ss += ((o0[0] * o0[0] + o0[1] * o0[1]) + (o0[2] * o0[2] + o0[3] * o0[3])) + ((o1[0] * o1[0] + o1[1] * o1[1]) + (o1[2] * o1[2] + o1[3] * o1[3]));
                    u32x4 w; w.x = cvt_pk_bf16(o0[0], o0[1]); w.y = cvt_pk_bf16(o0[2], o0[3]); w.z = cvt_pk_bf16(o1[0], o1[1]); w.w = cvt_pk_bf16(o1[2], o1[3]);
                    *(u32x4*)(((char*)xb + (size_t)((ai * HALF + m * 16) * DM_ + bj * HALF) * 2u) + ob0) = w;
                }
                ss = xsum32(xsum16(ss));
                if (stats_out && fq == 0) *(float*)((char*)stats_out + 4u * (trs ? stat_idx(row0 + ai * HALF + m * 16, u.pn * 4 + wc) : (unsigned)(row0 + ai * HALF + m * 16) * 16u + (unsigned)(u.pn * 4 + wc))) = ss;
            }
    }
};

struct EpiFinal {
    static constexpr bool PERM = true, AFTER_DRAIN = false, PROBE_TWICE = false, ZFIRST = ZFIRST_OTHER;
    __device__ __forceinline__ EpiFinal second() const { return *this; }
    const bf16_t* __restrict__ xb; float* stats; unsigned* cnt; const float* __restrict__ gfin; float* __restrict__ out; float alpha;
    __device__ __forceinline__ void operator()(f32x4 (&acc)[2][2][4][2], const Unit& u, int wr, int wc, int fr_in, int fq_in, PG8_LAS unsigned char* lds) const {
        int fr = fr_in, fq = fq_in; asm volatile("" : "+v"(fr), "+v"(fq));
        const int row0 = u.pm * BM + wr * 64 + fr, col0 = u.pn * BM + wc * 32 + 8 * fq;
        const unsigned ob0 = ((unsigned)row0 * DM_ + (unsigned)col0) * 2u;
        u32x4 rv[2][4][2];
#pragma unroll
        for (int ai = 0; ai < 2; ++ai)
#pragma unroll
            for (int m = 0; m < 4; ++m)
#pragma unroll
                for (int bj = 0; bj < 2; ++bj) rv[ai][m][bj] = *(const u32x4*)(((const char*)xb + (size_t)((ai * HALF + m * 16) * DM_ + bj * HALF) * 2u) + ob0);
#pragma unroll
        for (int ai = 0; ai < 2; ++ai)
#pragma unroll
            for (int m = 0; m < 4; ++m) {
                float ss = 0.f;
#pragma unroll
                for (int bj = 0; bj < 2; ++bj) {
                    const u32x4 r = rv[ai][m][bj];
                    const f32x4 r0 = {__uint_as_float(r.x << 16), __uint_as_float(r.x & 0xffff0000u), __uint_as_float(r.y << 16), __uint_as_float(r.y & 0xffff0000u)};
                    const f32x4 r1 = {__uint_as_float(r.z << 16), __uint_as_float(r.z & 0xffff0000u), __uint_as_float(r.w << 16), __uint_as_float(r.w & 0xffff0000u)};
                    const f32x4 o0 = r0 + acc[ai][bj][m][0] * alpha, o1 = r1 + acc[ai][bj][m][1] * alpha;
                    acc[ai][bj][m][0] = o0; acc[ai][bj][m][1] = o1;
                    ss += ((o0[0] * o0[0] + o0[1] * o0[1]) + (o0[2] * o0[2] + o0[3] * o0[3])) + ((o1[0] * o1[0] + o1[1] * o1[1]) + (o1[2] * o1[2] + o1[3] * o1[3]));
                }
                ss = xsum32(xsum16(ss));
                if (fq == 0) __hip_atomic_store((float*)((char*)stats + 4u * stat_idx(row0 + ai * HALF + m * 16, u.pn * 4 + wc)), ss, __ATOMIC_RELAXED, __HIP_MEMORY_SCOPE_AGENT);
            }
        asm volatile("s_waitcnt vmcnt(0)" ::: "memory");
        if (fq == 0 && fr == 0) __hip_atomic_fetch_add(cnt + 64 * u.pm, 1u, __ATOMIC_RELAXED, __HIP_MEMORY_SCOPE_AGENT);
        if (wr == 0 && wc == 0) {
            unsigned spins = 0;
            while ((unsigned)__builtin_amdgcn_readfirstlane(__hip_atomic_load(cnt + 64 * u.pm, __ATOMIC_RELAXED, __HIP_MEMORY_SCOPE_AGENT)) < 32u) { __builtin_amdgcn_s_sleep(2); if (++spins > (1u << 22)) break; }
        }
        asm volatile("s_waitcnt vmcnt(0) lgkmcnt(0)" ::: "memory"); __builtin_amdgcn_s_barrier(); asm volatile("" ::: "memory");
        float rstd[2][4];
        { f32x4 pv[2][4];
#pragma unroll
          for (int ai = 0; ai < 2; ++ai)
#pragma unroll
              for (int m = 0; m < 4; ++m) { const float* sp = (const float*)((const char*)stats + 4u * stat_idx(row0 + ai * HALF + m * 16, 4 * fq));
                  pv[ai][m] = (f32x4){__hip_atomic_load(sp, __ATOMIC_RELAXED, __HIP_MEMORY_SCOPE_AGENT), __hip_atomic_load(sp + 16, __ATOMIC_RELAXED, __HIP_MEMORY_SCOPE_AGENT),
                                       __hip_atomic_load(sp + 32, __ATOMIC_RELAXED, __HIP_MEMORY_SCOPE_AGENT), __hip_atomic_load(sp + 48, __ATOMIC_RELAXED, __HIP_MEMORY_SCOPE_AGENT)}; }
          asm volatile("" : "+v"(pv[0][0]), "+v"(pv[0][1]), "+v"(pv[0][2]), "+v"(pv[0][3]), "+v"(pv[1][0]), "+v"(pv[1][1]), "+v"(pv[1][2]), "+v"(pv[1][3]));
#pragma unroll
          for (int ai = 0; ai < 2; ++ai)
#pragma unroll
              for (int m = 0; m < 4; ++m) { float s = (pv[ai][m][0] + pv[ai][m][1]) + (pv[ai][m][2] + pv[ai][m][3]); s = xsum32(xsum16(s)); rstd[ai][m] = __builtin_amdgcn_rsqf(s * (1.0f / DM_) + EPS_); } }
        asm volatile("" : "+v"(rstd[0][0]), "+v"(rstd[0][1]), "+v"(rstd[0][2]), "+v"(rstd[0][3]), "+v"(rstd[1][0]), "+v"(rstd[1][1]), "+v"(rstd[1][2]), "+v"(rstd[1][3]));
        const bool hi8 = (fr & 8) != 0; const int row8 = row0 - (fr & 8), col8 = col0 + (hi8 ? 4 : 0); const unsigned oo8 = ((unsigned)row8 * DM_ + (unsigned)col8) * 4u;
#pragma unroll
        for (int bj = 0; bj < 2; ++bj) {
            const f32x4 g0 = *(const f32x4*)(gfin + col0 + bj * HALF), g1 = *(const f32x4*)(gfin + col0 + bj * HALF + 4);
#pragma unroll
            for (int ai = 0; ai < 2; ++ai)
#pragma unroll
                for (int m = 0; m < 4; ++m) {
                    const f32x4 x0 = acc[ai][bj][m][0] * rstd[ai][m] * g0, x1 = acc[ai][bj][m][1] * rstd[ai][m] * g1;
                    f32x4 ya, yb;
#pragma unroll
                    for (int j = 0; j < 4; ++j) {
                        const float a0 = x0[j], a1 = x1[j];
                        const float r0 = __uint_as_float((unsigned)__builtin_amdgcn_update_dpp(0, (int)__float_as_uint(a0), 0x128, 0xf, 0xf, false));
                        const float r1 = __uint_as_float((unsigned)__builtin_amdgcn_update_dpp(0, (int)__float_as_uint(a1), 0x128, 0xf, 0xf, false));
                        ya[j] = hi8 ? r1 : a0; yb[j] = hi8 ? a1 : r0; }
                    char* op = (char*)out + (oo8 + (unsigned)(((ai * HALF + m * 16) * DM_ + bj * HALF) * 4));
                    *(f32x4*)(op) = ya; *(f32x4*)(op + 8 * DM_ * 4) = yb; }
        }
    }
};

struct EpiBf16Plain {
    static constexpr bool PERM = true, AFTER_DRAIN = false, PROBE_TWICE = false, ZFIRST = ZFIRST_OTHER;
    __device__ __forceinline__ EpiBf16Plain second() const { return *this; }
    bf16_t* __restrict__ O; int ldc;
    __device__ __forceinline__ void operator()(const f32x4 (&acc)[2][2][4][2], const Unit& u, int wr, int wc, int fr_in, int fq_in, PG8_LAS unsigned char*) const {
        int fr = fr_in, fq = fq_in; asm volatile("" : "+v"(fr), "+v"(fq));
        const int row0 = u.pm * BM + wr * 64 + fr, col0 = u.pn * BM + wc * 32 + 8 * fq;
#pragma unroll
        for (int ai = 0; ai < 2; ++ai)
#pragma unroll
            for (int m = 0; m < 4; ++m) { bf16_t* rowp = O + (size_t)(row0 + ai * HALF + m * 16) * ldc + col0;
#pragma unroll
                for (int bj = 0; bj < 2; ++bj) { const f32x4 v0 = acc[ai][bj][m][0], v1 = acc[ai][bj][m][1];
                    u32x4 w; w.x = cvt_pk_bf16(v0[0], v0[1]); w.y = cvt_pk_bf16(v0[2], v0[3]); w.z = cvt_pk_bf16(v1[0], v1[1]); w.w = cvt_pk_bf16(v1[2], v1[3]);
                    *(u32x4*)(rowp + bj * HALF) = w; } }
    }
};

#ifndef PROBE_EPI_WIN
#define PROBE_EPI_WIN false
#endif
struct EpiWin {
    static constexpr bool PERM = false, AFTER_DRAIN = false, PROBE_TWICE = PROBE_EPI_WIN, ZFIRST = false;
    __device__ __forceinline__ EpiWin second() const { return *this; }
    const float* __restrict__ stats; bf16_t* __restrict__ XT2; float* __restrict__ Tv; float* __restrict__ ALTP; bf16_t* __restrict__ Qb; bf16_t* __restrict__ Kb; bf16_t* __restrict__ Vb;
    const float* __restrict__ qn; const float* __restrict__ kn; const float* __restrict__ ropeC; const float* __restrict__ ropeS;
    template <int TY> __device__ __forceinline__ void head_path(const f32x4 (&acc)[2][2][4][2], bf16_t* __restrict__ dst, unsigned pitchb, PG8_LAS const unsigned char* tbl, unsigned gnoff, const float (&rs)[2][4], const int (&pos)[2][4], int brow0, int fq) const {
        const float qs = (TY == 0) ? 0.125f * 1.4426950408889634f : 1.0f;
        const unsigned fqb = 16u * (unsigned)fq;
#pragma unroll
        for (int ai = 0; ai < 2; ++ai)
#pragma unroll
            for (int m = 0; m < 4; ++m) {
                const int s = pos[ai][m];
                f32x4 v[2][2];
#pragma unroll
                for (int bj = 0; bj < 2; ++bj)
#pragma unroll
                    for (int n = 0; n < 2; ++n) v[bj][n] = acc[ai][bj][m][n] * rs[ai][m];
                if (TY != 2) {
                    float ss = 0.f;
#pragma unroll
                    for (int bj = 0; bj < 2; ++bj)
#pragma unroll
                        for (int n = 0; n < 2; ++n) ss += (v[bj][n][0] * v[bj][n][0] + v[bj][n][1] * v[bj][n][1]) + (v[bj][n][2] * v[bj][n][2] + v[bj][n][3] * v[bj][n][3]);
                    ss = xsum32(xsum16(ss));
                    const float r = __builtin_amdgcn_rsqf(ss * (1.0f / 64.0f) + EPS_);
#pragma unroll
                    for (int bj = 0; bj < 2; ++bj) {
                        const unsigned p = bj ? (unsigned)(s & 63) : (unsigned)(s >> 6);
                        const f32x4 c = *(const PG8_LAS f32x4*)(tbl + (p * 64u + fqb)), sn = *(const PG8_LAS f32x4*)(tbl + (4096u + p * 64u + fqb));
                        const f32x4 g1 = *(const PG8_LAS f32x4*)(tbl + (gnoff + 128u * bj + fqb)), g2 = *(const PG8_LAS f32x4*)(tbl + (gnoff + 128u * bj + 64u + fqb));
                        const f32x4 x1 = v[bj][0] * r * g1, x2 = v[bj][1] * r * g2;
                        v[bj][0] = (x1 * c - x2 * sn) * qs; v[bj][1] = (x1 * sn + x2 * c) * qs;
                    }
                }
                const unsigned ob = (unsigned)(brow0 + s) * pitchb + 8u * (unsigned)fq;
#pragma unroll
                for (int bj = 0; bj < 2; ++bj)
#pragma unroll
                    for (int n = 0; n < 2; ++n) { u32x2 w; w.x = cvt_pk_bf16(v[bj][n][0], v[bj][n][1]); w.y = cvt_pk_bf16(v[bj][n][2], v[bj][n][3]); *(u32x2*)((char*)dst + (ob + 64u * bj + 32u * n)) = w; }
                if (m & 1) { asm volatile("" ::: "memory"); __builtin_amdgcn_sched_barrier(0); }
            }
    }
    __device__ __forceinline__ void operator()(const f32x4 (&acc)[2][2][4][2], const Unit& u, int wr_in, int wc_in, int fr_in, int fq_in, PG8_LAS unsigned char* lds) const {
        int fr = fr_in, fq = fq_in; asm volatile("" : "+v"(fr), "+v"(fq));
        int wr = wr_in, wc = wc_in; asm volatile("" : "+s"(wr), "+s"(wc));
        const int b = u.pm >> 3, sb = u.pm & 7, i0 = wr * 64 + fr, brow0 = b * 2048;
        int pos[2][4]; float rs[2][4];
#pragma unroll
        for (int m = 0; m < 4; ++m) { pos[0][m] = 128 * sb + i0 + 16 * m; const int q = 2048 - 128 * sb - i0 - 16 * m; pos[1][m] = (q == 2048) ? 1024 : q; }
        { int rws[2][4];
#pragma unroll
          for (int ai = 0; ai < 2; ++ai)
#pragma unroll
              for (int m = 0; m < 4; ++m) rws[ai][m] = brow0 + pos[ai][m];
          row_rstd8(stats, rws, fq, rs); }
        if (u.pn < 2) {
            const int lane = fq * 16 + fr, g = 2 * u.pn + (wc >> 1), ch0 = 32 * (wc & 1);
            const bool special = (sb == 0) && (i0 == 0);
            const bool spec_col = (ch0 == 0) && (fq == 0);
            PG8_LAS unsigned short* stg = (PG8_LAS unsigned short*)(lds + STAGE_BYTES + (wr * 4 + wc) * 2560);
            bf16_t* xt = XT2 + ((size_t)((b * 2 + u.pn) * 256 + 32 * wc) * 1024 + 128 * sb + wr * 64 + (lane & 7) * 8);
            float* tvg = Tv + (b * 512 + g * 128);
            f32x4 alt[2]; float alt64 = 0.f;
#pragma unroll
            for (int bj = 0; bj < 2; ++bj)
#pragma unroll
                for (int n = 0; n < 2; ++n) {
                    if (bj == 0) alt[n] = (f32x4){0.f, 0.f, 0.f, 0.f};
                    const bool sc = (bj == 1) && (n == 0) && spec_col;
                    const int cq = ch0 + 16 * n + 4 * fq;
#pragma unroll
                    for (int m = 0; m < 4; ++m) { const f32x4 a0 = acc[0][bj][m][n] * rs[0][m], a1 = acc[1][bj][m][n] * rs[1][m];
                        f32x4 v = (bj == 0) ? a0 + a1 : a0 - a1;
                        if (sc) v[0] = a0[0] + a1[0];
                        if (m == 0) { if (special) {
                            if (bj == 0) { *(f32x4*)(tvg + cq) = a1; v = a0; }
                            else { const float s0 = a0[0]; v = (f32x4){0.f, 0.f, 0.f, 0.f}; if (sc) { tvg[64] = a1[0]; v[0] = s0; } } } }
                        if (bj == 0) alt[n] += v; else if (sc) alt64 += v[0];
                        const unsigned w0 = cvt_pk_bf16(v[0], v[1]), w1 = cvt_pk_bf16(v[2], v[3]);
                        PG8_LAS unsigned short* p = stg + (4 * fq) * 80 + 16 * m + fr;
                        p[0] = (unsigned short)w0; p[80] = (unsigned short)(w0 >> 16); p[160] = (unsigned short)w1; p[240] = (unsigned short)(w1 >> 16); }
#pragma unroll
                    for (int i = 0; i < 2; ++i) { const int col = i * 8 + (lane >> 3);
                        const u32x4 w = *(const PG8_LAS u32x4*)(stg + col * 80 + (lane & 7) * 8);
                        *(u32x4*)(xt + (size_t)(bj * 128 + 16 * n + col) * 1024) = w; }
                    asm volatile("" ::: "memory"); __builtin_amdgcn_sched_barrier(0);
                }
            const float sg = (fr & 1) ? -1.0f : 1.0f;
            float* altg = ALTP + ((b * 16 + sb * 2 + wr) * 512 + g * 128);
#pragma unroll
            for (int n = 0; n < 3; ++n) { f32x4 a = (n < 2) ? alt[n < 2 ? n : 0] * sg : (f32x4){alt64 * sg, 0.f, 0.f, 0.f};
#pragma unroll
                for (int j = 0; j < 4; ++j) { float t = a[j];
                    t += __builtin_bit_cast(float, __builtin_amdgcn_update_dpp(0, __builtin_bit_cast(int, t), 0xB1, 0xf, 0xf, false));
                    t += __builtin_bit_cast(float, __builtin_amdgcn_update_dpp(0, __builtin_bit_cast(int, t), 0x4E, 0xf, 0xf, false));
                    t += __builtin_bit_cast(float, __builtin_amdgcn_update_dpp(0, __builtin_bit_cast(int, t), 0x141, 0xf, 0xf, false));
                    t += __builtin_bit_cast(float, __builtin_amdgcn_update_dpp(0, __builtin_bit_cast(int, t), 0x140, 0xf, 0xf, false));
                    a[j] = t; }
                if (fr == 0) {
                    if (n < 2) { const int cq = ch0 + 16 * n + 4 * fq; *(f32x4*)(altg + cq) = a; }
                    else if (spec_col) altg[64] = a[0]; } }
        } else { PG8_LAS const unsigned char* tbl = lds + WIN_TBL_OFF;
            if (u.pn < 4)      { head_path<0>(acc, Qb + (size_t)((u.pn - 2) * 4 + wc) * 64, 1024u, tbl, 8192u, rs, pos, brow0, fq); }
            else if (wc < 2)   { head_path<1>(acc, Kb + (size_t)wc * 64, 256u, tbl, 8448u, rs, pos, brow0, fq); }
            else               { head_path<2>(acc, Vb + (size_t)(wc - 2) * 64, 256u, tbl, 8448u, rs, pos, brow0, fq); } }
    }
};

struct EpiDft {
    static constexpr bool PERM = true, AFTER_DRAIN = false, PROBE_TWICE = false, ZFIRST = ZFIRST_OTHER;
    __device__ __forceinline__ EpiDft second() const { return *this; }
    bf16_t* __restrict__ O; const float* __restrict__ Tv; const float* __restrict__ ALTP;
    __device__ __forceinline__ void operator()(const f32x4 (&acc)[2][2][4][2], const Unit& u, int wr, int wc, int fr_in, int fq_in, PG8_LAS unsigned char*) const {
        int fr = fr_in, fq = fq_in; asm volatile("" : "+v"(fr), "+v"(fq));
        const int b = u.pm >> 3, kb = u.pm & 7, g = 2 * u.pn + (wc >> 1), c0 = 32 * (wc & 1) + 8 * fq, cc = g * 128 + c0;
        const bool sp = (c0 == 0);
        const float sc = 1.0f / 512.0f;
        const f32x4 t0 = *(const f32x4*)(Tv + b * 512 + cc) * sc, t1 = *(const f32x4*)(Tv + b * 512 + cc + 4) * sc;
        const float t64 = Tv[b * 512 + g * 128 + 64] * sc;
        const float sg = (fr & 1) ? -1.0f : 1.0f;
#pragma unroll
        for (int m = 0; m < 4; ++m) {
            const int k = 128 * kb + 64 * wr + 16 * m + fr;
            f32x4 q0 = acc[1][1][m][0]; const f32x4 q1 = acc[1][1][m][1];
            if (sp) q0[0] = 0.f;
            const f32x4 b0 = acc[0][0][m][0] + t0 * sg, b1 = acc[0][0][m][1] + t1 * sg;
            const f32x4 x0 = b0 - q0, x1 = b1 - q1, y0 = b0 + q0, y1 = b1 + q1;
            const float s64 = acc[0][1][m][0][0] + t64 * sg;
            f32x4 mk0 = y0, m20 = x0;
            if (sp) { mk0[0] = s64; m20[0] = s64; }
            f32x4 p20 = y0, p21 = y1, m21 = x1;
            int k2 = 2048 - k;
            if (k == 0) { k2 = 1024; f32x4 s0 = t0, s1 = t1; float sa = t64;
                for (int p = 0; p < 16; ++p) { s0 += *(const f32x4*)(ALTP + (b * 16 + p) * 512 + cc) * sc; s1 += *(const f32x4*)(ALTP + (b * 16 + p) * 512 + cc + 4) * sc; sa += ALTP[(b * 16 + p) * 512 + g * 128 + 64] * sc; }
                p20 = s0; p21 = s1; m20 = s0; m21 = s1; if (sp) m20[0] = sa; }
            u32x4 w; bf16_t* o1 = (bf16_t*)((char*)O + ((unsigned)(b * 2048 + k) * DM_ + (unsigned)cc) * 2u); bf16_t* o2 = (bf16_t*)((char*)O + ((unsigned)(b * 2048 + k2) * DM_ + (unsigned)cc) * 2u);
            w.x = cvt_pk_bf16(x0[0], x0[1]); w.y = cvt_pk_bf16(x0[2], x0[3]); w.z = cvt_pk_bf16(x1[0], x1[1]); w.w = cvt_pk_bf16(x1[2], x1[3]);
            *(u32x4*)o1 = w;
            w.x = cvt_pk_bf16(mk0[0], mk0[1]); w.y = cvt_pk_bf16(mk0[2], mk0[3]); w.z = cvt_pk_bf16(y1[0], y1[1]); w.w = cvt_pk_bf16(y1[2], y1[3]);
            *(u32x4*)(o1 + 64) = w;
            w.x = cvt_pk_bf16(p20[0], p20[1]); w.y = cvt_pk_bf16(p20[2], p20[3]); w.z = cvt_pk_bf16(p21[0], p21[1]); w.w = cvt_pk_bf16(p21[2], p21[3]);
            *(u32x4*)o2 = w;
            w.x = cvt_pk_bf16(m20[0], m20[1]); w.y = cvt_pk_bf16(m20[2], m20[3]); w.z = cvt_pk_bf16(m21[0], m21[1]); w.w = cvt_pk_bf16(m21[2], m21[3]);
            *(u32x4*)(o2 + 64) = w;
        }
    }
};

__device__ __forceinline__ void pg8_glds(const void* sbase, unsigned voff, unsigned lds_dst) {
#ifdef GLDS_M0_CLOBBER
    asm volatile("s_mov_b32 m0, %2\n\ts_nop 0\n\tglobal_load_lds_dwordx4 %0, %1" : : "v"(voff), "s"(sbase), "s"(lds_dst) : "memory", "m0");
#else
    unsigned keep; asm volatile("s_mov_b32 %0, m0\n\ts_mov_b32 m0, %3\n\ts_nop 0\n\tglobal_load_lds_dwordx4 %1, %2\n\ts_mov_b32 m0, %0" : "=&s"(keep) : "v"(voff), "s"(sbase), "s"(lds_dst) : "memory");
#endif
}
template <class Epi, class Sched, bool ALIGN_EPI = false, bool SP2 = false, bool AREV = false, int DIAG = 0, bool IMM = false, bool PF = false, int AAUX = 0>
__device__ __forceinline__ void gemm_phase(PG8_LAS unsigned char* lds, const Gemm g, const Sched& S, const Epi& E) {
    int tid_ = threadIdx.x; asm volatile("" : "+v"(tid_));
    const int tid = tid_, wid = __builtin_amdgcn_readfirstlane(tid >> 6), lane = tid & 63, wr = wid >> 2, wc = wid & 3, fr = lane & 15, fq = lane >> 4;
    const int K = g.K, nt = K / BK;
    unsigned voffA[2], voffB[2], voffA1[2];
#pragma unroll
    for (int i = 0; i < 2; ++i) { int R, C; stage_rc(tid * 16 + i * 8192, R, C); const int Rb = Epi::PERM ? ((R & ~31) + perm32(R & 31)) : R;
        voffA[i] = (unsigned)(R * K + C) * 2u; voffB[i] = (unsigned)(Rb * K + C) * 2u; voffA1[i] = AREV ? (unsigned)((1024 - R) * K + C) * 2u : voffA[i]; }
    const unsigned arev_th = 1024u * (unsigned)K * 2u;
    static_assert(!PF || (!AREV && !IMM && SP2), "PF: plain SP2 loop only");
    unsigned pf_dummy = 0u; const unsigned pf_voff = (unsigned)(((wid & 3) * 64 + lane) * K) * 2u;
    const bool pf_isB = wid >= 4;
    const size_t kstep = (size_t)(BK * 2);
    const int kr = S.krot(nt);
#define PG8_KO(t) ((size_t)(((t) + kr) >= nt ? ((t) + kr) - nt : ((t) + kr)) * kstep)
    const size_t hstep = (size_t)HALF * K * 2;
    const size_t tstep = 2 * hstep;
    const unsigned ldsw = (unsigned)wid * 1024u;
    const int aoff = lds_byte(wr * 64 + fr, fq * 8), boff = lds_byte(wc * 32 + fr, fq * 8);
#define PG8_SA(b, h) (((b) * 2 + (h)) * HTB)
#define PG8_SB(b, h) ((4 + (b) * 2 + (h)) * HTB)
#define PG8_STAGE(bufoff, gbase, voff) do { _Pragma("unroll") for (int _i = 0; _i < 2; ++_i) \
        pg8_glds((const void*)(gbase), (voff)[_i], (unsigned)(unsigned long)(lds + (bufoff) + ldsw + _i * 8192)); } while (0)
#define PG8_STAGE_A1(bufoff, gbase, spec) do { _Pragma("unroll") for (int _i = 0; _i < 2; ++_i) { unsigned _vo = voffA1[_i]; if (AREV) { if (spec) _vo = (_vo >= arev_th) ? _vo - arev_th : _vo; } \
        pg8_glds((const void*)(gbase), _vo, (unsigned)(unsigned long)(lds + (bufoff) + ldsw + _i * 8192)); } } while (0)
#define PG8_STAGEA(bufoff, gbase, voff) do { _Pragma("unroll") for (int _i = 0; _i < 2; ++_i) \
        pg8_glds((const void*)(gbase), (voff)[_i], (unsigned)(unsigned long)(lds + (bufoff) + ldsw + _i * 8192)); } while (0)
#ifndef B_AUX
#define B_AUX 0
#endif
#define PG8_STAGEB(bufoff, gbase, voff) do { _Pragma("unroll") for (int _i = 0; _i < 2; ++_i) \
        pg8_glds((const void*)(gbase), (voff)[_i], (unsigned)(unsigned long)(lds + (bufoff) + ldsw + _i * 8192)); } while (0)
#define PG8_LDA(dst, b, h) do { _Pragma("unroll") for (int m = 0; m < 4; ++m) _Pragma("unroll") for (int k = 0; k < 2; ++k) dst[m][k] = *(const PG8_LAS bf16x8*)(lds + PG8_SA(b, h) + aoff + m * 2048 + k * 1024); } while (0)
#define PG8_LDB(dst, b, h) do { _Pragma("unroll") for (int n = 0; n < 2; ++n) _Pragma("unroll") for (int k = 0; k < 2; ++k) dst[n][k] = *(const PG8_LAS bf16x8*)(lds + PG8_SB(b, h) + boff + n * 2048 + k * 1024); } while (0)
#define PG8_MMA(ai, bj, At, Bt) do { __builtin_amdgcn_s_setprio(1); _Pragma("unroll") for (int m = 0; m < 4; ++m) _Pragma("unroll") for (int n = 0; n < 2; ++n) _Pragma("unroll") for (int k = 0; k < 2; ++k) \
        acc[ai][bj][m][n] = __builtin_amdgcn_mfma_f32_16x16x32_bf16(Bt[n][k], At[m][k], acc[ai][bj][m][n], 0, 0, 0); __builtin_amdgcn_s_setprio(0); } while (0)
#define PG8_MMAZ(ai, bj, At, Bt) do { if (zf_) { __builtin_amdgcn_s_setprio(1); _Pragma("unroll") for (int m = 0; m < 4; ++m) _Pragma("unroll") for (int n = 0; n < 2; ++n) { \
        acc[ai][bj][m][n] = __builtin_amdgcn_mfma_f32_16x16x32_bf16(Bt[n][0], At[m][0], (f32x4){0.f, 0.f, 0.f, 0.f}, 0, 0, 0); acc[ai][bj][m][n] = __builtin_amdgcn_mfma_f32_16x16x32_bf16(Bt[n][1], At[m][1], acc[ai][bj][m][n], 0, 0, 0); } __builtin_amdgcn_s_setprio(0); } else PG8_MMA(ai, bj, At, Bt); } while (0)
#define PG8_STAGE1(bufoff, gbase, voff, i) pg8_glds((const void*)(gbase), (voff)[i], (unsigned)(unsigned long)(lds + (bufoff) + ldsw + (i) * 8192))
#define PG8_STAGE1_A1(bufoff, gbase, spec, i) do { unsigned _vo = voffA1[i]; if (AREV) { if (spec) _vo = (_vo >= arev_th) ? _vo - arev_th : _vo; } \
        pg8_glds((const void*)(gbase), _vo, (unsigned)(unsigned long)(lds + (bufoff) + ldsw + (i) * 8192)); } while (0)
#define PG8_MMA_H(ai, bj, At, Bt, HOOK) do { __builtin_amdgcn_s_setprio(1); _Pragma("unroll") for (int m = 0; m < 4; ++m) { _Pragma("unroll") for (int n = 0; n < 2; ++n) _Pragma("unroll") for (int k = 0; k < 2; ++k) \
        acc[ai][bj][m][n] = __builtin_amdgcn_mfma_f32_16x16x32_bf16(Bt[n][k], At[m][k], acc[ai][bj][m][n], 0, 0, 0); HOOK(m); __builtin_amdgcn_sched_barrier(0); } __builtin_amdgcn_s_setprio(0); } while (0)
#define PG8_WAIT_V(n) asm volatile("s_waitcnt vmcnt(" #n ")" ::: "memory")
#define PG8_WAIT_L(n) asm volatile("s_waitcnt lgkmcnt(" #n ")" ::: "memory")
#define PG8_BAR __builtin_amdgcn_s_barrier()
#define PG8_SCHED __builtin_amdgcn_sched_barrier(0)
    Unit cur, nxt; int ui = 0;
    if (!S.next(0, cur)) return;
    f32x4 acc[2][2][4][2];
#pragma unroll
    for (int a = 0; a < 2; ++a)
#pragma unroll
        for (int b = 0; b < 2; ++b)
#pragma unroll
            for (int m = 0; m < 4; ++m)
#pragma unroll
                for (int n = 0; n < 2; ++n) acc[a][b][m][n] = (f32x4){0.f, 0.f, 0.f, 0.f};
    bf16x8 At[4][2], B0[2][2], B1[2][2]; bool zl_ = false;
    const size_t rstep = (size_t)K * 2;
    const char* cA = (const char*)g.A + (size_t)cur.a0row * rstep; const char* cA1 = (const char*)g.A + (size_t)cur.a1row * rstep; const char* cB = (const char*)g.Bt + (size_t)cur.brow * tstep; int cspec = cur.spec;
    S.a_ready(cur);
    if constexpr (SP2) {
        PG8_STAGEB(PG8_SB(0, 0), cB + PG8_KO(0), voffB); PG8_STAGEB(PG8_SB(0, 1), cB + hstep + PG8_KO(0), voffB); PG8_STAGEA(PG8_SA(0, 0), cA + PG8_KO(0), voffA); PG8_STAGE_A1(PG8_SA(0, 1), cA1 + PG8_KO(0), cspec);
        if (wr == 1) PG8_BAR;
        PG8_WAIT_V(2); PG8_BAR;
        PG8_STAGEB(PG8_SB(1, 0), cB + PG8_KO(1), voffB); PG8_STAGEA(PG8_SA(1, 0), cA + PG8_KO(1), voffA); PG8_STAGEB(PG8_SB(1, 1), cB + hstep + PG8_KO(1), voffB);
        PG8_WAIT_V(6); PG8_BAR;
    } else {
        PG8_STAGEB(PG8_SB(0, 0), cB, voffB); PG8_STAGEA(PG8_SA(0, 0), cA, voffA); PG8_STAGEB(PG8_SB(0, 1), cB + hstep, voffB); PG8_STAGEA(PG8_SA(0, 1), cA + hstep, voffA);
        if (wr == 1) PG8_BAR;
        PG8_WAIT_V(4); PG8_BAR;
        PG8_STAGEB(PG8_SB(1, 0), cB + kstep, voffB); PG8_STAGEA(PG8_SA(1, 0), cA + kstep, voffA); PG8_STAGEB(PG8_SB(1, 1), cB + hstep + kstep, voffB);
        PG8_WAIT_V(6); PG8_BAR;
    }
    for (;;) {
        const bool has_next = S.next(ui + 1, nxt);
        const char* nA = has_next ? (const char*)g.A + (size_t)nxt.a0row * rstep : cA; const char* nA1 = has_next ? (const char*)g.A + (size_t)nxt.a1row * rstep : cA1; const char* nB = has_next ? (const char*)g.Bt + (size_t)nxt.brow * tstep : cB; const int nspec = has_next ? nxt.spec : cspec;
        for (int t = 0; t < nt; t += 2) {
            const bool last = (t == nt - 2); const bool zf_ = Epi::ZFIRST && (t == 0);
            const char* a1 = cA + PG8_KO(t + 1);
            const char* a2 = last ? nA + PG8_KO(0) : cA + PG8_KO(t + 2); const char* b2 = last ? nB + PG8_KO(0) : cB + PG8_KO(t + 2);
            const char* a3 = last ? nA + PG8_KO(1) : cA + PG8_KO(t + 3); const char* b3 = last ? nB + PG8_KO(1) : cB + PG8_KO(t + 3);
            const char* a1h = cA1 + PG8_KO(t + 1); const char* a2h = last ? nA1 + PG8_KO(0) : cA1 + PG8_KO(t + 2); const int spec2 = last ? nspec : cspec;
            if (last && has_next) S.a_ready(nxt);
            if constexpr (SP2 && IMM) {
#define H_NONE(m) do {} while (0)
#define H_SP1_A(m) do { if ((m) < 2) PG8_STAGE1_A1(PG8_SA(1, 1), a1h, cspec, (m)); } while (0)
#define H_SP1_B(m) do { if ((m) < 2) PG8_STAGE1_A1(PG8_SA(0, 1), a2h, spec2, (m)); } while (0)
#define H_SP2_A0(m) do { if ((m) < 2) PG8_STAGE1(PG8_SB(0, 0), b2, voffB, (m)); else PG8_STAGE1(PG8_SB(0, 1), b2 + hstep, voffB, (m) - 2); } while (0)
#define H_SP2_A1(m) do { if ((m) < 2) PG8_STAGE1(PG8_SA(0, 0), a2, voffA, (m)); } while (0)
#define H_SP2_B0(m) do { if ((m) < 2) PG8_STAGE1(PG8_SB(1, 0), b3, voffB, (m)); else PG8_STAGE1(PG8_SB(1, 1), b3 + hstep, voffB, (m) - 2); } while (0)
#define H_SP2_B1(m) do { if ((m) < 2) PG8_STAGE1(PG8_SA(1, 0), a3, voffA, (m)); } while (0)
#define H_SP2_AD(m) do { if ((m) == 0) { PG8_STAGE1(PG8_SB(0, 0), b2, voffB, 0); PG8_STAGE1(PG8_SB(0, 0), b2, voffB, 1); } else if ((m) == 1) { PG8_STAGE1(PG8_SB(0, 1), b2 + hstep, voffB, 0); PG8_STAGE1(PG8_SB(0, 1), b2 + hstep, voffB, 1); } else PG8_STAGE1(PG8_SA(0, 0), a2, voffA, (m) - 2); } while (0)
#define H_SP2_BD(m) do { if ((m) == 0) { PG8_STAGE1(PG8_SB(1, 0), b3, voffB, 0); PG8_STAGE1(PG8_SB(1, 0), b3, voffB, 1); } else if ((m) == 1) { PG8_STAGE1(PG8_SB(1, 1), b3 + hstep, voffB, 0); PG8_STAGE1(PG8_SB(1, 1), b3 + hstep, voffB, 1); } else PG8_STAGE1(PG8_SA(1, 0), a3, voffA, (m) - 2); } while (0)
            PG8_LDB(B0, 0, 0); PG8_LDB(B1, 0, 1); PG8_SCHED; PG8_LDA(At, 0, 0);
            PG8_WAIT_V(6); PG8_WAIT_L(0); PG8_BAR; PG8_MMA_H(0, 0, At, B0, H_SP1_A); if constexpr (!DIAG) PG8_MMA(0, 1, At, B1); PG8_BAR; PG8_SCHED;
            PG8_LDA(At, 0, 1);
            PG8_WAIT_V(2); PG8_WAIT_L(0); PG8_BAR; if constexpr (!DIAG) { PG8_MMA_H(1, 0, At, B0, H_SP2_A0); PG8_MMA_H(1, 1, At, B1, H_SP2_A1); } else { PG8_MMA_H(1, 1, At, B1, H_SP2_AD); } PG8_BAR; PG8_SCHED;
            PG8_LDB(B0, 1, 0); PG8_LDB(B1, 1, 1); PG8_SCHED; PG8_LDA(At, 1, 0);
            PG8_WAIT_V(6); PG8_WAIT_L(0); PG8_BAR; PG8_MMA_H(0, 0, At, B0, H_SP1_B); if constexpr (!DIAG) PG8_MMA(0, 1, At, B1); PG8_BAR; PG8_SCHED;
            PG8_LDA(At, 1, 1);
            PG8_WAIT_V(2); PG8_WAIT_L(0); PG8_BAR; if constexpr (!DIAG) { PG8_MMA_H(1, 0, At, B0, H_SP2_B0); PG8_MMA_H(1, 1, At, B1, H_SP2_B1); } else { PG8_MMA_H(1, 1, At, B1, H_SP2_BD); } PG8_BAR; PG8_SCHED;
            } else
            if constexpr (SP2) {
            if constexpr (PF) { const int t4 = t + 4; const char* pb = (t4 < nt) ? (pf_isB ? cB : cA) + PG8_KO(t4) : (pf_isB ? nB : nA) + PG8_KO(t4 - nt);
                asm volatile("s_nop 4\n\tglobal_load_dword %0, %1, %2" : "+v"(pf_dummy) : "v"(pf_voff), "s"(pb) : "memory"); }
            PG8_LDB(B0, 0, 0); PG8_LDB(B1, 0, 1); PG8_SCHED; PG8_LDA(At, 0, 0); PG8_STAGE_A1(PG8_SA(1, 1), a1h, cspec);
            if constexpr (!Epi::ZFIRST) { if (zl_) { zl_ = false;
                _Pragma("unroll") for (int a = 0; a < 2; ++a) _Pragma("unroll") for (int b = 0; b < 2; ++b) _Pragma("unroll") for (int m = 0; m < 4; ++m) _Pragma("unroll") for (int n = 0; n < 2; ++n) acc[a][b][m][n] = (f32x4){0.f, 0.f, 0.f, 0.f}; } }
            if constexpr (PF) PG8_WAIT_V(9); else PG8_WAIT_V(8); PG8_WAIT_L(0); PG8_BAR; PG8_MMAZ(0, 0, At, B0); if constexpr (DIAG != 1) PG8_MMAZ(0, 1, At, B1); PG8_BAR; PG8_SCHED;
            PG8_LDA(At, 0, 1); PG8_STAGEB(PG8_SB(0, 0), b2, voffB); PG8_STAGEB(PG8_SB(0, 1), b2 + hstep, voffB); PG8_STAGEA(PG8_SA(0, 0), a2, voffA);
            if constexpr (PF) PG8_WAIT_V(9); else PG8_WAIT_V(8); PG8_WAIT_L(0); PG8_BAR; if constexpr (DIAG == 0) PG8_MMAZ(1, 0, At, B0); PG8_MMAZ(1, 1, At, B1); PG8_BAR; PG8_SCHED;
            if constexpr (PF) { const int t5 = t + 5; const char* pb = (t5 < nt) ? (pf_isB ? cB : cA) + PG8_KO(t5) : (pf_isB ? nB : nA) + PG8_KO(t5 - nt);
                asm volatile("s_nop 4\n\tglobal_load_dword %0, %1, %2" : "+v"(pf_dummy) : "v"(pf_voff), "s"(pb) : "memory"); }
            PG8_LDB(B0, 1, 0); PG8_LDB(B1, 1, 1); PG8_SCHED; PG8_LDA(At, 1, 0); PG8_STAGE_A1(PG8_SA(0, 1), a2h, spec2);
            if constexpr (PF) PG8_WAIT_V(9); else PG8_WAIT_V(8); PG8_WAIT_L(0); PG8_BAR; PG8_MMA(0, 0, At, B0); if constexpr (DIAG != 1) PG8_MMA(0, 1, At, B1); PG8_BAR; PG8_SCHED;
            PG8_LDA(At, 1, 1); PG8_STAGEB(PG8_SB(1, 0), b3, voffB); PG8_STAGEB(PG8_SB(1, 1), b3 + hstep, voffB); PG8_STAGEA(PG8_SA(1, 0), a3, voffA);
            if constexpr (PF) PG8_WAIT_V(9); else PG8_WAIT_V(8); PG8_WAIT_L(0); PG8_BAR; if constexpr (DIAG == 0) PG8_MMA(1, 0, At, B0); PG8_MMA(1, 1, At, B1); PG8_BAR; PG8_SCHED;
            } else {
            PG8_LDB(B0, 0, 0); PG8_SCHED; PG8_LDA(At, 0, 0); PG8_STAGEA(PG8_SA(1, 1), a1 + hstep, voffA);
            PG8_WAIT_L(8); PG8_BAR; PG8_WAIT_L(0); PG8_MMA(0, 0, At, B0); PG8_BAR; PG8_SCHED;
            PG8_LDB(B1, 0, 1); PG8_STAGEB(PG8_SB(0, 0), b2, voffB);
            PG8_BAR; PG8_WAIT_L(0); PG8_MMA(0, 1, At, B1); PG8_BAR;
            PG8_LDA(At, 0, 1); PG8_STAGEA(PG8_SA(0, 0), a2, voffA);
            PG8_BAR; PG8_WAIT_L(0); PG8_MMA(1, 0, At, B0); PG8_BAR; PG8_SCHED;
            PG8_STAGEB(PG8_SB(0, 1), b2 + hstep, voffB);
            PG8_WAIT_V(6); PG8_BAR; PG8_MMA(1, 1, At, B1); PG8_BAR;
            PG8_LDB(B0, 1, 0); PG8_SCHED; PG8_LDA(At, 1, 0); PG8_STAGEA(PG8_SA(0, 1), a2 + hstep, voffA);
            PG8_WAIT_L(8); PG8_BAR; PG8_WAIT_L(0); PG8_MMA(0, 0, At, B0); PG8_BAR; PG8_SCHED;
            PG8_LDB(B1, 1, 1); PG8_STAGEB(PG8_SB(1, 0), b3, voffB);
            PG8_BAR; PG8_WAIT_L(0); PG8_MMA(0, 1, At, B1); PG8_BAR;
            PG8_LDA(At, 1, 1); PG8_STAGEA(PG8_SA(1, 0), a3, voffA);
            PG8_BAR; PG8_WAIT_L(0); PG8_MMA(1, 0, At, B0); PG8_BAR; PG8_SCHED;
            PG8_STAGEB(PG8_SB(1, 1), b3 + hstep, voffB);
            PG8_WAIT_V(6); PG8_BAR; PG8_MMA(1, 1, At, B1); PG8_BAR;
            }
        }
        if constexpr (ALIGN_EPI) { if (wr == 0) PG8_BAR; }
        if constexpr (!Epi::AFTER_DRAIN) { E(acc, cur, wr, wc, fr, fq, lds); if constexpr (Epi::PROBE_TWICE) { auto E2 = E.second(); E2(acc, cur, wr, wc, fr, fq, lds); } S.done(cur); }
        if (!has_next) break;
        zl_ = true;
        if constexpr (!(SP2 && !IMM))
#pragma unroll
        for (int a = 0; a < 2; ++a)
#pragma unroll
            for (int b = 0; b < 2; ++b)
#pragma unroll
                for (int m = 0; m < 4; ++m)
#pragma unroll
                    for (int n = 0; n < 2; ++n) acc[a][b][m][n] = (f32x4){0.f, 0.f, 0.f, 0.f};
        cur = nxt; cA = nA; cA1 = nA1; cB = nB; cspec = nspec; ++ui;
        if constexpr (ALIGN_EPI) { if (wr == 1) PG8_BAR; }
    }
    PG8_WAIT_V(0); asm volatile("" :: "v"(pf_dummy));
    if constexpr (!ALIGN_EPI) { if (wr == 0) PG8_BAR; }
    PG8_BAR;
    if constexpr (Epi::AFTER_DRAIN) { E.fused(acc, cur, wr, wc, fr, fq, lds, wid, lane); S.done(cur); }
#undef PG8_SA
#undef PG8_SB
#undef PG8_STAGE
#undef PG8_STAGE_A1
#undef PG8_KO
#undef PG8_LDA
#undef PG8_LDB
#undef PG8_MMA
#undef PG8_WAIT_V
#undef PG8_WAIT_L
#undef PG8_BAR
#undef PG8_SCHED
}
}
namespace attn_body {
using bf16=__hip_bfloat16;
using bf16x8=__attribute__((ext_vector_type(8)))short;
using s16x4=__attribute__((ext_vector_type(4)))short;
using f32x16=__attribute__((ext_vector_type(16)))float;
using u32x4=__attribute__((ext_vector_type(4)))unsigned;
constexpr int BATCH=16,NHEAD=8,SEQ=2048,D=64; constexpr int QP=512,KP=128,VP=128,OP=1024,OCOL=512;
constexpr int NW=8,QBLK=32,QB=QBLK*NW,KVBLK=64,NQB=SEQ/QB;
constexpr int ATTN_UNIT_ROWS=QB;
__device__ __forceinline__ int crow(int r,int hi){return (r&3)+8*(r>>2)+4*hi;}
#define SBAR() __builtin_amdgcn_sched_barrier(0)
__device__ __forceinline__ void cmask(f32x16&p0,f32x16&p1,int jb,int qrel,int hi){
  const float NEG=-INFINITY; int kb=64*jb+4*hi;
  #pragma unroll
  for(int r=0;r<16;++r){int kv=kb+(r&3)+8*(r>>2); if(kv>qrel)p0[r]=NEG; if(kv+32>qrel)p1[r]=NEG;}
}

constexpr int NSLOT=3, SLOTB=8192;
constexpr int LDS_K=0, LDS_V=NSLOT*SLOTB, LDS_WS=2*NSLOT*SLOTB, LDS_OST=LDS_WS+NW*64*4, LDS_BYTES=LDS_OST+NW*4096;
constexpr float C2=0.125f*1.4426950408889634f;
__device__ __forceinline__ void glds16(const void*gsrc,unsigned lds_dst){unsigned keep;
  asm volatile("s_mov_b32 %0, m0\n\ts_mov_b32 m0, %2\n\ts_nop 0\n\tglobal_load_lds_dwordx4 %1, off\n\ts_mov_b32 m0, %0":"=&s"(keep):"v"(gsrc),"s"(lds_dst):"memory");}
__device__ __forceinline__ float max3f(float a,float b,float c){float r;asm("v_max3_f32 %0, %1, %2, %3":"=v"(r):"v"(a),"v"(b),"v"(c));return r;}
__device__ __forceinline__ float max2f(float a,float b){float r;asm("v_max_f32_e32 %0, %1, %2":"=v"(r):"v"(a),"v"(b));return r;}
__device__ __forceinline__ float fadd_s(float a,float b){float r;asm("v_add_f32_e32 %0, %1, %2":"=v"(r):"v"(a),"v"(b));return r;}
__device__ __forceinline__ float fsub_s(float a,float b){float r;asm("v_sub_f32_e32 %0, %1, %2":"=v"(r):"v"(a),"v"(b));return r;}
typedef float f32x2_t __attribute__((ext_vector_type(2))); typedef __bf16 bf16x2_t __attribute__((ext_vector_type(2)));
__device__ __forceinline__ unsigned cvtpk_s(float lo,float hi){f32x2_t v={lo,hi};bf16x2_t b=__builtin_convertvector(v,bf16x2_t);return __builtin_bit_cast(unsigned,b);}
#define WAIT_BAR(N) asm volatile("s_waitcnt vmcnt(" #N ") lgkmcnt(0)\n\ts_barrier":::"memory")

__device__ __forceinline__ void qkt(f32x16&p0,f32x16&p1,const char*Kslot,const bf16x8*qr,const f32x16&negm,int r32,int hi){
  const char*kb=Kslot+hi*1024+r32*16;
  #pragma unroll
  for(int d0=0;d0<4;++d0){
    const bf16x8 b0=*reinterpret_cast<const bf16x8*>(kb+d0*2048);
    const bf16x8 b1=*reinterpret_cast<const bf16x8*>(kb+d0*2048+512);
    if(d0==0){p0=__builtin_amdgcn_mfma_f32_32x32x16_bf16(b0,qr[0],negm,0,0,0);p1=__builtin_amdgcn_mfma_f32_32x32x16_bf16(b1,qr[0],negm,0,0,0);}
    else{p0=__builtin_amdgcn_mfma_f32_32x32x16_bf16(b0,qr[d0],p0,0,0,0);p1=__builtin_amdgcn_mfma_f32_32x32x16_bf16(b1,qr[d0],p1,0,0,0);}}
}
typedef __attribute__((address_space(3))) const char* lds_cptr;
typedef short v4i16_t __attribute__((ext_vector_type(4)));
__device__ __forceinline__ void kload8(bf16x8*kf,lds_cptr kp){
  kf[0]=*(const __attribute__((address_space(3))) bf16x8*)(kp);      kf[1]=*(const __attribute__((address_space(3))) bf16x8*)(kp+512);
  kf[2]=*(const __attribute__((address_space(3))) bf16x8*)(kp+2048); kf[3]=*(const __attribute__((address_space(3))) bf16x8*)(kp+2560);
  kf[4]=*(const __attribute__((address_space(3))) bf16x8*)(kp+4096); kf[5]=*(const __attribute__((address_space(3))) bf16x8*)(kp+4608);
  kf[6]=*(const __attribute__((address_space(3))) bf16x8*)(kp+6144); kf[7]=*(const __attribute__((address_space(3))) bf16x8*)(kp+6656);
}
__device__ __forceinline__ void kload2(bf16x8*kf,lds_cptr kp,int j){ kf[2*j]=*(const __attribute__((address_space(3))) bf16x8*)(kp+j*2048); kf[2*j+1]=*(const __attribute__((address_space(3))) bf16x8*)(kp+j*2048+512); }
__device__ __forceinline__ s16x4 vtr(lds_cptr p){ return __builtin_bit_cast(s16x4,__builtin_amdgcn_ds_read_tr16_b64_v4i16((__attribute__((address_space(3))) v4i16_t*)p)); }
__device__ __forceinline__ float rowmax(const f32x16&p0,const f32x16&p1){
  float a=max3f(p0[0],p0[1],p1[0]),b=max3f(p0[2],p0[3],p1[1]);a=max3f(a,p1[2],p1[3]);
  #pragma unroll
  for(int r=4;r<16;r+=4){a=max3f(a,p0[r],p0[r+1]);b=max3f(b,p0[r+2],p0[r+3]);a=max3f(a,p1[r],p1[r+1]);b=max3f(b,p1[r+2],p1[r+3]);}
  const float m=max2f(a,b);
  auto rr=__builtin_amdgcn_permlane32_swap(__float_as_uint(m),__float_as_uint(m),false,false);
  return max2f(__uint_as_float(rr[0]),__uint_as_float(rr[1]));
}
__device__ __forceinline__ void pv(f32x16*o,int vb,bf16x8 pa0,bf16x8 pa1,bf16x8 pa2,bf16x8 pa3){
  #pragma unroll
  for(int d0=0;d0<2;++d0){s16x4 lo[4],hi[4];
    #pragma unroll
    for(int ks=0;ks<4;++ks){
      asm volatile("ds_read_b64_tr_b16 %0,%1 offset:%c2":"=&v"(lo[ks]):"v"(vb),"i"(d0*4096+ks*1024):"memory");
      asm volatile("ds_read_b64_tr_b16 %0,%1 offset:%c2":"=&v"(hi[ks]):"v"(vb),"i"(d0*4096+ks*1024+512):"memory");}
    asm volatile("s_waitcnt lgkmcnt(0)":::"memory");SBAR();
    #define PK(k) (bf16x8){lo[k][0],lo[k][1],lo[k][2],lo[k][3],hi[k][0],hi[k][1],hi[k][2],hi[k][3]}
    o[d0]=__builtin_amdgcn_mfma_f32_32x32x16_bf16(pa0,PK(0),o[d0],0,0,0);
    o[d0]=__builtin_amdgcn_mfma_f32_32x32x16_bf16(pa1,PK(1),o[d0],0,0,0);
    o[d0]=__builtin_amdgcn_mfma_f32_32x32x16_bf16(pa2,PK(2),o[d0],0,0,0);
    o[d0]=__builtin_amdgcn_mfma_f32_32x32x16_bf16(pa3,PK(3),o[d0],0,0,0);
    #undef PK
  }
}

#ifndef ATTN_STORE16
#define ATTN_STORE16(p,v) (*(u32x4*)(p)=(v))
#endif
template<int THRL> __device__ __forceinline__ void attn_unit(float coff,int b,int h,int qb,const bf16*Q,const bf16*__restrict__ K,const bf16*__restrict__ V,bf16*O,char*shm){
  int tid_=threadIdx.x; asm volatile("":"+v"(tid_)); const int tid=tid_,lane=tid&63,r32=lane&31,hi=lane>>5; const int wid=__builtin_amdgcn_readfirstlane(tid>>6);
  const long rowbase=(long)b*SEQ; const int q0=qb*QB;
  const bf16*Qw=Q+(rowbase+q0+wid*QBLK)*QP+h*D;
  const int kvh=h>>2; const bf16*Kh=K+rowbase*KP+kvh*D,*Vh=V+rowbase*VP+kvh*D;
  const unsigned lds0=(unsigned)(uintptr_t)shm;
  float*wsf=(float*)(shm+LDS_WS)+wid*64;
  const bf16*ksrc=Kh+(long)lane*KP+wid*8;
  const bf16*vsrc=Vh+(long)(16*(wid&3)+(lane>>2))*VP+(wid>>2)*32+(lane&3)*8;
  const unsigned kdst=lds0+LDS_K+wid*1024, vdst=lds0+LDS_V+wid*1024;
  #define DMA_K(t,slot) glds16(ksrc+(long)(t)*KVBLK*KP,(unsigned)__builtin_amdgcn_readfirstlane(kdst+(slot)))
  #define DMA_V(t,slot) glds16(vsrc+(long)(t)*KVBLK*VP,(unsigned)__builtin_amdgcn_readfirstlane(vdst+(slot)))
  const int vb0=(int)(lds0+LDS_V)+((lane>>4)&1)*32+(lane&3)*8+(4*hi+((lane&15)>>2))*64;
  const char*Kbase=shm+LDS_K; bf16x8 kf[8];
  const lds_cptr shm3=(lds_cptr)shm; const lds_cptr kp0=shm3+LDS_K+hi*1024+r32*16; const lds_cptr vp0=shm3+LDS_V+((lane>>4)&1)*32+(lane&3)*8+(4*hi+((lane&15)>>2))*64;
  const int NT=SEQ/KVBLK;
  DMA_K(0,0);DMA_V(0,0);DMA_K(1,SLOTB);
  bf16x8 qr[4];
  #pragma unroll
  for(int d0=0;d0<4;++d0)qr[d0]=*reinterpret_cast<const bf16x8*>(&Qw[(long)r32*QP+d0*16+hi*8]);
  float mhat=0.f,l_reg=0.f;f32x16 o[2];o[0]=f32x16{};o[1]=f32x16{};f32x16 negm=f32x16{};
#ifdef ATTN_NOMAX
  _Pragma("unroll") for(int r=0;r<16;++r)negm[r]=-coff;
#endif
  asm volatile("":"+v"(negm));
  const int qrel=wid*QBLK+r32;
  #define CMASK(P0,P1,t) do{}while(0)
  bool resc=false;
#ifdef ATTN_NOMAX
  #define START(P0,P1) do{ resc=false; _Pragma("unroll") for(int r=0;r<16;++r)P0[r]=__builtin_amdgcn_exp2f(P0[r]); }while(0)
#else
  #define START(P0,P1) do{ const float rm=rowmax(P0,P1); resc=false; \
    { const float dl=rm; mhat=fadd_s(mhat,dl); \
      _Pragma("unroll") for(int r=0;r<16;++r){P0[r]=fsub_s(P0[r],dl);P1[r]=fsub_s(P1[r],dl);} \
      _Pragma("unroll") for(int r=0;r<16;++r)negm[r]=-mhat; asm volatile("":"+v"(negm)); } \
    _Pragma("unroll") for(int r=0;r<16;++r)P0[r]=__builtin_amdgcn_exp2f(P0[r]); }while(0)
#endif
  #define RESC() do{ if(resc){ asm volatile("s_waitcnt lgkmcnt(0)":::"memory"); \
      _Pragma("unroll") for(int d_=0;d_<2;++d_) _Pragma("unroll") for(int r=0;r<16;++r)o[d_][r]*=wsf[crow(r,hi)]; } }while(0)
  f32x16 pA0,pA1,pB0,pB1;
  int sl_prev=0,sl_cur=0,sl_next=SLOTB;
  #define ROT() do{sl_prev=sl_cur;sl_cur=sl_next;sl_next=(sl_next==(NSLOT-1)*SLOTB)?0:sl_next+SLOTB;}while(0)
  DMA_K(2,2*SLOTB);
  WAIT_BAR(3);
  qkt(pA0,pA1,Kbase,qr,negm,r32,hi);asm volatile("s_nop 15\n\ts_nop 7":"+v"(pA0),"+v"(pA1));CMASK(pA0,pA1,0);
  START(pA0,pA1);
  _Pragma("unroll") for(int r=0;r<16;++r)pA1[r]=__builtin_amdgcn_exp2f(pA1[r]);
  WAIT_BAR(0);
  DMA_K(3,0);DMA_V(1,SLOTB);
  ROT();
  kload8(kf,kp0+sl_cur);
  WAIT_BAR(2);
  s16x4 vlo[8],vhi[8]; u32x4 pw0,pw1,pw2,pw3;
  #define PKW(P,B) cvtpk_s(P[B],P[B+1])
  #define PAF(k) __builtin_bit_cast(bf16x8,pw##k)
  #define VFR(i) (bf16x8){vlo[i][0],vlo[i][1],vlo[i][2],vlo[i][3],vhi[i][0],vhi[i][1],vhi[i][2],vhi[i][3]}
  #define PIN(x) asm volatile("":"+v"(x))
  #define MX3(a,b,c) __builtin_fmaxf(__builtin_fmaxf((a),(b)),(c))
  #define GAPA(MF,A0,A1,A2,A3,W0,W1,PW) do{ MF; sacc+=A0; sacc+=A1; sacc+=A2; sacc+=A3; PIN(sacc); W0; W1; PIN(PW); SBAR(); }while(0)
  #define EX(v) __builtin_amdgcn_exp2f(v)
  #define GAPB(MF,X,B) do{ MF; X[B]=EX(X[B]); X[B+1]=EX(X[B+1]); X[B+2]=EX(X[B+2]); X[B+3]=EX(X[B+3]); PIN(X); SBAR(); }while(0)
  #define VRD(i) do{ vlo[i]=vtr(vp_+(((i)>>2)*4096+((i)&3)*1024)); vhi[i]=vtr(vp_+(((i)>>2)*4096+((i)&3)*1024+512)); }while(0)
  #define KRD(G,j) do{ if(G){ kload2(kf,kp0+sl_next,j); SBAR(); } }while(0)
#ifdef ATTN_NOMAX
  #define MAXBLOCK(C0,C1) do{}while(0)
#else
  #define MAXBLOCK(C0,C1) do{ \
    { float a=MX3(C0[0],C0[1],C1[0]),b=MX3(C0[2],C0[3],C1[1]); a=MX3(a,C1[2],C1[3]); \
      _Pragma("unroll") for(int r=4;r<16;r+=4){a=MX3(a,C0[r],C0[r+1]);b=MX3(b,C0[r+2],C0[r+3]);a=MX3(a,C1[r],C1[r+1]);b=MX3(b,C1[r+2],C1[r+3]);} \
      float rm=__builtin_fmaxf(a,b); { auto rr=__builtin_amdgcn_permlane32_swap(__float_as_uint(rm),__float_as_uint(rm),false,false); rm=__builtin_fmaxf(__uint_as_float(rr[0]),__uint_as_float(rr[1])); } \
      resc=false; \
      if(__builtin_expect(__any(rm>(float)THRL),0)){ const float dl=__builtin_fmaxf(rm,0.f); mhat+=dl; \
        _Pragma("unroll") for(int r=0;r<16;++r){C0[r]-=dl;C1[r]-=dl;} \
        _Pragma("unroll") for(int r=0;r<16;++r)negm[r]=-mhat; asm volatile("":"+v"(negm)); \
        const float f=__builtin_amdgcn_exp2f(-dl); l_reg*=f; if(hi==0)wsf[r32]=f; resc=true; } } \
  }while(0)
#endif
  #define STEP(C0,C1,P0,P1,t,GK,GV,GL) do{ SBAR(); \
    const lds_cptr vp_=vp0+sl_prev; \
    VRD(0); SBAR(); float sacc=(P0[0]+P0[1]); \
    GAPA(C0=__builtin_amdgcn_mfma_f32_32x32x16_bf16(kf[0],qr[0],negm,0,0,0), P0[2],P0[3],P0[4],P0[5],     pw0[0]=PKW(P0,0), pw0[1]=PKW(P0,2), pw0); \
    VRD(4); SBAR(); GAPA(C1=__builtin_amdgcn_mfma_f32_32x32x16_bf16(kf[1],qr[0],negm,0,0,0), P0[6],P0[7],P0[8],P0[9],     pw0[2]=PKW(P0,4), pw0[3]=PKW(P0,6), pw0); \
    VRD(1); SBAR(); GAPA(C0=__builtin_amdgcn_mfma_f32_32x32x16_bf16(kf[2],qr[1],C0,0,0,0),   P0[10],P0[11],P0[12],P0[13], pw1[0]=PKW(P0,8), pw1[1]=PKW(P0,10), pw1); \
    VRD(5); SBAR(); GAPA(C1=__builtin_amdgcn_mfma_f32_32x32x16_bf16(kf[3],qr[1],C1,0,0,0),   P0[14],P0[15],P1[0],P1[1],   pw1[2]=PKW(P0,12),pw1[3]=PKW(P0,14), pw1); \
    VRD(2); SBAR(); GAPA(C0=__builtin_amdgcn_mfma_f32_32x32x16_bf16(kf[4],qr[2],C0,0,0,0),   P1[2],P1[3],P1[4],P1[5],     pw2[0]=PKW(P1,0), pw2[1]=PKW(P1,2), pw2); \
    VRD(6); SBAR(); GAPA(C1=__builtin_amdgcn_mfma_f32_32x32x16_bf16(kf[5],qr[2],C1,0,0,0),   P1[6],P1[7],P1[8],P1[9],     pw2[2]=PKW(P1,4), pw2[3]=PKW(P1,6), pw2); \
    VRD(3); SBAR(); GAPA(C0=__builtin_amdgcn_mfma_f32_32x32x16_bf16(kf[6],qr[3],C0,0,0,0),   P1[10],P1[11],P1[12],P1[13], pw3[0]=PKW(P1,8), pw3[1]=PKW(P1,10), pw3); \
    VRD(7); SBAR(); GAPA(C1=__builtin_amdgcn_mfma_f32_32x32x16_bf16(kf[7],qr[3],C1,0,0,0),   P1[14],P1[15],0.f,0.f,       pw3[2]=PKW(P1,12),pw3[3]=PKW(P1,14), pw3); \
    l_reg+=sacc; \
    if(GK){DMA_K((t)+3,sl_cur);} if(GV){DMA_V((t)+1,sl_next);} \
    CMASK(C0,C1,t); \
    MAXBLOCK(C0,C1); \
    SBAR(); \
    GAPB(o[0]=__builtin_amdgcn_mfma_f32_32x32x16_bf16(PAF(0),VFR(0),o[0],0,0,0), C0,0); \
    GAPB(o[1]=__builtin_amdgcn_mfma_f32_32x32x16_bf16(PAF(0),VFR(4),o[1],0,0,0), C0,4); \
    KRD(GL,0); GAPB(o[0]=__builtin_amdgcn_mfma_f32_32x32x16_bf16(PAF(1),VFR(1),o[0],0,0,0), C0,8); \
    KRD(GL,1); GAPB(o[1]=__builtin_amdgcn_mfma_f32_32x32x16_bf16(PAF(1),VFR(5),o[1],0,0,0), C0,12); \
    KRD(GL,2); GAPB(o[0]=__builtin_amdgcn_mfma_f32_32x32x16_bf16(PAF(2),VFR(2),o[0],0,0,0), C1,0); \
    KRD(GL,3); GAPB(o[1]=__builtin_amdgcn_mfma_f32_32x32x16_bf16(PAF(2),VFR(6),o[1],0,0,0), C1,4); \
    GAPB(o[0]=__builtin_amdgcn_mfma_f32_32x32x16_bf16(PAF(3),VFR(3),o[0],0,0,0), C1,8); \
    GAPB(o[1]=__builtin_amdgcn_mfma_f32_32x32x16_bf16(PAF(3),VFR(7),o[1],0,0,0), C1,12); \
    }while(0)
  int t=1;
  #undef CMASK
  #define CMASK(P0,P1,t) do{}while(0)
  for(;t+5<NT;t+=2){
    STEP(pB0,pB1,pA0,pA1,t,true,true,true);     WAIT_BAR(2); RESC(); ROT();
    STEP(pA0,pA1,pB0,pB1,t+1,true,true,true);   WAIT_BAR(2); RESC(); ROT();
  }
  #undef CMASK
  #define CMASK(P0,P1,t) do{}while(0)
  #define ENDW(tt) do{ if((tt)+3<NT){WAIT_BAR(2);} else if((tt)+2<NT){WAIT_BAR(1);} else {WAIT_BAR(0);} }while(0)
  for(;t+1<NT;t+=2){
    STEP(pB0,pB1,pA0,pA1,t,(t+3<NT),(t+1<NT),(t+1<NT));       ENDW(t);   RESC(); ROT();
    STEP(pA0,pA1,pB0,pB1,t+1,(t+4<NT),(t+2<NT),(t+2<NT));     ENDW(t+1); RESC(); ROT();
  }
  STEP(pB0,pB1,pA0,pA1,NT-1,false,false,false); RESC();
  { float sacc=pB0[0]+pB0[1]; _Pragma("unroll") for(int r=2;r<16;++r)sacc+=pB0[r]; _Pragma("unroll") for(int r=0;r<16;++r)sacc+=pB1[r]; l_reg+=sacc;
    pw0=(u32x4){PKW(pB0,0),PKW(pB0,2),PKW(pB0,4),PKW(pB0,6)};pw1=(u32x4){PKW(pB0,8),PKW(pB0,10),PKW(pB0,12),PKW(pB0,14)};pw2=(u32x4){PKW(pB1,0),PKW(pB1,2),PKW(pB1,4),PKW(pB1,6)};pw3=(u32x4){PKW(pB1,8),PKW(pB1,10),PKW(pB1,12),PKW(pB1,14)};
    SBAR(); pv(o,vb0+sl_cur,PAF(0),PAF(1),PAF(2),PAF(3)); }
  #undef PKW
  #undef PAF
  #undef VFR
  #undef PIN
  #undef MX3
  #undef GAPA
  #undef GAPB
  #undef EX
  #undef VRD
  #undef KRD
  #undef STEP
  #undef ENDW
  {auto rr=__builtin_amdgcn_permlane32_swap(__float_as_uint(l_reg),__float_as_uint(l_reg),false,false);l_reg=__uint_as_float(rr[0])+__uint_as_float(rr[1]);}
  if(hi==0)wsf[32+r32]=l_reg;asm volatile("s_waitcnt lgkmcnt(0)":::"memory");
  float rli[16];
  #pragma unroll
  for(int r=0;r<16;++r)rli[r]=__builtin_amdgcn_rcpf(wsf[32+crow(r,hi)]);
  bf16*Ow=O+(rowbase+q0+wid*QBLK)*OP+OCOL+h*D;
  { bf16*stg=(bf16*)(shm+LDS_OST)+wid*2048;
    #pragma unroll
    for(int r=0;r<16;++r){const int orow=crow(r,hi);
      #pragma unroll
      for(int d0=0;d0<2;++d0)stg[orow*64+d0*32+r32]=__float2bfloat16(o[d0][r]*rli[r]);}
    asm volatile("s_waitcnt lgkmcnt(0)":::"memory");
    #pragma unroll
    for(int i=0;i<4;++i){const int row=i*8+(lane>>3),ch=lane&7; const u32x4 v=*(const u32x4*)(stg+row*64+ch*8); ATTN_STORE16(Ow+(long)row*OP+ch*8,v);} }
  asm volatile("s_waitcnt lgkmcnt(0)\n\ts_barrier":::"memory");
  #undef DMA_K
  #undef DMA_V
  #undef CMASK
  #undef START
  #undef RESC
  #undef ROT
}
constexpr int ATTN_LDS_BYTES=LDS_BYTES;
struct AttnTensors { const bf16* Q; const bf16* K; const bf16* V; bf16* O; };
struct AttnUnit { int b, h, qb; };
struct AttnOrder {
  int vcu, G;
  __device__ __forceinline__ AttnOrder(int grid,int v):vcu(v),G(grid){}
  __device__ __forceinline__ bool next(int i,AttnUnit&u)const{ const int L=i*G+vcu; if(L>=1024)return false; const int hq=L>>8, rem=L&255, grp=rem>>3; u.qb=rem&7; u.b=grp>>1; u.h=(grp&1)*4+hq; return true; }
  __device__ __forceinline__ void a_ready(const AttnUnit&)const{}
  __device__ __forceinline__ void done(const AttnUnit&)const{}
};
template<class Sched,int THRL=8> __device__ __forceinline__ void attn_phase(char*lds,const AttnTensors&T,const Sched&S,float coff){
  AttnUnit u;
  for(int i=0;S.next(i,u);++i){ S.a_ready(u); attn_unit<THRL>(coff,u.b,u.h,u.qb,T.Q,T.K,T.V,T.O,lds); S.done(u); }
}
#undef SBAR
#undef WAIT_BAR
}
#define GAS __attribute__((address_space(1)))
#define LAS __attribute__((address_space(3)))
typedef unsigned short bf16;
typedef unsigned v4u __attribute__((ext_vector_type(4)));
typedef float f32x4 __attribute__((ext_vector_type(4)));
typedef short bf16x8 __attribute__((ext_vector_type(8)));
typedef GAS unsigned gu32;
typedef GAS unsigned long long gu64;
#define RLX_AGENT __ATOMIC_RELAXED, __HIP_MEMORY_SCOPE_AGENT
#define LDS_WAIT() asm volatile("s_waitcnt lgkmcnt(0)" ::: "memory")
#define VM_WAIT() asm volatile("s_waitcnt vmcnt(0)" ::: "memory")
__device__ __forceinline__ unsigned long long rt() { return __builtin_amdgcn_s_memrealtime(); }
__device__ __forceinline__ unsigned f2bf(float f) { unsigned u = __builtin_bit_cast(unsigned, f); return (u + 0x7fffu + ((u >> 16) & 1u)) >> 16; }
__device__ __forceinline__ unsigned pk2(float lo, float hi) { return f2bf(lo) | (f2bf(hi) << 16); }

#define XB_TMO      128
#define XB_XCNT(j)  (256  + 64 * (j))
#define XB_XSUB(j)  (1280 + 64 * (j))
#define XB_XGEN(j)  (2304 + 64 * (j))
#define XB_TOP      3328
#define XB_TOPGEN   3392
#define XCD_BAR_WORDS 3456
#define XB_SPIN_CAP (1u << 18)

__device__ __forceinline__ unsigned xb_ld(unsigned* p)              { return __hip_atomic_load(p, __ATOMIC_RELAXED, __HIP_MEMORY_SCOPE_AGENT); }
__device__ __forceinline__ unsigned xb_add(unsigned* p, unsigned v) { return __hip_atomic_fetch_add(p, v, __ATOMIC_RELAXED, __HIP_MEMORY_SCOPE_AGENT); }
__device__ __forceinline__ unsigned xb_xcc_id() { return (unsigned)__builtin_amdgcn_s_getreg((3 << 11) | 20) & 0xFu; }
#define XB_SPIN(cond, bar) do { unsigned _sp = 0; while (cond) { __builtin_amdgcn_s_sleep(1); \
    if ((++_sp & 255u) == 0u) { if (xb_ld(&(bar)[XB_TMO])) break; if (_sp > XB_SPIN_CAP) { atomicAdd(&(bar)[XB_TMO], 1u); break; } } } } while (0)

struct XcdBarrier {
    unsigned* bar; unsigned x;
    volatile LAS unsigned* st;
};

__device__ __forceinline__ XcdBarrier xcd_barrier_post(unsigned* bar, volatile LAS unsigned* st) {
    XcdBarrier b; b.bar = bar; b.x = xb_xcc_id(); b.st = st;
    if (threadIdx.x == 0) (void)xb_add(&bar[XB_XCNT(b.x)], 1u);
    return b;
}
__device__ __forceinline__ void xcd_barrier_complete(unsigned* bar, unsigned x, unsigned& nloc, unsigned& nx) {
    const unsigned G = gridDim.x * gridDim.y * gridDim.z;
    unsigned sum, cnt, mine, sp = 0u;
    for (;;) {
        sum = 0u; cnt = 0u; mine = 0u;
#pragma unroll
        for (unsigned j = 0; j < 16; ++j) { const unsigned c = xb_ld(&bar[XB_XCNT(j)]); sum += c; cnt += (c > 0u) ? 1u : 0u; mine = (j == x) ? c : mine; }
        if (sum == G) break;
        __builtin_amdgcn_s_sleep(1);
        if ((++sp & 255u) == 0u) { if (xb_ld(&bar[XB_TMO])) break; if (sp > XB_SPIN_CAP) { atomicAdd(&bar[XB_TMO], 1u); break; } }
    }
    nloc = mine > 0u ? mine : 1u; nx = cnt > 0u ? cnt : 1u;
}

__device__ __forceinline__ void xcd_barrier(const XcdBarrier& b) {
    asm volatile("s_waitcnt vmcnt(0)" ::: "memory");
    __syncthreads();
    if (threadIdx.x == 0) {
        unsigned* bar = b.bar;
        __builtin_amdgcn_s_waitcnt(0);
        unsigned nloc = b.st[0], nx = b.st[1];
        if (nloc == 0u) { xcd_barrier_complete(bar, b.x, nloc, nx); b.st[0] = nloc; b.st[1] = nx; }
        const unsigned old = xb_add(&bar[XB_XSUB(b.x)], 1u);
        const unsigned gen = old / nloc;
        if (old + 1u == (gen + 1u) * nloc) {
            __builtin_amdgcn_fence(__ATOMIC_RELEASE, "agent");
            asm volatile("s_waitcnt vmcnt(0)" ::: "memory");
            const unsigned og = xb_add(&bar[XB_TOP], 1u);
            const unsigned tg = og / nx;
            if (og + 1u == (tg + 1u) * nx) xb_add(&bar[XB_TOPGEN], 1u);
            else XB_SPIN(xb_ld(&bar[XB_TOPGEN]) == tg, bar);
            __builtin_amdgcn_fence(__ATOMIC_ACQUIRE, "agent");
            xb_add(&bar[XB_XGEN(b.x)], 1u);
            asm volatile("s_waitcnt vmcnt(0)" ::: "memory");
        } else {
            __builtin_amdgcn_fence(__ATOMIC_ACQUIRE, "agent");
            XB_SPIN(xb_ld(&bar[XB_XGEN(b.x)]) == gen, bar);
            asm volatile("s_waitcnt vmcnt(0)" ::: "memory");
        }
    }
    __syncthreads();
}

constexpr int NWAVES = 8;
#ifndef MK_N_LAUNCHES
#define MK_N_LAUNCHES 1
#endif
#ifndef PHASE_MASK
#define PHASE_MASK 0x1ff
#endif
#define PH_ON(k) ((PHASE_MASK >> (k)) & 1)
constexpr int N_PHASES = 8;
constexpr int N_LAUNCHES = MK_N_LAUNCHES;
static_assert(N_LAUNCHES == 1 || N_LAUNCHES == N_PHASES, "MK_N_LAUNCHES is 1 or 8");

constexpr int BATCH = 16, SEQ = 2048, DM = 1024, M = BATCH * SEQ, DFF = 2752, DFFP = 2816, NGU = 2 * DFFP, NIN = 1280, INW = 1280;
constexpr size_t MiB = 1u << 20;
constexpr size_t WS_CTL = 0, CTL_ZERO_BYTES = 128 * 1024;
constexpr size_t WS_W1 = 2 * MiB, WS_WD1 = 13 * MiB, WS_W2 = 19 * MiB, WS_WD2 = 30 * MiB, WS_WIN = 36 * MiB, WS_WOUT = 40 * MiB, WS_DFT = 42 * MiB;
constexpr size_t WS_MISC = 58 * MiB;
constexpr size_t WS_STATS = 59 * MiB;
constexpr size_t WS_XB = 67 * MiB;
constexpr size_t WS_ACT = 131 * MiB;
constexpr size_t WS_XT = 131 * MiB, WS_Q = 195 * MiB, WS_K = 227 * MiB, WS_V = 235 * MiB, WS_MIX = 243 * MiB;
constexpr size_t WS_X1 = 307 * MiB;
constexpr size_t WS_END = 435 * MiB;
static_assert(WS_W1 + (size_t)NGU * DM * 2 <= WS_WD1 && WS_WD1 + (size_t)DM * DFFP * 2 <= WS_W2 && WS_W2 + (size_t)NGU * DM * 2 <= WS_WD2 && WS_WD2 + (size_t)DM * DFFP * 2 <= WS_WIN, "ws map 1");
static_assert(WS_WIN + (size_t)NIN * DM * 2 <= WS_WOUT && WS_WOUT + (size_t)DM * DM * 2 <= WS_DFT && WS_DFT + (size_t)2048 * 4096 * 2 <= WS_MISC && WS_STATS + 4 * (size_t)M * 16 * 4 <= WS_XB, "ws map 2");
static_assert(WS_XB + (size_t)M * DM * 2 <= WS_ACT && WS_ACT + (size_t)M * DFFP * 2 <= WS_X1 && WS_XT + (size_t)BATCH * 4 * 256 * 1024 * 2 <= WS_Q && WS_Q + (size_t)M * 512 * 2 <= WS_K, "ws map 3");
static_assert(WS_K + (size_t)M * 128 * 2 <= WS_V && WS_V + (size_t)M * 128 * 2 <= WS_MIX && WS_MIX + (size_t)M * DM * 2 <= WS_X1 && WS_X1 + (size_t)M * DM * 4 <= WS_END, "ws map 4");
constexpr int CW_BAR = 4096;
constexpr int CW_SEAM = 16384;
constexpr int RING_BYTES = 131072;
constexpr int EPI_STAGE_BYTES = 8 * 2560;
constexpr int LDSCTL_OFF = RING_BYTES + EPI_STAGE_BYTES, MISC_OFF = LDSCTL_OFF + 320;
constexpr int LDS_BYTES = 163840;
static_assert(MISC_OFF + 128 <= pg8::WIN_TBL_OFF && pg8::WIN_TBL_OFF + 8704 <= LDS_BYTES && pg8::STAGE_BYTES == RING_BYTES && attn_body::ATTN_LDS_BYTES <= RING_BYTES, "LDS map");

template <int CTRL> __device__ __forceinline__ float dpp_mov(float v) { return __builtin_bit_cast(float, __builtin_amdgcn_update_dpp(0, __builtin_bit_cast(int, v), CTRL, 0xf, 0xf, false)); }
__device__ __forceinline__ float wave_sum(float v) {
    v += dpp_mov<0xB1>(v);
    v += dpp_mov<0x4E>(v);
    v += dpp_mov<0x141>(v);
    v += dpp_mov<0x140>(v);
    return pg8::xsum32(pg8::xsum16(v));
}
__device__ __forceinline__ float wave_max(float v) {
    v = fmaxf(v, dpp_mov<0xB1>(v)); v = fmaxf(v, dpp_mov<0x4E>(v)); v = fmaxf(v, dpp_mov<0x141>(v)); v = fmaxf(v, dpp_mov<0x140>(v));
    { const auto r = __builtin_amdgcn_permlane16_swap(__float_as_uint(v), __float_as_uint(v), false, false); const unsigned r0 = r[0], r1 = r[1]; v = fmaxf(__uint_as_float(r0), __uint_as_float(r1)); }
    { const auto r = __builtin_amdgcn_permlane32_swap(__float_as_uint(v), __float_as_uint(v), false, false); const unsigned r0 = r[0], r1 = r[1]; v = fmaxf(__uint_as_float(r0), __uint_as_float(r1)); }
    return v;
}
__device__ __forceinline__ void p0_transpose_item(const float* __restrict__ W, int N, int k0, int n0, bf16* __restrict__ dst, int ldk, const float* __restrict__ gain, LAS float* scr, int lane) {
    const int kk = lane >> 3, nq = lane & 7;
    f32x4 v[8];
#pragma unroll
    for (int i = 0; i < 8; ++i) v[i] = __builtin_nontemporal_load((const f32x4*)(W + (size_t)(k0 + 8 * i + kk) * N + n0 + 4 * nq));
#pragma unroll
    for (int i = 0; i < 8; ++i) { const float gsc = gain ? gain[k0 + 8 * i + kk] : 1.0f; LAS float* p = scr + (8 * i + kk) * 33 + 4 * nq;
        p[0] = v[i][0] * gsc; p[1] = v[i][1] * gsc; p[2] = v[i][2] * gsc; p[3] = v[i][3] * gsc; }
    LDS_WAIT(); asm volatile("" ::: "memory");
    const int c = lane & 7;
#pragma unroll
    for (int j = 0; j < 4; ++j) { const int n = (lane >> 3) + 8 * j; const LAS float* s = scr + (8 * c) * 33 + n;
        v4u o; o.x = pk2(s[0 * 33], s[1 * 33]); o.y = pk2(s[2 * 33], s[3 * 33]); o.z = pk2(s[4 * 33], s[5 * 33]); o.w = pk2(s[6 * 33], s[7 * 33]);
        *(v4u*)(dst + (size_t)n * ldk + k0 + 8 * c) = o; }
    LDS_WAIT(); asm volatile("" ::: "memory");
}

struct Args { const float* in[17]; float* out; unsigned char* ws; int ph_lo, ph_hi, li, pad; };

__global__ void __launch_bounds__(NWAVES * 64, 2) mk_fwd(Args args) {
    extern __shared__ __attribute__((aligned(16))) unsigned char lds[];
    LAS unsigned char* const ldsp = (LAS unsigned char*)lds;
    volatile LAS unsigned* const MISC = (volatile LAS unsigned*)(ldsp + MISC_OFF);
    const int tid0 = threadIdx.x;
    gu32* const ctl = (gu32*)(args.ws + WS_CTL);
    for (int u = tid0; u < (LDS_BYTES - LDSCTL_OFF) / 4; u += NWAVES * 64) ((LAS unsigned*)(ldsp + LDSCTL_OFF))[u] = 0u;
    __syncthreads();
    XcdBarrier bar; bar.bar = (unsigned*)(ctl + CW_BAR); bar.x = 0; bar.st = nullptr;
    if (N_LAUNCHES == 1) bar = xcd_barrier_post((unsigned*)(ctl + CW_BAR), MISC + 8);
#ifndef PROBE_BAR2
#define PROBE_BAR2 0
#endif
#define GRID_BAR() do { if (N_LAUNCHES == 1) { xcd_barrier(bar); if (PROBE_BAR2) xcd_barrier(bar); } } while (0)
    const int lo = args.ph_lo, hi = args.ph_hi;

#ifndef PROBE_REPEAT
#define PROBE_REPEAT 0
#endif
    for (int ph2 = 2 * lo; ph2 < 2 * hi; ++ph2) {
        const int ph = ph2 >> 1;
        if ((ph2 & 1) && !((PROBE_REPEAT >> ph) & 1)) continue;
        const __attribute__((address_space(4))) Args* ap = (const __attribute__((address_space(4))) Args*)__builtin_amdgcn_kernarg_segment_ptr(); asm volatile("" : "+s"(ap));
        int tid_ = threadIdx.x; asm volatile("" : "+v"(tid_));
        int G = gridDim.x, bx = blockIdx.x; asm volatile("" : "+s"(G), "+s"(bx));
        const int vcu = (G % 8 == 0) ? (bx % 8) * (G / 8) + bx / 8 : bx, NGW = G * NWAVES;
        const bool late_ok = (G == 256);
        const int tid = tid_, lane = tid & 63, wave = __builtin_amdgcn_readfirstlane(tid >> 6), gw = vcu * NWAVES + wave;
        unsigned char* const ws = ap->ws;
        const float* const x = ap->in[0];
        const float* const g_ffn1 = ap->in[1]; const float* const w_gate1 = ap->in[2]; const float* const w_up1 = ap->in[3]; const float* const w_down1 = ap->in[4];
        const float* const g_mix = ap->in[5]; const float* const w_in = ap->in[6]; const float* const fnet_w = ap->in[7]; const float* const fnet_b = ap->in[8];
        const float* const q_norm = ap->in[9]; const float* const k_norm = ap->in[10]; const float* const w_out = ap->in[11];
        const float* const g_ffn2 = ap->in[12]; const float* const w_gate2 = ap->in[13]; const float* const w_up2 = ap->in[14]; const float* const w_down2 = ap->in[15];
        const float* const g_final = ap->in[16];
        float* const out = ap->out;
        bf16* const W1 = (bf16*)(ws + WS_W1); bf16* const WD1 = (bf16*)(ws + WS_WD1); bf16* const W2 = (bf16*)(ws + WS_W2); bf16* const WD2 = (bf16*)(ws + WS_WD2);
        bf16* const WIN = (bf16*)(ws + WS_WIN); bf16* const WOUT = (bf16*)(ws + WS_WOUT); bf16* const DFT = (bf16*)(ws + WS_DFT);
        float* const BIASP = (float*)(ws + WS_MISC); float* const ROPEC = (float*)(ws + WS_MISC + 4096); float* const ROPES = (float*)(ws + WS_MISC + 8192); float* const TV = (float*)(ws + WS_MISC + 16384); float* const ALTP = (float*)(ws + WS_MISC + 65536);
        float* const ST1 = (float*)(ws + WS_STATS); float* const ST2 = ST1 + (size_t)M * 16; float* const ST3 = ST2 + (size_t)M * 16; float* const ST4 = ST3 + (size_t)M * 16;
        bf16* const XB = (bf16*)(ws + WS_XB); bf16* const ACT = (bf16*)(ws + WS_ACT); bf16* const XT = (bf16*)(ws + WS_XT);
        bf16* const QB_ = (bf16*)(ws + WS_Q); bf16* const KB_ = (bf16*)(ws + WS_K); bf16* const VB_ = (bf16*)(ws + WS_V); bf16* const MIX = (bf16*)(ws + WS_MIX);
        float* const X1 = (float*)(ws + WS_X1);

#ifdef PROBE_CLOCK
        unsigned long long pc_t0 = 0, pc_r0 = 0;
        if (ph == PROBE_CLOCK) { pc_t0 = __builtin_amdgcn_s_memtime(); pc_r0 = __builtin_amdgcn_s_memrealtime(); }
#endif
        if (ph == 0 && PH_ON(0)) {
            LAS float* scr = (LAS float*)(ldsp + wave * 16384);
            const int gw0 = wave * G + bx;
            const int n1_ = 2752 * (late_ok ? 1 : 2), n2_ = 1376 * (late_ok ? 1 : 2);
            const int o2_ = n1_ % NGW, o3_ = (o2_ + n2_) % NGW, o4_ = (o3_ + 384) % NGW, o5_ = (o4_ + 1024) % NGW;
#define ROT_START(off) ((gw0 + NGW - (off)) % NGW)
            for (int it = 2752 * 0 + gw0; it < 2752 * (late_ok ? 1 : 2); it += NGW) {
                const int f = it / 2752, r = it % 2752, mat = r / 1376, r2 = r % 1376, kb = r2 / 86, nb = r2 % 86, n0 = nb * 32;
                const int drow = 256 * (n0 >> 7) + (n0 & 127) + 128 * mat;
                const float* Wsrc = f ? (mat ? w_up2 : w_gate2) : (mat ? w_up1 : w_gate1);
                p0_transpose_item(Wsrc, DFF, kb * 64, n0, (f ? W2 : W1) + (size_t)drow * DM, DM, f ? g_ffn2 : g_ffn1, scr, lane);
            }
            for (int it = ROT_START(o2_); it < 1376 * (late_ok ? 1 : 2); it += NGW) {
                const int f = it / 1376, r = it % 1376, kb = r / 32, nb = r % 32;
                p0_transpose_item(f ? w_down2 : w_down1, DM, kb * 64, nb * 32, (f ? WD2 : WD1) + (size_t)(nb * 32) * DFFP, DFFP, nullptr, scr, lane);
            }
            unsigned zz = 0u; asm volatile("" : "+v"(zz)); const v4u zero4 = {zz, zz, zz, zz};
            for (int it = ROT_START(o5_); it < 256 * (late_ok ? 1 : 2); it += NGW) {
                const int f = it >> 8, r = (it >> 1) & 127, hh = it & 1; const int row = 256 * 21 + 64 + (r & 63) + 128 * (r >> 6);
                *(v4u*)((f ? W2 : W1) + (size_t)row * DM + hh * 512 + lane * 8) = zero4;
            }
            for (int it = ROT_START(o5_); it < 128 * (late_ok ? 1 : 2); it += NGW) {
                const int f = it >> 7, row = (it & 127) * 8 + (lane >> 3);
                *(v4u*)((f ? WD2 : WD1) + (size_t)row * DFFP + DFF + (lane & 7) * 8) = zero4;
            }
            for (int it = ROT_START(o3_); it < 384; it += NGW) {
                const int kb = it / 24, blk = it % 24, bjj = blk & 1; int drow;
                if (blk < 16) { const int head = blk >> 1; drow = 256 * (2 + (head >> 2)) + 128 * bjj + 32 * (head & 3); }
                else if (blk < 20) { drow = 1024 + 128 * bjj + 32 * ((blk - 16) >> 1); }
                else { drow = 1024 + 128 * bjj + 32 * (2 + ((blk - 20) >> 1)); }
                p0_transpose_item(w_in, INW, kb * 64, 512 + 32 * blk, WIN + (size_t)drow * DM, DM, g_mix, scr, lane);
            }
            if (!late_ok) {
            for (int it = gw0; it < 256; it += NGW) {
                const int kb = 8 + it / 32, nb = it % 32;
                p0_transpose_item(w_out, DM, kb * 64, nb * 32, WOUT + (size_t)(nb * 32) * DM, DM, nullptr, scr, lane);
            }
            for (int it = gw0; it < 1024; it += NGW) {
                const int g = it >> 8, cb = (it >> 4) & 15, n = (it & 15) * 64 + lane;
                LAS float* Fl = scr;
                { const int r = lane >> 3, d0 = (lane & 7) * 16, ps = cb * 8 + r; const float* fp = fnet_w + (size_t)(g * 128 + (ps <= 64 ? ps : 192 - ps) - r) * 128;
                  f32x4 f4[4];
#pragma unroll
                  for (int e = 0; e < 4; ++e) f4[e] = *(const f32x4*)(fp + r * 128 + d0 + 4 * e);
#pragma unroll
                  for (int e = 0; e < 4; ++e)
#pragma unroll
                      for (int j = 0; j < 4; ++j) Fl[(d0 + 4 * e + j) * 8 + r] = f4[e][j]; }
                LDS_WAIT(); asm volatile("" ::: "memory");
                float a[8];
#pragma unroll
                for (int cc = 0; cc < 8; ++cc) a[cc] = 0.f;
                const float* wo = w_out + (size_t)(g * 128) * DM + n;
                for (int d = 0; d < 128; d += 16) {
                    float bq[16];
#pragma unroll
                    for (int e = 0; e < 16; ++e) bq[e] = wo[(size_t)(d + e) * DM];
#pragma unroll
                    for (int e = 0; e < 16; ++e) { const f32x4 fa = *(const LAS f32x4*)(Fl + (d + e) * 8), fb = *(const LAS f32x4*)(Fl + (d + e) * 8 + 4);
#pragma unroll
                        for (int cc = 0; cc < 4; ++cc) { a[cc] += fa[cc] * bq[e]; a[4 + cc] += fb[cc] * bq[e]; } }
                }
                v4u o; o.x = pk2(a[0], a[1]); o.y = pk2(a[2], a[3]); o.z = pk2(a[4], a[5]); o.w = pk2(a[6], a[7]);
                *(v4u*)(WOUT + (size_t)n * DM + g * 128 + cb * 8) = o;
                LDS_WAIT(); asm volatile("" ::: "memory");
            }
            for (int it = gw0; it < 128; it += NGW) {
                f32x4 p0 = {0.f, 0.f, 0.f, 0.f}, p1 = {0.f, 0.f, 0.f, 0.f}; f32x4 wv[8][2]; float fb[8];
#pragma unroll
                for (int i = 0; i < 8; ++i) { const int r = lane + 64 * i; fb[i] = fnet_b[r]; wv[i][0] = *(const f32x4*)(w_out + (size_t)r * DM + it * 8); wv[i][1] = *(const f32x4*)(w_out + (size_t)r * DM + it * 8 + 4); }
#pragma unroll
                for (int i = 0; i < 8; ++i) { p0 += wv[i][0] * fb[i]; p1 += wv[i][1] * fb[i]; }
                float o8[8];
#pragma unroll
                for (int j = 0; j < 4; ++j) { o8[j] = wave_sum(p0[j]); o8[4 + j] = wave_sum(p1[j]); }
                if (lane == 0) { *(f32x4*)(BIASP + it * 8) = (f32x4){o8[0], o8[1], o8[2], o8[3]}; *(f32x4*)(BIASP + it * 8 + 4) = (f32x4){o8[4], o8[5], o8[6], o8[7]}; }
            }
            }
            for (int it = ROT_START(o4_); it < 1024; it += NGW) {
                const int kb8 = it >> 3, g = (it >> 1) & 3, q = it & 1, c = lane; const bool spec = q && (lane == 0);
                LAS float* T = scr;
                LAS float* Wl = scr + 256;
                { const float a0 = (float)lane * (1.0f / 64.0f), a1 = (float)(lane + 64) * (1.0f / 64.0f); T[lane] = q ? sinpif(a0) : cospif(a0); T[lane + 64] = q ? sinpif(a1) : cospif(a1); }
                { const int r = lane >> 3, c0 = (lane & 7) * 16; const float* wp = w_in + (size_t)(kb8 * 8 + r) * INW + g * 128 + c0; const float gk = g_mix[kb8 * 8 + r];
                  f32x4 w4[4];
#pragma unroll
                  for (int e = 0; e < 4; ++e) w4[e] = *(const f32x4*)(wp + 4 * e);
#pragma unroll
                  for (int e = 0; e < 4; ++e)
#pragma unroll
                      for (int j = 0; j < 4; ++j) Wl[(c0 + 4 * e + j) * 8 + r] = w4[e][j] * gk; }
                LDS_WAIT(); asm volatile("" ::: "memory");
                float ac[8];
#pragma unroll
                for (int kk = 0; kk < 8; ++kk) ac[kk] = 0.f;
#pragma unroll 4
                for (int cp = 0; cp < 128; ++cp) {
                    const f32x4 wa = *(const LAS f32x4*)(Wl + cp * 8), wb = *(const LAS f32x4*)(Wl + cp * 8 + 4);
                    const float tt = T[(cp * c) & 127]; const float t = spec ? ((cp & 1) ? -1.0f : 1.0f) : tt;
#pragma unroll
                    for (int kk = 0; kk < 4; ++kk) { ac[kk] += wa[kk] * t; ac[4 + kk] += wb[kk] * t; }
                }
                v4u o; o.x = pk2(ac[0], ac[1]); o.y = pk2(ac[2], ac[3]); o.z = pk2(ac[4], ac[5]); o.w = pk2(ac[6], ac[7]);
                *(v4u*)(WIN + (size_t)((g >> 1) * 256 + q * 128 + (g & 1) * 64 + c) * DM + kb8 * 8) = o;
                LDS_WAIT(); asm volatile("" ::: "memory");
            }
            if (!late_ok) {
            for (int it = gw0; it < 4096; it += NGW) {
                const int row = it >> 1, hh = it & 1, kb = row >> 8, r = row & 255, k = 128 * kb + (r & 127), n0 = hh * 512 + lane * 8; float v[8];
#pragma unroll
                for (int e = 0; e < 8; ++e) { const float ph_ = (float)((k * (n0 + e)) & 2047) * (1.0f / 1024.0f); v[e] = (r < 128 ? cospif(ph_) : sinpif(ph_)) * (1.0f / 512.0f); }
                v4u o; o.x = pk2(v[0], v[1]); o.y = pk2(v[2], v[3]); o.z = pk2(v[4], v[5]); o.w = pk2(v[6], v[7]);
                *(v4u*)(DFT + (size_t)row * 1024 + n0) = o;
            }
            }
            if (gw0 == 0) {
#pragma unroll
                for (int e = 0; e < 16; ++e) { const float inv = powf(10000.0f, -(float)(2 * e) / 32.0f); const float ang = (float)lane * inv; ROPEC[lane * 16 + e] = cosf(ang); ROPES[lane * 16 + e] = sinf(ang); }
            }
            for (int m0 = gw0 * 4; m0 < M; m0 += NGW * 4) {
                f32x4 v[4][4];
#pragma unroll
                for (int r = 0; r < 4; ++r)
#pragma unroll
                    for (int j = 0; j < 4; ++j) v[r][j] = __builtin_nontemporal_load((const f32x4*)(x + (size_t)(m0 + r) * DM) + lane + 64 * j);
#pragma unroll
                for (int r = 0; r < 4; ++r) { float s = 0.f;
#pragma unroll
                    for (int j = 0; j < 4; ++j) s += (v[r][j][0] * v[r][j][0] + v[r][j][1] * v[r][j][1]) + (v[r][j][2] * v[r][j][2] + v[r][j][3] * v[r][j][3]);
                    s = wave_sum(s);
                    unsigned long long* o8 = (unsigned long long*)(XB + (size_t)(m0 + r) * DM) + lane;
#pragma unroll
                    for (int j = 0; j < 4; ++j) o8[64 * j] = (unsigned long long)pk2(v[r][j][0], v[r][j][1]) | ((unsigned long long)pk2(v[r][j][2], v[r][j][3]) << 32);
                    if (lane < 16) ST1[(size_t)(m0 + r) * 16 + lane] = s * (1.0f / 16.0f); }
            }
            __syncthreads();
        } else if ((ph == 1 || ph == 6) && PH_ON(1)) {
#ifndef GEMM_KROT
#define GEMM_KROT 0
#endif
#ifndef PROBE_HALFCU
#define PROBE_HALFCU 0
#endif
            ((LAS unsigned*)(ldsp + pg8::WIN_TBL_OFF + 4096))[tid >> 6] = 0u;
            pg8::Gemm g{XB, ph == 1 ? W1 : W2, M, NGU, DM}; pg8::StaticOrder S; S.init(M, NGU, G, bx); S.rot = GEMM_KROT;
            if (PROBE_HALFCU && ph == 1) { if ((bx >> 3) & 1) S.init(M, 0, G, bx); else S.init(M, NGU, G / 2, (bx & 7) + 8 * (bx >> 4)); }
            pg8::EpiSwiGLU E{ACT, ph == 1 ? ST1 : ST3, ph != 1};
            #ifndef SWIGLU_SP2
#define SWIGLU_SP2 true
#endif
#ifndef GEMM_IMM
#define GEMM_IMM false
#endif
            #ifndef SWIGLU_ALIGN
#define SWIGLU_ALIGN true
#endif
            #ifndef GEMM_PF
#define GEMM_PF false
#endif
            pg8::gemm_phase<pg8::EpiSwiGLU, pg8::StaticOrder, SWIGLU_ALIGN, SWIGLU_SP2, false, false, GEMM_IMM, GEMM_PF>(ldsp, g, S, E);
        } else if ((ph == 2 || ph == 5) && PH_ON(2)) {
            pg8::Gemm g{ph == 5 ? MIX : ACT, ph == 2 ? WD1 : WOUT, M, DM, ph == 5 ? DM : DFFP}; pg8::StaticOrder S; S.init(M, DM, G, bx);
#ifndef REV_MASK
#define REV_MASK 0
#endif
            S.rev = (REV_MASK >> ph) & 1;
            pg8::EpiResid E{XB, ph == 2 ? ST2 : ST3, ph == 5 ? BIASP : (const float*)nullptr, ph == 5 ? 1.0f : 0.5f, ph == 5};
            pg8::gemm_phase<pg8::EpiResid, pg8::StaticOrder, true, true>(ldsp, g, S, E);
        } else if (ph == 3 && PH_ON(3)) {
            { LAS float* tb = (LAS float*)(ldsp + pg8::WIN_TBL_OFF);
              for (int i = tid; i < 1024; i += NWAVES * 64) { tb[i] = ROPEC[i]; tb[1024 + i] = ROPES[i]; }
              if (tid < 64) tb[2048 + tid] = q_norm[tid]; else if (tid < 128) tb[2112 + tid - 64] = k_norm[tid - 64];
              __syncthreads(); }
            pg8::Gemm g{XB, WIN, M, NIN, DM}; pg8::StaticOrder S; S.init(M, NIN, G, bx); S.mode = 1;
            pg8::EpiWin E{ST2, XT, TV, ALTP, QB_, KB_, VB_, q_norm, k_norm, ROPEC, ROPES};
            pg8::gemm_phase<pg8::EpiWin, pg8::StaticOrder, true, true, true, false>(ldsp, g, S, E);
            if (late_ok && 2 * G + bx >= 640) {
                LAS float* scr = (LAS float*)(ldsp + wave * 16384);
                const int gwi = (bx - 128) * NWAVES + wave, ngwi = 128 * NWAVES;
            for (int it = gwi; it < 4096; it += ngwi) {
                const int row = it >> 1, hh = it & 1, kb = row >> 8, r = row & 255, k = 128 * kb + (r & 127), n0 = hh * 512 + lane * 8; float v[8];
#pragma unroll
                for (int e = 0; e < 8; ++e) { const float ph_ = (float)((k * (n0 + e)) & 2047) * (1.0f / 1024.0f); v[e] = (r < 128 ? cospif(ph_) : sinpif(ph_)) * (1.0f / 512.0f); }
                v4u o; o.x = pk2(v[0], v[1]); o.y = pk2(v[2], v[3]); o.z = pk2(v[4], v[5]); o.w = pk2(v[6], v[7]);
                *(v4u*)(DFT + (size_t)row * 1024 + n0) = o;
            }
            for (int it = 2752 * 1 + gwi; it < 2752 * 2; it += ngwi) {
                const int f = it / 2752, r = it % 2752, mat = r / 1376, r2 = r % 1376, kb = r2 / 86, nb = r2 % 86, n0 = nb * 32;
                const int drow = 256 * (n0 >> 7) + (n0 & 127) + 128 * mat;
                const float* Wsrc = f ? (mat ? w_up2 : w_gate2) : (mat ? w_up1 : w_gate1);
                p0_transpose_item(Wsrc, DFF, kb * 64, n0, (f ? W2 : W1) + (size_t)drow * DM, DM, f ? g_ffn2 : g_ffn1, scr, lane);
            }
            for (int it = 1376 * 1 + gwi; it < 1376 * 2; it += ngwi) {
                const int f = it / 1376, r = it % 1376, kb = r / 32, nb = r % 32;
                p0_transpose_item(f ? w_down2 : w_down1, DM, kb * 64, nb * 32, (f ? WD2 : WD1) + (size_t)(nb * 32) * DFFP, DFFP, nullptr, scr, lane);
            }
            unsigned zz = 0u; asm volatile("" : "+v"(zz)); const v4u zero4 = {zz, zz, zz, zz};
            for (int it = 256 * 1 + gwi; it < 256 * 2; it += ngwi) {
                const int f = it >> 8, r = (it >> 1) & 127, hh = it & 1; const int row = 256 * 21 + 64 + (r & 63) + 128 * (r >> 6);
                *(v4u*)((f ? W2 : W1) + (size_t)row * DM + hh * 512 + lane * 8) = zero4;
            }
            for (int it = 128 * 1 + gwi; it < 128 * 2; it += ngwi) {
                const int f = it >> 7, row = (it & 127) * 8 + (lane >> 3);
                *(v4u*)((f ? WD2 : WD1) + (size_t)row * DFFP + DFF + (lane & 7) * 8) = zero4;
            }
            for (int it = gwi; it < 256; it += ngwi) {
                const int kb = 8 + it / 32, nb = it % 32;
                p0_transpose_item(w_out, DM, kb * 64, nb * 32, WOUT + (size_t)(nb * 32) * DM, DM, nullptr, scr, lane);
            }
            for (int it = gwi; it < 1024; it += ngwi) {
                const int g = it >> 8, cb = (it >> 4) & 15, n = (it & 15) * 64 + lane;
                LAS float* Fl = scr;
                { const int r = lane >> 3, d0 = (lane & 7) * 16, ps = cb * 8 + r; const float* fp = fnet_w + (size_t)(g * 128 + (ps <= 64 ? ps : 192 - ps) - r) * 128;
                  f32x4 f4[4];
#pragma unroll
                  for (int e = 0; e < 4; ++e) f4[e] = *(const f32x4*)(fp + r * 128 + d0 + 4 * e);
#pragma unroll
                  for (int e = 0; e < 4; ++e)
#pragma unroll
                      for (int j = 0; j < 4; ++j) Fl[(d0 + 4 * e + j) * 8 + r] = f4[e][j]; }
                LDS_WAIT(); asm volatile("" ::: "memory");
                float a[8];
#pragma unroll
                for (int cc = 0; cc < 8; ++cc) a[cc] = 0.f;
                const float* wo = w_out + (size_t)(g * 128) * DM + n;
                for (int d = 0; d < 128; d += 16) {
                    float bq[16];
#pragma unroll
                    for (int e = 0; e < 16; ++e) bq[e] = wo[(size_t)(d + e) * DM];
#pragma unroll
                    for (int e = 0; e < 16; ++e) { const f32x4 fa = *(const LAS f32x4*)(Fl + (d + e) * 8), fb = *(const LAS f32x4*)(Fl + (d + e) * 8 + 4);
#pragma unroll
                        for (int cc = 0; cc < 4; ++cc) { a[cc] += fa[cc] * bq[e]; a[4 + cc] += fb[cc] * bq[e]; } }
                }
                v4u o; o.x = pk2(a[0], a[1]); o.y = pk2(a[2], a[3]); o.z = pk2(a[4], a[5]); o.w = pk2(a[6], a[7]);
                *(v4u*)(WOUT + (size_t)n * DM + g * 128 + cb * 8) = o;
                LDS_WAIT(); asm volatile("" ::: "memory");
            }
            for (int it = gwi; it < 128; it += ngwi) {
                f32x4 p0 = {0.f, 0.f, 0.f, 0.f}, p1 = {0.f, 0.f, 0.f, 0.f}; f32x4 wv[8][2]; float fb[8];
#pragma unroll
                for (int i = 0; i < 8; ++i) { const int r = lane + 64 * i; fb[i] = fnet_b[r]; wv[i][0] = *(const f32x4*)(w_out + (size_t)r * DM + it * 8); wv[i][1] = *(const f32x4*)(w_out + (size_t)r * DM + it * 8 + 4); }
#pragma unroll
                for (int i = 0; i < 8; ++i) { p0 += wv[i][0] * fb[i]; p1 += wv[i][1] * fb[i]; }
                float o8[8];
#pragma unroll
                for (int j = 0; j < 4; ++j) { o8[j] = wave_sum(p0[j]); o8[4 + j] = wave_sum(p1[j]); }
                if (lane == 0) { *(f32x4*)(BIASP + it * 8) = (f32x4){o8[0], o8[1], o8[2], o8[3]}; *(f32x4*)(BIASP + it * 8 + 4) = (f32x4){o8[4], o8[5], o8[6], o8[7]}; }
            }
            }
        } else if (ph == 4 && PH_ON(4)) {
#ifndef PROBE_SUB
#define PROBE_SUB 0
#endif
#ifndef P4_SWAP
#define P4_SWAP 0
#endif
            const bool attn_first = P4_SWAP && ((vcu >> 3) & 1);
            for (int step = 0; step < 2; ++step) {
                if ((step == 0) != attn_first) {
                    for (int rep_ = 0; rep_ < 1 + (PROBE_SUB & 1); ++rep_) {
                        pg8::Gemm g{DFT, XT, M, 512, 1024}; pg8::StaticOrder S; S.init(M, 512, G, bx); S.mode = 2;
                        pg8::EpiDft E{MIX, TV, ALTP};
                        pg8::gemm_phase<pg8::EpiDft, pg8::StaticOrder, true, true, false, 2>(ldsp, g, S, E);
                    }
                } else {
                    for (int rep_ = 0; rep_ < 1 + ((PROBE_SUB >> 1) & 1); ++rep_) {
                        const attn_body::AttnTensors AT{(const attn_body::bf16*)QB_, (const attn_body::bf16*)KB_, (const attn_body::bf16*)VB_, (attn_body::bf16*)MIX};
                        const attn_body::AttnOrder S(G, vcu);
                        float gq = fabsf(q_norm[lane]), gk = fabsf(k_norm[lane]);
                        gq = wave_max(gq); gk = wave_max(gk);
                        const float coff = 8.0f * 1.4426950408889634f * gq * gk;
                        attn_body::attn_phase<attn_body::AttnOrder>((char*)lds, AT, S, coff);
                    }
                }
            }
        } else if (ph == 7 && PH_ON(7)) {
            pg8::Gemm g{ACT, WD2, M, DM, DFFP}; pg8::StaticOrder S; S.init(M, DM, G, bx);
            S.rev = (REV_MASK >> 7) & 1;
            pg8::EpiFinal E{XB, ST4, (unsigned*)(ctl + CW_SEAM), g_final, out, 0.5f};
            pg8::gemm_phase<pg8::EpiFinal, pg8::StaticOrder, true, true>(ldsp, g, S, E);
        }
#ifdef PROBE_CLOCK
        if (ph == PROBE_CLOCK) { const unsigned long long t1 = __builtin_amdgcn_s_memtime(), r1 = __builtin_amdgcn_s_memrealtime();
            if (bx == 0 && tid == 0) { const unsigned long long mhz = (t1 - pc_t0) * 100ull / (r1 - pc_r0); MISC[16] = (unsigned)mhz; } }
#endif
#ifdef PROBE_SKEW
        if (ph == PROBE_SKEW && tid == 0) { ((unsigned long long*)(ap->ws + WS_MISC + 786432))[bx] = __builtin_amdgcn_s_memrealtime(); }
        if (ph == PROBE_SKEW + 1 && bx == 0 && tid == 0) {
#if defined(PROBE_SKEW_XCD)
            unsigned long long base = ~0ull; for (int i = 0; i < G; ++i) { const unsigned long long v = ((volatile unsigned long long*)(ap->ws + WS_MISC + 786432))[i]; base = v < base ? v : base; }
            unsigned long long mnm = ~0ull, mxm = 0ull; for (int x = 0; x < 8; ++x) { unsigned long long s = 0; for (int i = x; i < G; i += 8) s += ((volatile unsigned long long*)(ap->ws + WS_MISC + 786432))[i] - base; s /= (unsigned long long)(G / 8); mnm = s < mnm ? s : mnm; mxm = s > mxm ? s : mxm; }
#if defined(PROBE_SKEW_ID)
            { int slow = 0, fast = 0; unsigned long long smx = 0, smn = ~0ull; for (int x = 0; x < 8; ++x) { unsigned long long s = 0; for (int i = x; i < G; i += 8) s += ((volatile unsigned long long*)(ap->ws + WS_MISC + 786432))[i] - base; if (s > smx) { smx = s; slow = x; } if (s < smn) { smn = s; fast = x; } }
              MISC[16] = (unsigned)((slow * 8 + fast) * 5000) + (unsigned)((mxm - mnm) > 4999 ? 4999 : (mxm - mnm)); }
#else
            MISC[16] = (unsigned)(mxm - mnm);
#endif
#else
            unsigned long long mn = ~0ull, mx = 0ull; for (int i = 0; i < G; ++i) { const unsigned long long v = ((volatile unsigned long long*)(ap->ws + WS_MISC + 786432))[i]; mn = v < mn ? v : mn; mx = v > mx ? v : mx; } MISC[16] = (unsigned)(mx - mn);
#endif
        }
#endif
        if (ph2 + 1 < 2 * hi && !(!(ph2 & 1) && ph + 1 == hi && !((PROBE_REPEAT >> ph) & 1))) GRID_BAR();
    }
#undef GRID_BAR
#ifdef PROBE_SKEW
    if (blockIdx.x == 0 && threadIdx.x == 0) { const unsigned sk = MISC[16]; const unsigned long long r0 = __builtin_amdgcn_s_memrealtime(); const unsigned long long ticks = (unsigned long long)sk * 20ull;
        while (__builtin_amdgcn_s_memrealtime() - r0 < ticks) __builtin_amdgcn_s_sleep(8); }
#endif
#ifdef PROBE_CLOCK
    if (blockIdx.x == 0 && threadIdx.x == 0) { const unsigned mhz = MISC[16]; const unsigned long long r0 = __builtin_amdgcn_s_memrealtime(); const unsigned long long ticks = (unsigned long long)(mhz / 4u) * 100ull;
        while (__builtin_amdgcn_s_memrealtime() - r0 < ticks) __builtin_amdgcn_s_sleep(8); }
#endif
}

extern "C" void kernel_launch(void* const* d_in, const int* in_sizes, int n_in, void* d_out, int out_size, void* d_ws, size_t ws_size, hipStream_t stream) {
    static int grid = 0;
    if (grid == 0) {
        if (n_in != 17 || in_sizes[0] != M * DM || out_size != M * DM || ws_size < WS_END) { fprintf(stderr, "kernel_launch: unexpected shapes (n_in %d, in0 %d, out %d, ws %zu); nothing launched\n", n_in, n_in > 0 ? in_sizes[0] : -1, out_size, ws_size); grid = -1; return; }
        int dev = 0, cus = 0, per_cu = 0;
        if (hipGetDevice(&dev) != hipSuccess || hipDeviceGetAttribute(&cus, hipDeviceAttributeMultiprocessorCount, dev) != hipSuccess) { fprintf(stderr, "kernel_launch: device query failed\n"); grid = -1; return; }
        if (hipFuncSetAttribute((const void*)mk_fwd, hipFuncAttributeMaxDynamicSharedMemorySize, LDS_BYTES) != hipSuccess) { fprintf(stderr, "kernel_launch: hipFuncSetAttribute failed\n"); grid = -1; return; }
        if (hipOccupancyMaxActiveBlocksPerMultiprocessor(&per_cu, (const void*)mk_fwd, NWAVES * 64, LDS_BYTES) != hipSuccess || per_cu < 1) { fprintf(stderr, "kernel_launch: occupancy query reports %d workgroups per CU\n", per_cu); per_cu = 1; }
        (void)hipGetLastError();
        grid = cus;
    }
    if (grid < 0) return;
    if (hipMemsetAsync((char*)d_ws + WS_CTL, 0, CTL_ZERO_BYTES, stream) != hipSuccess) { fprintf(stderr, "kernel_launch: hipMemsetAsync failed\n"); return; }
    Args a{};
    for (int i = 0; i < 17; ++i) a.in[i] = (const float*)d_in[i];
    a.out = (float*)d_out; a.ws = (unsigned char*)d_ws;
    for (int li = 0; li < N_LAUNCHES; ++li) {
        a.ph_lo = (N_LAUNCHES == 1) ? 0 : li; a.ph_hi = (N_LAUNCHES == 1) ? N_PHASES : li + 1; a.li = li;
        hipLaunchKernelGGL(mk_fwd, dim3(grid), dim3(NWAVES * 64), LDS_BYTES, stream, a);
        const hipError_t le = hipPeekAtLastError();
        if (le != hipSuccess) { fprintf(stderr, "kernel_launch: launch %d failed: %s\n", li, hipGetErrorName(le)); break; }
    }
}
```

```cpp
#ifndef ATTN_RUNNING_MAX
#define ATTN_NOMAX 1
#endif
#include <hip/hip_runtime.h>
#include <hip/hip_bf16.h>
#include <cstdio>
#include <cstdint>
#include <cmath>
#define ZFIRST_SWIGLU true
#define DFT_HWSIN 1
#define HEAD_SWAP 1
#define LATE_PIPE 1
#define FOLD_UNROLL 1
#define REV_MASK 0xA4
namespace pg8 {
#define PG8_LAS __attribute__((address_space(3)))
typedef unsigned short bf16_t;
typedef short bf16x8 __attribute__((ext_vector_type(8)));
typedef float f32x4 __attribute__((ext_vector_type(4)));
typedef unsigned u32x4 __attribute__((ext_vector_type(4)));
constexpr int BM = 256, BK = 64, HALF = 128, HTB = HALF * BK * 2  , STAGE_BYTES = 8 * HTB, NXCD = 8;
#ifndef WGM_OVERRIDE
#define WGM_OVERRIDE 8
#endif
constexpr int WGM = WGM_OVERRIDE;

__host__ __device__ __forceinline__ int lds_byte(int r, int c) { const int st = (r >> 4) * 2 + (c >> 5), rr = r & 15, cc = c & 31, ob = rr * 64 + cc * 2; return st * 1024 + (ob ^ (((ob >> 9) & 1) << 5)); }
__host__ __device__ __forceinline__ void stage_rc(int b, int& R, int& C) { const int st = b / 1024, sb = b % 1024, swz = sb ^ (((sb >> 9) & 1) << 5); R = (st >> 1) * 16 + swz / 64; C = (st & 1) * 32 + (swz % 64) / 2; }
__host__ __device__ __forceinline__ int perm32(int rho) { const int n = rho >> 4, i = rho & 15; return 8 * (i >> 2) + 4 * n + (i & 3); }

struct Unit { int pm, pn, a0row, a1row, brow, spec; };
struct Gemm { const bf16_t* A; const bf16_t* Bt; int M, N, K; };

struct StaticOrder {
    int rev;
    int nM, nN, nwg, G, c, mode, rot;
    __host__ __device__ void init(int M, int N, int G_, int c_) { nM = M / BM; nN = N / BM; nwg = nM * nN; G = G_; c = c_; mode = 0; rot = 0; rev = 0; }
    __host__ __device__ bool next(int i, Unit& u) const {
        const long L = (long)i * G + c; if (L >= nwg) return false;
        int wgid = (int)L; { const int q = nwg / NXCD, r = nwg % NXCD, xcd = wgid % NXCD, off = wgid / NXCD; const int cntx = (xcd < r) ? q + 1 : q; wgid = (xcd < r ? xcd * (q + 1) : r * (q + 1) + (xcd - r) * q) + (rev ? cntx - 1 - off : off); }
        const int nig = WGM * nN, gid = wgid / nig, fm = gid * WGM, gsz = (nM - fm) < WGM ? (nM - fm) : WGM;
        u.pm = fm + ((wgid % nig) % gsz); u.pn = (wgid % nig) / gsz;
        if (mode == 1) { const int b = u.pm >> 3, sb = u.pm & 7; u.a0row = b * 2048 + 128 * sb; u.a1row = b * 2048 + 1024 - 128 * sb; u.brow = u.pn; u.spec = (sb == 0); }
        else if (mode == 2) { u.a0row = 256 * (u.pm & 7); u.a1row = u.a0row + 128; u.brow = (u.pm >> 3) * 2 + u.pn; u.spec = 0; }
        else { u.a0row = 256 * u.pm; u.a1row = u.a0row + 128; u.brow = u.pn; u.spec = 0; }
        return true;
    }
    __device__ __forceinline__ int krot(int nt) const { if (!rot) return 0; const int j = c >> 3; return (((j & 7) + (j >> 3)) & 1) ? ((nt >> 1) & ~1) : 0; }
    __device__ __forceinline__ void a_ready(const Unit&) const {}
    __device__ __forceinline__ void done(const Unit&) const {}
};


typedef float f32x2_t __attribute__((ext_vector_type(2))); typedef __bf16 bf16x2_t __attribute__((ext_vector_type(2)));
typedef unsigned u32x2 __attribute__((ext_vector_type(2)));
__device__ __forceinline__ unsigned cvt_pk_bf16(float lo, float hi) { f32x2_t v = {lo, hi}; bf16x2_t b = __builtin_convertvector(v, bf16x2_t); return __builtin_bit_cast(unsigned, b); }
__device__ __forceinline__ float xsum16(float v) { const auto r = __builtin_amdgcn_permlane16_swap(__float_as_uint(v), __float_as_uint(v), false, false); const unsigned r0 = r[0], r1 = r[1]; return __uint_as_float(r0) + __uint_as_float(r1); }
__device__ __forceinline__ float xsum32(float v) { const auto r = __builtin_amdgcn_permlane32_swap(__float_as_uint(v), __float_as_uint(v), false, false); const unsigned r0 = r[0], r1 = r[1]; return __uint_as_float(r0) + __uint_as_float(r1); }
#ifndef ZFIRST_SWIGLU
#define ZFIRST_SWIGLU false
#endif
#ifndef ZFIRST_RESID
#define ZFIRST_RESID false
#endif
#ifndef ZFIRST_OTHER
#define ZFIRST_OTHER false
#endif
constexpr int DM_ = 1024, M_ = 32768;
constexpr int WIN_TBL_OFF = STAGE_BYTES + 8 * 2560 + 512;
constexpr float EPS_ = 1e-6f;
__device__ __forceinline__ float row_rstd(const float* __restrict__ stats, int row, int fq) {
    const f32x4 v = *(const f32x4*)((const char*)stats + ((unsigned)row * 64u + 16u * (unsigned)fq));
    float s = (v[0] + v[1]) + (v[2] + v[3]);
    s = xsum32(xsum16(s));
    return __builtin_amdgcn_rsqf(s * (1.0f / DM_) + EPS_);
}

__device__ __forceinline__ void row_rstd8(const float* __restrict__ stats, const int (&rows)[2][4], int fq, float (&rs)[2][4]) {
    f32x4 v[2][4];
#pragma unroll
    for (int ai = 0; ai < 2; ++ai)
#pragma unroll
        for (int m = 0; m < 4; ++m) v[ai][m] = *(const f32x4*)((const char*)stats + ((unsigned)rows[ai][m] * 64u + 16u * (unsigned)fq));
    asm volatile("" : "+v"(v[0][0]), "+v"(v[0][1]), "+v"(v[0][2]), "+v"(v[0][3]), "+v"(v[1][0]), "+v"(v[1][1]), "+v"(v[1][2]), "+v"(v[1][3]));
#pragma unroll
    for (int ai = 0; ai < 2; ++ai)
#pragma unroll
        for (int m = 0; m < 4; ++m) { float s = (v[ai][m][0] + v[ai][m][1]) + (v[ai][m][2] + v[ai][m][3]); s = xsum32(xsum16(s)); rs[ai][m] = __builtin_amdgcn_rsqf(s * (1.0f / DM_) + EPS_); }
}

__device__ __forceinline__ unsigned stat_idx(int row, int slot) { return ((unsigned)row & ~15u) * 16u + (unsigned)slot * 16u + ((unsigned)row & 15u); }
__device__ __forceinline__ void row_rstd8t(const float* __restrict__ stats, const int (&rows)[2][4], int fq, float (&rs)[2][4]) {
#pragma unroll
    for (int ai = 0; ai < 2; ++ai) {
        float v[4][4];
#pragma unroll
        for (int m = 0; m < 4; ++m) { const char* sp = (const char*)stats + stat_idx(rows[ai][m], 4 * fq) * 4u;
#pragma unroll
            for (int i = 0; i < 4; ++i) v[m][i] = *(const float*)(sp + 64 * i); }
        asm volatile("" : "+v"(v[0][0]), "+v"(v[0][1]), "+v"(v[0][2]), "+v"(v[0][3]), "+v"(v[1][0]), "+v"(v[1][1]), "+v"(v[1][2]), "+v"(v[1][3]),
                          "+v"(v[2][0]), "+v"(v[2][1]), "+v"(v[2][2]), "+v"(v[2][3]), "+v"(v[3][0]), "+v"(v[3][1]), "+v"(v[3][2]), "+v"(v[3][3]));
#pragma unroll
        for (int m = 0; m < 4; ++m) { float s = (v[m][0] + v[m][1]) + (v[m][2] + v[m][3]); s = xsum32(xsum16(s)); rs[ai][m] = __builtin_amdgcn_rsqf(s * (1.0f / DM_) + EPS_); }
    }
}

struct EpiSwiGLU {
    #ifndef PROBE_EPI_SWIGLU
#define PROBE_EPI_SWIGLU false
#endif
    static constexpr bool PERM = true, AFTER_DRAIN = false, PROBE_TWICE = PROBE_EPI_SWIGLU, ZFIRST = ZFIRST_SWIGLU;
    __device__ __forceinline__ EpiSwiGLU second() const { return *this; }
    bf16_t* __restrict__ O; const float* __restrict__ stats; bool tr;
    __device__ __forceinline__ void operator()(const f32x4 (&acc)[2][2][4][2], const Unit& u, int wr, int wc, int fr_in, int fq_in, PG8_LAS unsigned char* lds) const {
        int fr = fr_in, fq = fq_in; asm volatile("" : "+v"(fr), "+v"(fq));
        const int row0 = u.pm * BM + wr * 64 + fr, col0 = u.pn * 128 + wc * 32 + 8 * fq;
#if defined(ACT_WT)
        const __amdgpu_buffer_rsrc_t orsrc = __builtin_amdgcn_make_buffer_rsrc((void*)O, 0, 0x7fffffff, 0x00020000);
#endif
        const unsigned ob0 = ((unsigned)row0 * 2816u + (unsigned)col0) * 2u;
        float rsv[2][4]; int rws[2][4];
#pragma unroll
        for (int ai = 0; ai < 2; ++ai)
#pragma unroll
            for (int m = 0; m < 4; ++m) rws[ai][m] = row0 + ai * HALF + m * 16;
        { PG8_LAS float* rc = (PG8_LAS float*)(lds + WIN_TBL_OFF + (wr * 4 + wc) * 512) + fr * 8;
          PG8_LAS unsigned* tg = (PG8_LAS unsigned*)(lds + WIN_TBL_OFF + 4096 + (wr * 4 + wc) * 4);
          const unsigned want = (unsigned)u.pm + 1u;
          if ((unsigned)__builtin_amdgcn_readfirstlane((int)*tg) == want) {
              const f32x4 c0 = *(const PG8_LAS f32x4*)rc, c1 = *(const PG8_LAS f32x4*)(rc + 4);
              rsv[0][0] = c0[0]; rsv[0][1] = c0[1]; rsv[0][2] = c0[2]; rsv[0][3] = c0[3]; rsv[1][0] = c1[0]; rsv[1][1] = c1[1]; rsv[1][2] = c1[2]; rsv[1][3] = c1[3];
          } else {
              if (tr) row_rstd8t(stats, rws, fq, rsv); else row_rstd8(stats, rws, fq, rsv);
              if (fq == 0) { *(PG8_LAS f32x4*)rc = (f32x4){rsv[0][0], rsv[0][1], rsv[0][2], rsv[0][3]}; *(PG8_LAS f32x4*)(rc + 4) = (f32x4){rsv[1][0], rsv[1][1], rsv[1][2], rsv[1][3]}; }
              *tg = want;
          } }
#pragma unroll
        for (int ai = 0; ai < 2; ++ai)
#pragma unroll
            for (int m = 0; m < 4; ++m) {
                const int row = row0 + ai * HALF + m * 16;
                const float rs = rsv[ai][m];
                const float k1 = rs * -1.4426950408889634f, ik2 = __builtin_amdgcn_rcpf(rs * rs);
                float a[8];
#pragma unroll
                for (int n = 0; n < 2; ++n)
#pragma unroll
                    for (int jj = 0; jj < 2; ++jj) {
                        const f32x2_t g = {acc[ai][0][m][n][2 * jj], acc[ai][0][m][n][2 * jj + 1]}, up = {acc[ai][1][m][n][2 * jj], acc[ai][1][m][n][2 * jj + 1]};
                        const f32x2_t t = g * k1; f32x2_t e; e.x = __builtin_amdgcn_exp2f(t.x); e.y = __builtin_amdgcn_exp2f(t.y);
                        const f32x2_t d = e * ik2 + ik2; f32x2_t r; r.x = __builtin_amdgcn_rcpf(d.x); r.y = __builtin_amdgcn_rcpf(d.y);
                        const f32x2_t o = (g * up) * r;
                        a[n * 4 + 2 * jj] = o.x; a[n * 4 + 2 * jj + 1] = o.y;
                    }
                u32x4 w; w.x = cvt_pk_bf16(a[0], a[1]); w.y = cvt_pk_bf16(a[2], a[3]); w.z = cvt_pk_bf16(a[4], a[5]); w.w = cvt_pk_bf16(a[6], a[7]);
#if defined(ACT_WT)
                __builtin_amdgcn_raw_buffer_store_b128(w, orsrc, ((unsigned)row * 2816u + (unsigned)col0) * 2u, 0, 16);
#elif defined(ACT_NT)
                __builtin_nontemporal_store(w, (u32x4*)(O + (size_t)row * 2816 + col0));
#else
                *(u32x4*)((char*)O + (ob0 + (unsigned)((ai * HALF + m * 16) * 2816 * 2))) = w;
#endif
            }
    }
};

#ifndef PROBE_EPI_RESID
#define PROBE_EPI_RESID false
#endif
struct EpiResid {
    static constexpr bool PERM = true, AFTER_DRAIN = false, PROBE_TWICE = PROBE_EPI_RESID, ZFIRST = ZFIRST_RESID;
    __device__ __forceinline__ EpiResid second() const { EpiResid e = *this; e.alpha = 0.f; e.bias = nullptr; return e; }
    bf16_t* xb; float* __restrict__ stats_out; const float* __restrict__ bias; float alpha; bool trs;
    __device__ __forceinline__ void operator()(const f32x4 (&acc)[2][2][4][2], const Unit& u, int wr, int wc, int fr_in, int fq_in, PG8_LAS unsigned char*) const {
        int fr = fr_in, fq = fq_in; asm volatile("" : "+v"(fr), "+v"(fq));
        const int row0 = u.pm * BM + wr * 64 + fr, col0 = u.pn * BM + wc * 32 + 8 * fq;
        const unsigned ob0 = ((unsigned)row0 * DM_ + (unsigned)col0) * 2u;
        u32x4 rv[2][4][2];
#pragma unroll
        for (int ai = 0; ai < 2; ++ai)
#pragma unroll
            for (int m = 0; m < 4; ++m)
#pragma unroll
                for (int bj = 0; bj < 2; ++bj) rv[ai][m][bj] = *(const u32x4*)(((const char*)xb + (size_t)((ai * HALF + m * 16) * DM_ + bj * HALF) * 2u) + ob0);
        f32x4 bv[2][2];
#pragma unroll
        for (int bj = 0; bj < 2; ++bj)
#pragma unroll
            for (int n = 0; n < 2; ++n) bv[bj][n] = bias ? *(const f32x4*)(bias + col0 + bj * HALF + n * 4) : (f32x4){0.f, 0.f, 0.f, 0.f};
        asm volatile("" ::: "memory");
#pragma unroll
        for (int ai = 0; ai < 2; ++ai)
#pragma unroll
            for (int m = 0; m < 4; ++m) {
                float ss = 0.f;
#pragma unroll
                for (int bj = 0; bj < 2; ++bj) {
                    const u32x4 r = rv[ai][m][bj];
                    const f32x4 r0 = {__uint_as_float(r.x << 16), __uint_as_float(r.x & 0xffff0000u), __uint_as_float(r.y << 16), __uint_as_float(r.y & 0xffff0000u)};
                    const f32x4 r1 = {__uint_as_float(r.z << 16), __uint_as_float(r.z & 0xffff0000u), __uint_as_float(r.w << 16), __uint_as_float(r.w & 0xffff0000u)};
                    const f32x4 o0 = r0 + acc[ai][bj][m][0] * alpha + bv[bj][0], o1 = r1 + acc[ai][bj][m][1] * alpha + bv[bj][1];
                    ss += ((o0[0] * o0[0] + o0[1] * o0[1]) + (o0[2] * o0[2] + o0[3] * o0[3])) + ((o1[0] * o1[0] + o1[1] * o1[1]) + (o1[2] * o1[2] + o1[3] * o1[3]));
                    u32x4 w; w.x = cvt_pk_bf16(o0[0], o0[1]); w.y = cvt_pk_bf16(o0[2], o0[3]); w.z = cvt_pk_bf16(o1[0], o1[1]); w.w = cvt_pk_bf16(o1[2], o1[3]);
                    *(u32x4*)(((char*)xb + (size_t)((ai * HALF + m * 16) * DM_ + bj * HALF) * 2u) + ob0) = w;
                }
                ss = xsum32(xsum16(ss));
                if (stats_out && fq == 0) *(float*)((char*)stats_out + 4u * (trs ? stat_idx(row0 + ai * HALF + m * 16, u.pn * 4 + wc) : (unsigned)(row0 + ai * HALF + m * 16) * 16u + (unsigned)(u.pn * 4 + wc))) = ss;
            }
    }
};

struct EpiFinal {
    static constexpr bool PERM = true, AFTER_DRAIN = false, PROBE_TWICE = false, ZFIRST = ZFIRST_OTHER;
    __device__ __forceinline__ EpiFinal second() const { return *this; }
    const bf16_t* __restrict__ xb; float* stats; unsigned* cnt; const float* __restrict__ gfin; float* __restrict__ out; float alpha;
    __device__ __forceinline__ void operator()(f32x4 (&acc)[2][2][4][2], const Unit& u, int wr, int wc, int fr_in, int fq_in, PG8_LAS unsigned char* lds) const {
        int fr = fr_in, fq = fq_in; asm volatile("" : "+v"(fr), "+v"(fq));
        const int row0 = u.pm * BM + wr * 64 + fr, col0 = u.pn * BM + wc * 32 + 8 * fq;
        const unsigned ob0 = ((unsigned)row0 * DM_ + (unsigned)col0) * 2u;
        u32x4 rv[2][4][2];
#pragma unroll
        for (int ai = 0; ai < 2; ++ai)
#pragma unroll
            for (int m = 0; m < 4; ++m)
#pragma unroll
                for (int bj = 0; bj < 2; ++bj) rv[ai][m][bj] = *(const u32x4*)(((const char*)xb + (size_t)((ai * HALF + m * 16) * DM_ + bj * HALF) * 2u) + ob0);
#pragma unroll
        for (int ai = 0; ai < 2; ++ai)
#pragma unroll
            for (int m = 0; m < 4; ++m) {
                float ss = 0.f;
#pragma unroll
                for (int bj = 0; bj < 2; ++bj) {
                    const u32x4 r = rv[ai][m][bj];
                    const f32x4 r0 = {__uint_as_float(r.x << 16), __uint_as_float(r.x & 0xffff0000u), __uint_as_float(r.y << 16), __uint_as_float(r.y & 0xffff0000u)};
                    const f32x4 r1 = {__uint_as_float(r.z << 16), __uint_as_float(r.z & 0xffff0000u), __uint_as_float(r.w << 16), __uint_as_float(r.w & 0xffff0000u)};
                    const f32x4 o0 = r0 + acc[ai][bj][m][0] * alpha, o1 = r1 + acc[ai][bj][m][1] * alpha;
                    acc[ai][bj][m][0] = o0; acc[ai][bj][m][1] = o1;
                    ss += ((o0[0] * o0[0] + o0[1] * o0[1]) + (o0[2] * o0[2] + o0[3] * o0[3])) + ((o1[0] * o1[0] + o1[1] * o1[1]) + (o1[2] * o1[2] + o1[3] * o1[3]));
                }
                ss = xsum32(xsum16(ss));
                if (fq == 0) __hip_atomic_store((float*)((char*)stats + 4u * stat_idx(row0 + ai * HALF + m * 16, u.pn * 4 + wc)), ss, __ATOMIC_RELAXED, __HIP_MEMORY_SCOPE_AGENT);
            }
        asm volatile("s_waitcnt vmcnt(0)" ::: "memory");
        if (fq == 0 && fr == 0) __hip_atomic_fetch_add(cnt + 64 * u.pm, 1u, __ATOMIC_RELAXED, __HIP_MEMORY_SCOPE_AGENT);
        if (wr == 0 && wc == 0) {
            unsigned spins = 0;
            while ((unsigned)__builtin_amdgcn_readfirstlane(__hip_atomic_load(cnt + 64 * u.pm, __ATOMIC_RELAXED, __HIP_MEMORY_SCOPE_AGENT)) < 32u) { __builtin_amdgcn_s_sleep(2); if (++spins > (1u << 22)) break; }
        }
        asm volatile("s_waitcnt vmcnt(0) lgkmcnt(0)" ::: "memory"); __builtin_amdgcn_s_barrier(); asm volatile("" ::: "memory");
        float rstd[2][4];
        { f32x4 pv[2][4];
#pragma unroll
          for (int ai = 0; ai < 2; ++ai)
#pragma unroll
              for (int m = 0; m < 4; ++m) { const float* sp = (const float*)((const char*)stats + 4u * stat_idx(row0 + ai * HALF + m * 16, 4 * fq));
                  pv[ai][m] = (f32x4){__hip_atomic_load(sp, __ATOMIC_RELAXED, __HIP_MEMORY_SCOPE_AGENT), __hip_atomic_load(sp + 16, __ATOMIC_RELAXED, __HIP_MEMORY_SCOPE_AGENT),
                                       __hip_atomic_load(sp + 32, __ATOMIC_RELAXED, __HIP_MEMORY_SCOPE_AGENT), __hip_atomic_load(sp + 48, __ATOMIC_RELAXED, __HIP_MEMORY_SCOPE_AGENT)}; }
          asm volatile("" : "+v"(pv[0][0]), "+v"(pv[0][1]), "+v"(pv[0][2]), "+v"(pv[0][3]), "+v"(pv[1][0]), "+v"(pv[1][1]), "+v"(pv[1][2]), "+v"(pv[1][3]));
#pragma unroll
          for (int ai = 0; ai < 2; ++ai)
#pragma unroll
              for (int m = 0; m < 4; ++m) { float s = (pv[ai][m][0] + pv[ai][m][1]) + (pv[ai][m][2] + pv[ai][m][3]); s = xsum32(xsum16(s)); rstd[ai][m] = __builtin_amdgcn_rsqf(s * (1.0f / DM_) + EPS_); } }
        asm volatile("" : "+v"(rstd[0][0]), "+v"(rstd[0][1]), "+v"(rstd[0][2]), "+v"(rstd[0][3]), "+v"(rstd[1][0]), "+v"(rstd[1][1]), "+v"(rstd[1][2]), "+v"(rstd[1][3]));
        const bool hi8 = (fr & 8) != 0; const int row8 = row0 - (fr & 8), col8 = col0 + (hi8 ? 4 : 0); const unsigned oo8 = ((unsigned)row8 * DM_ + (unsigned)col8) * 4u;
#pragma unroll
        for (int bj = 0; bj < 2; ++bj) {
            const f32x4 g0 = *(const f32x4*)(gfin + col0 + bj * HALF), g1 = *(const f32x4*)(gfin + col0 + bj * HALF + 4);
#pragma unroll
            for (int ai = 0; ai < 2; ++ai)
#pragma unroll
                for (int m = 0; m < 4; ++m) {
                    const f32x4 x0 = acc[ai][bj][m][0] * rstd[ai][m] * g0, x1 = acc[ai][bj][m][1] * rstd[ai][m] * g1;
                    f32x4 ya, yb;
#pragma unroll
                    for (int j = 0; j < 4; ++j) {
                        const float a0 = x0[j], a1 = x1[j];
                        const float r0 = __uint_as_float((unsigned)__builtin_amdgcn_mov_dpp((int)__float_as_uint(a0), 0x128, 0xf, 0xf, false));
                        const float r1 = __uint_as_float((unsigned)__builtin_amdgcn_mov_dpp((int)__float_as_uint(a1), 0x128, 0xf, 0xf, false));
                        ya[j] = hi8 ? r1 : a0; yb[j] = hi8 ? a1 : r0; }
                    char* op = (char*)out + (oo8 + (unsigned)(((ai * HALF + m * 16) * DM_ + bj * HALF) * 4));
#ifdef FINAL_NT
                    __builtin_nontemporal_store(ya, (f32x4*)(op)); __builtin_nontemporal_store(yb, (f32x4*)(op + 8 * DM_ * 4)); }
#else
                    *(f32x4*)(op) = ya; *(f32x4*)(op + 8 * DM_ * 4) = yb; }
#endif
        }
    }
};

struct EpiBf16Plain {
    static constexpr bool PERM = true, AFTER_DRAIN = false, PROBE_TWICE = false, ZFIRST = ZFIRST_OTHER;
    __device__ __forceinline__ EpiBf16Plain second() const { return *this; }
    bf16_t* __restrict__ O; int ldc;
    __device__ __forceinline__ void operator()(const f32x4 (&acc)[2][2][4][2], const Unit& u, int wr, int wc, int fr_in, int fq_in, PG8_LAS unsigned char*) const {
        int fr = fr_in, fq = fq_in; asm volatile("" : "+v"(fr), "+v"(fq));
        const int row0 = u.pm * BM + wr * 64 + fr, col0 = u.pn * BM + wc * 32 + 8 * fq;
#pragma unroll
        for (int ai = 0; ai < 2; ++ai)
#pragma unroll
            for (int m = 0; m < 4; ++m) { bf16_t* rowp = O + (size_t)(row0 + ai * HALF + m * 16) * ldc + col0;
#pragma unroll
                for (int bj = 0; bj < 2; ++bj) { const f32x4 v0 = acc[ai][bj][m][0], v1 = acc[ai][bj][m][1];
                    u32x4 w; w.x = cvt_pk_bf16(v0[0], v0[1]); w.y = cvt_pk_bf16(v0[2], v0[3]); w.z = cvt_pk_bf16(v1[0], v1[1]); w.w = cvt_pk_bf16(v1[2], v1[3]);
                    *(u32x4*)(rowp + bj * HALF) = w; } }
    }
};

#ifndef PROBE_EPI_WIN
#define PROBE_EPI_WIN false
#endif
struct EpiWin {
    static constexpr bool PERM = false, AFTER_DRAIN = false, PROBE_TWICE = PROBE_EPI_WIN, ZFIRST = false;
    __device__ __forceinline__ EpiWin second() const { return *this; }
    const float* __restrict__ stats; bf16_t* __restrict__ XT2; float* __restrict__ Tv; float* __restrict__ ALTP; bf16_t* __restrict__ Qb; bf16_t* __restrict__ Kb; bf16_t* __restrict__ Vb;
    const float* __restrict__ qn; const float* __restrict__ kn; const float* __restrict__ ropeC; const float* __restrict__ ropeS;
    template <int TY> __device__ __forceinline__ void head_path(const f32x4 (&acc)[2][2][4][2], bf16_t* __restrict__ dst, unsigned pitchb, PG8_LAS const unsigned char* tbl, unsigned gnoff, const float (&rs)[2][4], const int (&pos)[2][4], int brow0, int fq) const {
        const float qs = (TY == 0) ? 0.125f * 1.4426950408889634f : 1.0f;
        const unsigned fqb = 16u * (unsigned)fq;
#pragma unroll
        for (int ai = 0; ai < 2; ++ai)
#pragma unroll
            for (int m = 0; m < 4; ++m) {
                const int s = pos[ai][m];
                f32x4 v[2][2];
#pragma unroll
                for (int bj = 0; bj < 2; ++bj)
#pragma unroll
                    for (int n = 0; n < 2; ++n) v[bj][n] = acc[ai][bj][m][n] * rs[ai][m];
                if (TY != 2) {
                    float ss = 0.f;
#pragma unroll
                    for (int bj = 0; bj < 2; ++bj)
#pragma unroll
                        for (int n = 0; n < 2; ++n) ss += (v[bj][n][0] * v[bj][n][0] + v[bj][n][1] * v[bj][n][1]) + (v[bj][n][2] * v[bj][n][2] + v[bj][n][3] * v[bj][n][3]);
                    ss = xsum32(xsum16(ss));
                    const float r = __builtin_amdgcn_rsqf(ss * (1.0f / 64.0f) + EPS_);
#pragma unroll
                    for (int bj = 0; bj < 2; ++bj) {
                        const unsigned p = bj ? (unsigned)(s & 63) : (unsigned)(s >> 6);
                        const f32x4 c = *(const PG8_LAS f32x4*)(tbl + (p * 64u + fqb)), sn = *(const PG8_LAS f32x4*)(tbl + (4096u + p * 64u + fqb));
                        const f32x4 g1 = *(const PG8_LAS f32x4*)(tbl + (gnoff + 128u * bj + fqb)), g2 = *(const PG8_LAS f32x4*)(tbl + (gnoff + 128u * bj + 64u + fqb));
                        const f32x4 x1 = v[bj][0] * r * g1, x2 = v[bj][1] * r * g2;
                        v[bj][0] = (x1 * c - x2 * sn) * qs; v[bj][1] = (x1 * sn + x2 * c) * qs;
                    }
                }
#ifdef HEAD_SWAP
                const unsigned ob = (unsigned)(brow0 + s) * pitchb + 16u * (unsigned)(fq >> 1) + 32u * (unsigned)(fq & 1);
#pragma unroll
                for (int bj = 0; bj < 2; ++bj) {
                    const unsigned a0 = cvt_pk_bf16(v[bj][0][0], v[bj][0][1]), a1 = cvt_pk_bf16(v[bj][0][2], v[bj][0][3]), b0 = cvt_pk_bf16(v[bj][1][0], v[bj][1][1]), b1 = cvt_pk_bf16(v[bj][1][2], v[bj][1][3]);
                    const auto s0 = __builtin_amdgcn_permlane16_swap(a0, b0, false, false), s1 = __builtin_amdgcn_permlane16_swap(a1, b1, false, false);
                    u32x4 w; w.x = s0[0]; w.y = s1[0]; w.z = s0[1]; w.w = s1[1];
                    *(u32x4*)((char*)dst + (ob + 64u * bj)) = w; }
#else
                const unsigned ob = (unsigned)(brow0 + s) * pitchb + 8u * (unsigned)fq;
#pragma unroll
                for (int bj = 0; bj < 2; ++bj)
#pragma unroll
                    for (int n = 0; n < 2; ++n) { u32x2 w; w.x = cvt_pk_bf16(v[bj][n][0], v[bj][n][1]); w.y = cvt_pk_bf16(v[bj][n][2], v[bj][n][3]); *(u32x2*)((char*)dst + (ob + 64u * bj + 32u * n)) = w; }
#endif
                if (m & 1) { asm volatile("" ::: "memory"); __builtin_amdgcn_sched_barrier(0); }
            }
    }
    __device__ __forceinline__ void operator()(const f32x4 (&acc)[2][2][4][2], const Unit& u, int wr_in, int wc_in, int fr_in, int fq_in, PG8_LAS unsigned char* lds) const {
        int fr = fr_in, fq = fq_in; asm volatile("" : "+v"(fr), "+v"(fq));
        int wr = wr_in, wc = wc_in; asm volatile("" : "+s"(wr), "+s"(wc));
        const int b = u.pm >> 3, sb = u.pm & 7, i0 = wr * 64 + fr, brow0 = b * 2048;
        int pos[2][4]; float rs[2][4];
#pragma unroll
        for (int m = 0; m < 4; ++m) { pos[0][m] = 128 * sb + i0 + 16 * m; const int q = 2048 - 128 * sb - i0 - 16 * m; pos[1][m] = (q == 2048) ? 1024 : q; }
        { int rws[2][4];
#pragma unroll
          for (int ai = 0; ai < 2; ++ai)
#pragma unroll
              for (int m = 0; m < 4; ++m) rws[ai][m] = brow0 + pos[ai][m];
          row_rstd8(stats, rws, fq, rs); }
        if (u.pn < 2) {
            const int lane = fq * 16 + fr, g = 2 * u.pn + (wc >> 1), ch0 = 32 * (wc & 1);
            const bool special = (sb == 0) && (i0 == 0);
            const bool spec_col = (ch0 == 0) && (fq == 0);
            PG8_LAS unsigned short* stg = (PG8_LAS unsigned short*)(lds + STAGE_BYTES + (wr * 4 + wc) * 2560);
            bf16_t* xt = XT2 + ((size_t)((b * 2 + u.pn) * 256 + 32 * wc) * 1024 + 128 * sb + wr * 64 + (lane & 7) * 8);
            float* tvg = Tv + (b * 512 + g * 128);
            f32x4 alt[2]; float alt64 = 0.f;
#pragma unroll
            for (int bj = 0; bj < 2; ++bj)
#pragma unroll
                for (int n = 0; n < 2; ++n) {
                    if (bj == 0) alt[n] = (f32x4){0.f, 0.f, 0.f, 0.f};
                    const bool sc = (bj == 1) && (n == 0) && spec_col;
                    const int cq = ch0 + 16 * n + 4 * fq;
#pragma unroll
                    for (int m = 0; m < 4; ++m) { const f32x4 a0 = acc[0][bj][m][n] * rs[0][m], a1 = acc[1][bj][m][n] * rs[1][m];
                        f32x4 v = (bj == 0) ? a0 + a1 : a0 - a1;
                        if (sc) v[0] = a0[0] + a1[0];
                        if (m == 0) { if (special) {
                            if (bj == 0) { *(f32x4*)(tvg + cq) = a1; v = a0; }
                            else { const float s0 = a0[0]; v = (f32x4){0.f, 0.f, 0.f, 0.f}; if (sc) { tvg[64] = a1[0]; v[0] = s0; } } } }
                        if (bj == 0) alt[n] += v; else if (sc) alt64 += v[0];
                        const unsigned w0 = cvt_pk_bf16(v[0], v[1]), w1 = cvt_pk_bf16(v[2], v[3]);
                        PG8_LAS unsigned short* p = stg + (4 * fq) * 80 + 16 * m + fr;
                        p[0] = (unsigned short)w0; p[80] = (unsigned short)(w0 >> 16); p[160] = (unsigned short)w1; p[240] = (unsigned short)(w1 >> 16); }
#pragma unroll
                    for (int i = 0; i < 2; ++i) { const int col = i * 8 + (lane >> 3);
                        const u32x4 w = *(const PG8_LAS u32x4*)(stg + col * 80 + (lane & 7) * 8);
                        *(u32x4*)(xt + (size_t)(bj * 128 + 16 * n + col) * 1024) = w; }
                    asm volatile("" ::: "memory"); __builtin_amdgcn_sched_barrier(0);
                }
            const float sg = (fr & 1) ? -1.0f : 1.0f;
            float* altg = ALTP + ((b * 16 + sb * 2 + wr) * 512 + g * 128);
#pragma unroll
            for (int n = 0; n < 3; ++n) { f32x4 a = (n < 2) ? alt[n < 2 ? n : 0] * sg : (f32x4){alt64 * sg, 0.f, 0.f, 0.f};
#pragma unroll
                for (int j = 0; j < 4; ++j) { float t = a[j];
                    t += __builtin_bit_cast(float, __builtin_amdgcn_update_dpp(0, __builtin_bit_cast(int, t), 0xB1, 0xf, 0xf, false));
                    t += __builtin_bit_cast(float, __builtin_amdgcn_update_dpp(0, __builtin_bit_cast(int, t), 0x4E, 0xf, 0xf, false));
                    t += __builtin_bit_cast(float, __builtin_amdgcn_update_dpp(0, __builtin_bit_cast(int, t), 0x141, 0xf, 0xf, false));
                    t += __builtin_bit_cast(float, __builtin_amdgcn_update_dpp(0, __builtin_bit_cast(int, t), 0x140, 0xf, 0xf, false));
                    a[j] = t; }
                if (fr == 0) {
                    if (n < 2) { const int cq = ch0 + 16 * n + 4 * fq; *(f32x4*)(altg + cq) = a; }
                    else if (spec_col) altg[64] = a[0]; } }
        } else { PG8_LAS const unsigned char* tbl = lds + WIN_TBL_OFF;
            if (u.pn < 4)      { head_path<0>(acc, Qb + (size_t)((u.pn - 2) * 4 + wc) * 64, 1024u, tbl, 8192u, rs, pos, brow0, fq); }
            else if (wc < 2)   { head_path<1>(acc, Kb + (size_t)wc * 64, 256u, tbl, 8448u, rs, pos, brow0, fq); }
            else               { head_path<2>(acc, Vb + (size_t)(wc - 2) * 64, 256u, tbl, 8448u, rs, pos, brow0, fq); } }
    }
};

struct EpiDft {
    static constexpr bool PERM = true, AFTER_DRAIN = false, PROBE_TWICE = false, ZFIRST = ZFIRST_OTHER;
    __device__ __forceinline__ EpiDft second() const { return *this; }
    bf16_t* __restrict__ O; const float* __restrict__ Tv; const float* __restrict__ ALTP;
    __device__ __forceinline__ void operator()(const f32x4 (&acc)[2][2][4][2], const Unit& u, int wr, int wc, int fr_in, int fq_in, PG8_LAS unsigned char*) const {
        int fr = fr_in, fq = fq_in; asm volatile("" : "+v"(fr), "+v"(fq));
        const int b = u.pm >> 3, kb = u.pm & 7, g = 2 * u.pn + (wc >> 1), c0 = 32 * (wc & 1) + 8 * fq, cc = g * 128 + c0;
        const bool sp = (c0 == 0);
        const float sc = 1.0f / 512.0f;
        const f32x4 t0 = *(const f32x4*)(Tv + b * 512 + cc) * sc, t1 = *(const f32x4*)(Tv + b * 512 + cc + 4) * sc;
        const float t64 = Tv[b * 512 + g * 128 + 64] * sc;
        const float sg = (fr & 1) ? -1.0f : 1.0f;
#pragma unroll
        for (int m = 0; m < 4; ++m) {
            const int k = 128 * kb + 64 * wr + 16 * m + fr;
            f32x4 q0 = acc[1][1][m][0]; const f32x4 q1 = acc[1][1][m][1];
            if (sp) q0[0] = 0.f;
            const f32x4 b0 = acc[0][0][m][0] + t0 * sg, b1 = acc[0][0][m][1] + t1 * sg;
            const f32x4 x0 = b0 - q0, x1 = b1 - q1, y0 = b0 + q0, y1 = b1 + q1;
            const float s64 = acc[0][1][m][0][0] + t64 * sg;
            f32x4 mk0 = y0, m20 = x0;
            if (sp) { mk0[0] = s64; m20[0] = s64; }
            f32x4 p20 = y0, p21 = y1, m21 = x1;
            int k2 = 2048 - k;
            if (k == 0) { k2 = 1024; f32x4 s0 = t0, s1 = t1; float sa = t64;
#ifdef ALT_UNROLL
#pragma unroll
#endif
                for (int p = 0; p < 16; ++p) { s0 += *(const f32x4*)(ALTP + (b * 16 + p) * 512 + cc) * sc; s1 += *(const f32x4*)(ALTP + (b * 16 + p) * 512 + cc + 4) * sc; sa += ALTP[(b * 16 + p) * 512 + g * 128 + 64] * sc; }
                p20 = s0; p21 = s1; m20 = s0; m21 = s1; if (sp) m20[0] = sa; }
            u32x4 w; bf16_t* o1 = (bf16_t*)((char*)O + ((unsigned)(b * 2048 + k) * DM_ + (unsigned)cc) * 2u); bf16_t* o2 = (bf16_t*)((char*)O + ((unsigned)(b * 2048 + k2) * DM_ + (unsigned)cc) * 2u);
            w.x = cvt_pk_bf16(x0[0], x0[1]); w.y = cvt_pk_bf16(x0[2], x0[3]); w.z = cvt_pk_bf16(x1[0], x1[1]); w.w = cvt_pk_bf16(x1[2], x1[3]);
            *(u32x4*)o1 = w;
            w.x = cvt_pk_bf16(mk0[0], mk0[1]); w.y = cvt_pk_bf16(mk0[2], mk0[3]); w.z = cvt_pk_bf16(y1[0], y1[1]); w.w = cvt_pk_bf16(y1[2], y1[3]);
            *(u32x4*)(o1 + 64) = w;
            w.x = cvt_pk_bf16(p20[0], p20[1]); w.y = cvt_pk_bf16(p20[2], p20[3]); w.z = cvt_pk_bf16(p21[0], p21[1]); w.w = cvt_pk_bf16(p21[2], p21[3]);
            *(u32x4*)o2 = w;
            w.x = cvt_pk_bf16(m20[0], m20[1]); w.y = cvt_pk_bf16(m20[2], m20[3]); w.z = cvt_pk_bf16(m21[0], m21[1]); w.w = cvt_pk_bf16(m21[2], m21[3]);
            *(u32x4*)(o2 + 64) = w;
        }
    }
};

#define PRIO_IN_ 0
#define PRIO_OUT_ 0
__device__ __forceinline__ void pg8_glds(const void* sbase, unsigned voff, unsigned lds_dst) {
#ifdef GLDS_M0_CLOBBER
    asm volatile("s_mov_b32 m0, %2\n\ts_nop 0\n\tglobal_load_lds_dwordx4 %0, %1" : : "v"(voff), "s"(sbase), "s"(lds_dst) : "memory", "m0");
#else
    unsigned keep; asm volatile("s_mov_b32 %0, m0\n\ts_mov_b32 m0, %3\n\ts_nop 0\n\tglobal_load_lds_dwordx4 %1, %2\n\ts_mov_b32 m0, %0" : "=&s"(keep) : "v"(voff), "s"(sbase), "s"(lds_dst) : "memory");
#endif
}
template <class Epi, class Sched, bool ALIGN_EPI = false, bool SP2 = false, bool AREV = false, int DIAG = 0, bool IMM = false, bool PF = false, int AAUX = 0>
__device__ __forceinline__ void gemm_phase(PG8_LAS unsigned char* lds, const Gemm g, const Sched& S, const Epi& E) {
    int tid_ = threadIdx.x; asm volatile("" : "+v"(tid_));
    const int tid = tid_, wid = __builtin_amdgcn_readfirstlane(tid >> 6), lane = tid & 63, wr = wid >> 2, wc = wid & 3, fr = lane & 15, fq = lane >> 4;
    const int K = g.K, nt = K / BK;
    unsigned voffA[2], voffB[2], voffA1[2];
#pragma unroll
    for (int i = 0; i < 2; ++i) { int R, C; stage_rc(tid * 16 + i * 8192, R, C); const int Rb = Epi::PERM ? ((R & ~31) + perm32(R & 31)) : R;
        voffA[i] = (unsigned)(R * K + C) * 2u; voffB[i] = (unsigned)(Rb * K + C) * 2u; voffA1[i] = AREV ? (unsigned)((1024 - R) * K + C) * 2u : voffA[i]; }
    const unsigned arev_th = 1024u * (unsigned)K * 2u;
    static_assert(!PF || (!AREV && !IMM && SP2), "PF: plain SP2 loop only");
    unsigned pf_dummy = 0u; const unsigned pf_voff = (unsigned)(((wid & 3) * 64 + lane) * K) * 2u;
    const bool pf_isB = wid >= 4;
    const size_t kstep = (size_t)(BK * 2);
    const int kr = S.krot(nt);
#define PG8_KO(t) ((size_t)(((t) + kr) >= nt ? ((t) + kr) - nt : ((t) + kr)) * kstep)
    const size_t hstep = (size_t)HALF * K * 2;
    const size_t tstep = 2 * hstep;
    const unsigned ldsw = (unsigned)wid * 1024u;
    const int aoff = lds_byte(wr * 64 + fr, fq * 8), boff = lds_byte(wc * 32 + fr, fq * 8);
#define PG8_SA(b, h) (((b) * 2 + (h)) * HTB)
#define PG8_SB(b, h) ((4 + (b) * 2 + (h)) * HTB)
#define PG8_STAGE(bufoff, gbase, voff) do { _Pragma("unroll") for (int _i = 0; _i < 2; ++_i) \
        pg8_glds((const void*)(gbase), (voff)[_i], (unsigned)(unsigned long)(lds + (bufoff) + ldsw + _i * 8192)); } while (0)
#define PG8_STAGE_A1(bufoff, gbase, spec) do { _Pragma("unroll") for (int _i = 0; _i < 2; ++_i) { unsigned _vo = voffA1[_i]; if (AREV) { if (spec) _vo = (_vo >= arev_th) ? _vo - arev_th : _vo; } \
        pg8_glds((const void*)(gbase), _vo, (unsigned)(unsigned long)(lds + (bufoff) + ldsw + _i * 8192)); } } while (0)
#define PG8_STAGEA(bufoff, gbase, voff) do { _Pragma("unroll") for (int _i = 0; _i < 2; ++_i) \
        pg8_glds((const void*)(gbase), (voff)[_i], (unsigned)(unsigned long)(lds + (bufoff) + ldsw + _i * 8192)); } while (0)
#ifndef B_AUX
#define B_AUX 0
#endif
#define PG8_STAGEB(bufoff, gbase, voff) do { _Pragma("unroll") for (int _i = 0; _i < 2; ++_i) \
        pg8_glds((const void*)(gbase), (voff)[_i], (unsigned)(unsigned long)(lds + (bufoff) + ldsw + _i * 8192)); } while (0)
#define PG8_LDA(dst, b, h) do { _Pragma("unroll") for (int m = 0; m < 4; ++m) _Pragma("unroll") for (int k = 0; k < 2; ++k) dst[m][k] = *(const PG8_LAS bf16x8*)(lds + PG8_SA(b, h) + aoff + m * 2048 + k * 1024); } while (0)
#define PG8_LDB(dst, b, h) do { _Pragma("unroll") for (int n = 0; n < 2; ++n) _Pragma("unroll") for (int k = 0; k < 2; ++k) dst[n][k] = *(const PG8_LAS bf16x8*)(lds + PG8_SB(b, h) + boff + n * 2048 + k * 1024); } while (0)
#define PG8_MMA(ai, bj, At, Bt) do { __builtin_amdgcn_s_setprio(PRIO_IN_); _Pragma("unroll") for (int m = 0; m < 4; ++m) _Pragma("unroll") for (int n = 0; n < 2; ++n) _Pragma("unroll") for (int k = 0; k < 2; ++k) \
        acc[ai][bj][m][n] = __builtin_amdgcn_mfma_f32_16x16x32_bf16(Bt[n][k], At[m][k], acc[ai][bj][m][n], 0, 0, 0); __builtin_amdgcn_s_setprio(PRIO_OUT_); } while (0)
#define PG8_MMAZ(ai, bj, At, Bt) do { if (zf_) { __builtin_amdgcn_s_setprio(PRIO_IN_); _Pragma("unroll") for (int m = 0; m < 4; ++m) _Pragma("unroll") for (int n = 0; n < 2; ++n) { \
        acc[ai][bj][m][n] = __builtin_amdgcn_mfma_f32_16x16x32_bf16(Bt[n][0], At[m][0], (f32x4){0.f, 0.f, 0.f, 0.f}, 0, 0, 0); acc[ai][bj][m][n] = __builtin_amdgcn_mfma_f32_16x16x32_bf16(Bt[n][1], At[m][1], acc[ai][bj][m][n], 0, 0, 0); } __builtin_amdgcn_s_setprio(PRIO_OUT_); } else PG8_MMA(ai, bj, At, Bt); } while (0)
#define PG8_STAGE1(bufoff, gbase, voff, i) pg8_glds((const void*)(gbase), (voff)[i], (unsigned)(unsigned long)(lds + (bufoff) + ldsw + (i) * 8192))
#define PG8_STAGE1_A1(bufoff, gbase, spec, i) do { unsigned _vo = voffA1[i]; if (AREV) { if (spec) _vo = (_vo >= arev_th) ? _vo - arev_th : _vo; } \
        pg8_glds((const void*)(gbase), _vo, (unsigned)(unsigned long)(lds + (bufoff) + ldsw + (i) * 8192)); } while (0)
#define PG8_MMA_H(ai, bj, At, Bt, HOOK) do { __builtin_amdgcn_s_setprio(PRIO_IN_); _Pragma("unroll") for (int m = 0; m < 4; ++m) { _Pragma("unroll") for (int n = 0; n < 2; ++n) _Pragma("unroll") for (int k = 0; k < 2; ++k) \
        acc[ai][bj][m][n] = __builtin_amdgcn_mfma_f32_16x16x32_bf16(Bt[n][k], At[m][k], acc[ai][bj][m][n], 0, 0, 0); HOOK(m); __builtin_amdgcn_sched_barrier(0); } __builtin_amdgcn_s_setprio(PRIO_OUT_); } while (0)
#define PG8_WAIT_V(n) asm volatile("s_waitcnt vmcnt(" #n ")" ::: "memory")
#define PG8_WAIT_L(n) asm volatile("s_waitcnt lgkmcnt(" #n ")" ::: "memory")
#define PG8_BAR __builtin_amdgcn_s_barrier()
#define PG8_SCHED __builtin_amdgcn_sched_barrier(0)
    Unit cur, nxt; int ui = 0;
    if (!S.next(0, cur)) return;
    f32x4 acc[2][2][4][2];
#pragma unroll
    for (int a = 0; a < 2; ++a)
#pragma unroll
        for (int b = 0; b < 2; ++b)
#pragma unroll
            for (int m = 0; m < 4; ++m)
#pragma unroll
                for (int n = 0; n < 2; ++n) acc[a][b][m][n] = (f32x4){0.f, 0.f, 0.f, 0.f};
    bf16x8 At[4][2], B0[2][2], B1[2][2]; bool zl_ = false;
    bool zfc_ = true;
    const size_t rstep = (size_t)K * 2;
    const char* cA = (const char*)g.A + (size_t)cur.a0row * rstep; const char* cA1 = (const char*)g.A + (size_t)cur.a1row * rstep; const char* cB = (const char*)g.Bt + (size_t)cur.brow * tstep; int cspec = cur.spec;
    S.a_ready(cur);
    if constexpr (SP2) {
        PG8_STAGEB(PG8_SB(0, 0), cB + PG8_KO(0), voffB); PG8_STAGEB(PG8_SB(0, 1), cB + hstep + PG8_KO(0), voffB); PG8_STAGEA(PG8_SA(0, 0), cA + PG8_KO(0), voffA); PG8_STAGE_A1(PG8_SA(0, 1), cA1 + PG8_KO(0), cspec);
        if (wr == 1) PG8_BAR;
        PG8_WAIT_V(2); PG8_BAR;
        PG8_STAGEB(PG8_SB(1, 0), cB + PG8_KO(1), voffB); PG8_STAGEA(PG8_SA(1, 0), cA + PG8_KO(1), voffA); PG8_STAGEB(PG8_SB(1, 1), cB + hstep + PG8_KO(1), voffB);
        PG8_WAIT_V(6); PG8_BAR;
    } else {
        PG8_STAGEB(PG8_SB(0, 0), cB, voffB); PG8_STAGEA(PG8_SA(0, 0), cA, voffA); PG8_STAGEB(PG8_SB(0, 1), cB + hstep, voffB); PG8_STAGEA(PG8_SA(0, 1), cA + hstep, voffA);
        if (wr == 1) PG8_BAR;
        PG8_WAIT_V(4); PG8_BAR;
        PG8_STAGEB(PG8_SB(1, 0), cB + kstep, voffB); PG8_STAGEA(PG8_SA(1, 0), cA + kstep, voffA); PG8_STAGEB(PG8_SB(1, 1), cB + hstep + kstep, voffB);
        PG8_WAIT_V(6); PG8_BAR;
    }
    for (;;) {
        const bool has_next = S.next(ui + 1, nxt);
        const char* nA = has_next ? (const char*)g.A + (size_t)nxt.a0row * rstep : cA; const char* nA1 = has_next ? (const char*)g.A + (size_t)nxt.a1row * rstep : cA1; const char* nB = has_next ? (const char*)g.Bt + (size_t)nxt.brow * tstep : cB; const int nspec = has_next ? nxt.spec : cspec;
        for (int t = 0; t < nt; t += 2) {
            const bool last = (t == nt - 2); const bool zf_ = Epi::ZFIRST && zfc_; zfc_ = false;
            const char* a1 = cA + PG8_KO(t + 1);
            const char* a2 = last ? nA + PG8_KO(0) : cA + PG8_KO(t + 2); const char* b2 = last ? nB + PG8_KO(0) : cB + PG8_KO(t + 2);
            const char* a3 = last ? nA + PG8_KO(1) : cA + PG8_KO(t + 3); const char* b3 = last ? nB + PG8_KO(1) : cB + PG8_KO(t + 3);
            const char* a1h = cA1 + PG8_KO(t + 1); const char* a2h = last ? nA1 + PG8_KO(0) : cA1 + PG8_KO(t + 2); const int spec2 = last ? nspec : cspec;
            if (last && has_next) S.a_ready(nxt);
            if constexpr (SP2 && IMM) {
#define H_NONE(m) do {} while (0)
#define H_SP1_A(m) do { if ((m) < 2) PG8_STAGE1_A1(PG8_SA(1, 1), a1h, cspec, (m)); } while (0)
#define H_SP1_B(m) do { if ((m) < 2) PG8_STAGE1_A1(PG8_SA(0, 1), a2h, spec2, (m)); } while (0)
#define H_SP2_A0(m) do { if ((m) < 2) PG8_STAGE1(PG8_SB(0, 0), b2, voffB, (m)); else PG8_STAGE1(PG8_SB(0, 1), b2 + hstep, voffB, (m) - 2); } while (0)
#define H_SP2_A1(m) do { if ((m) < 2) PG8_STAGE1(PG8_SA(0, 0), a2, voffA, (m)); } while (0)
#define H_SP2_B0(m) do { if ((m) < 2) PG8_STAGE1(PG8_SB(1, 0), b3, voffB, (m)); else PG8_STAGE1(PG8_SB(1, 1), b3 + hstep, voffB, (m) - 2); } while (0)
#define H_SP2_B1(m) do { if ((m) < 2) PG8_STAGE1(PG8_SA(1, 0), a3, voffA, (m)); } while (0)
#define H_SP2_AD(m) do { if ((m) == 0) { PG8_STAGE1(PG8_SB(0, 0), b2, voffB, 0); PG8_STAGE1(PG8_SB(0, 0), b2, voffB, 1); } else if ((m) == 1) { PG8_STAGE1(PG8_SB(0, 1), b2 + hstep, voffB, 0); PG8_STAGE1(PG8_SB(0, 1), b2 + hstep, voffB, 1); } else PG8_STAGE1(PG8_SA(0, 0), a2, voffA, (m) - 2); } while (0)
#define H_SP2_BD(m) do { if ((m) == 0) { PG8_STAGE1(PG8_SB(1, 0), b3, voffB, 0); PG8_STAGE1(PG8_SB(1, 0), b3, voffB, 1); } else if ((m) == 1) { PG8_STAGE1(PG8_SB(1, 1), b3 + hstep, voffB, 0); PG8_STAGE1(PG8_SB(1, 1), b3 + hstep, voffB, 1); } else PG8_STAGE1(PG8_SA(1, 0), a3, voffA, (m) - 2); } while (0)
            PG8_LDB(B0, 0, 0); PG8_LDB(B1, 0, 1); PG8_SCHED; PG8_LDA(At, 0, 0);
            PG8_WAIT_V(6); PG8_WAIT_L(0); PG8_BAR; PG8_MMA_H(0, 0, At, B0, H_SP1_A); if constexpr (!DIAG) PG8_MMA(0, 1, At, B1); PG8_BAR; PG8_SCHED;
            PG8_LDA(At, 0, 1);
            PG8_WAIT_V(2); PG8_WAIT_L(0); PG8_BAR; if constexpr (!DIAG) { PG8_MMA_H(1, 0, At, B0, H_SP2_A0); PG8_MMA_H(1, 1, At, B1, H_SP2_A1); } else { PG8_MMA_H(1, 1, At, B1, H_SP2_AD); } PG8_BAR; PG8_SCHED;
            PG8_LDB(B0, 1, 0); PG8_LDB(B1, 1, 1); PG8_SCHED; PG8_LDA(At, 1, 0);
            PG8_WAIT_V(6); PG8_WAIT_L(0); PG8_BAR; PG8_MMA_H(0, 0, At, B0, H_SP1_B); if constexpr (!DIAG) PG8_MMA(0, 1, At, B1); PG8_BAR; PG8_SCHED;
            PG8_LDA(At, 1, 1);
            PG8_WAIT_V(2); PG8_WAIT_L(0); PG8_BAR; if constexpr (!DIAG) { PG8_MMA_H(1, 0, At, B0, H_SP2_B0); PG8_MMA_H(1, 1, At, B1, H_SP2_B1); } else { PG8_MMA_H(1, 1, At, B1, H_SP2_BD); } PG8_BAR; PG8_SCHED;
            } else
            if constexpr (SP2) {
            if constexpr (PF) { const int t4 = t + 4; const char* pb = (t4 < nt) ? (pf_isB ? cB : cA) + PG8_KO(t4) : (pf_isB ? nB : nA) + PG8_KO(t4 - nt);
                asm volatile("s_nop 4\n\tglobal_load_dword %0, %1, %2" : "+v"(pf_dummy) : "v"(pf_voff), "s"(pb) : "memory"); }
            PG8_LDB(B0, 0, 0); PG8_LDB(B1, 0, 1); PG8_SCHED; PG8_LDA(At, 0, 0); PG8_STAGE_A1(PG8_SA(1, 1), a1h, cspec);
            if constexpr (!Epi::ZFIRST) { if (zl_) { zl_ = false;
                _Pragma("unroll") for (int a = 0; a < 2; ++a) _Pragma("unroll") for (int b = 0; b < 2; ++b) _Pragma("unroll") for (int m = 0; m < 4; ++m) _Pragma("unroll") for (int n = 0; n < 2; ++n) acc[a][b][m][n] = (f32x4){0.f, 0.f, 0.f, 0.f}; } }
            if constexpr (PF) PG8_WAIT_V(9); else PG8_WAIT_V(8); PG8_WAIT_L(0); PG8_BAR; PG8_MMAZ(0, 0, At, B0); if constexpr (DIAG != 1) PG8_MMAZ(0, 1, At, B1); PG8_BAR; PG8_SCHED;
            PG8_LDA(At, 0, 1); PG8_STAGEB(PG8_SB(0, 0), b2, voffB); PG8_STAGEB(PG8_SB(0, 1), b2 + hstep, voffB); PG8_STAGEA(PG8_SA(0, 0), a2, voffA);
            if constexpr (PF) PG8_WAIT_V(9); else PG8_WAIT_V(8); PG8_WAIT_L(0); PG8_BAR; if constexpr (DIAG == 0) PG8_MMAZ(1, 0, At, B0); PG8_MMAZ(1, 1, At, B1); PG8_BAR; PG8_SCHED;
            if constexpr (PF) { const int t5 = t + 5; const char* pb = (t5 < nt) ? (pf_isB ? cB : cA) + PG8_KO(t5) : (pf_isB ? nB : nA) + PG8_KO(t5 - nt);
                asm volatile("s_nop 4\n\tglobal_load_dword %0, %1, %2" : "+v"(pf_dummy) : "v"(pf_voff), "s"(pb) : "memory"); }
            PG8_LDB(B0, 1, 0); PG8_LDB(B1, 1, 1); PG8_SCHED; PG8_LDA(At, 1, 0); PG8_STAGE_A1(PG8_SA(0, 1), a2h, spec2);
            if constexpr (PF) PG8_WAIT_V(9); else PG8_WAIT_V(8); PG8_WAIT_L(0); PG8_BAR; PG8_MMA(0, 0, At, B0); if constexpr (DIAG != 1) PG8_MMA(0, 1, At, B1); PG8_BAR; PG8_SCHED;
            PG8_LDA(At, 1, 1); PG8_STAGEB(PG8_SB(1, 0), b3, voffB); PG8_STAGEB(PG8_SB(1, 1), b3 + hstep, voffB); PG8_STAGEA(PG8_SA(1, 0), a3, voffA);
            if constexpr (PF) PG8_WAIT_V(9); else PG8_WAIT_V(8); PG8_WAIT_L(0); PG8_BAR; if constexpr (DIAG == 0) PG8_MMA(1, 0, At, B0); PG8_MMA(1, 1, At, B1); PG8_BAR; PG8_SCHED;
            } else {
            PG8_LDB(B0, 0, 0); PG8_SCHED; PG8_LDA(At, 0, 0); PG8_STAGEA(PG8_SA(1, 1), a1 + hstep, voffA);
            PG8_WAIT_L(8); PG8_BAR; PG8_WAIT_L(0); PG8_MMA(0, 0, At, B0); PG8_BAR; PG8_SCHED;
            PG8_LDB(B1, 0, 1); PG8_STAGEB(PG8_SB(0, 0), b2, voffB);
            PG8_BAR; PG8_WAIT_L(0); PG8_MMA(0, 1, At, B1); PG8_BAR;
            PG8_LDA(At, 0, 1); PG8_STAGEA(PG8_SA(0, 0), a2, voffA);
            PG8_BAR; PG8_WAIT_L(0); PG8_MMA(1, 0, At, B0); PG8_BAR; PG8_SCHED;
            PG8_STAGEB(PG8_SB(0, 1), b2 + hstep, voffB);
            PG8_WAIT_V(6); PG8_BAR; PG8_MMA(1, 1, At, B1); PG8_BAR;
            PG8_LDB(B0, 1, 0); PG8_SCHED; PG8_LDA(At, 1, 0); PG8_STAGEA(PG8_SA(0, 1), a2 + hstep, voffA);
            PG8_WAIT_L(8); PG8_BAR; PG8_WAIT_L(0); PG8_MMA(0, 0, At, B0); PG8_BAR; PG8_SCHED;
            PG8_LDB(B1, 1, 1); PG8_STAGEB(PG8_SB(1, 0), b3, voffB);
            PG8_BAR; PG8_WAIT_L(0); PG8_MMA(0, 1, At, B1); PG8_BAR;
            PG8_LDA(At, 1, 1); PG8_STAGEA(PG8_SA(1, 0), a3, voffA);
            PG8_BAR; PG8_WAIT_L(0); PG8_MMA(1, 0, At, B0); PG8_BAR; PG8_SCHED;
            PG8_STAGEB(PG8_SB(1, 1), b3 + hstep, voffB);
            PG8_WAIT_V(6); PG8_BAR; PG8_MMA(1, 1, At, B1); PG8_BAR;
            }
        }
        if constexpr (ALIGN_EPI) { if (wr == 0) PG8_BAR; }
        if constexpr (!Epi::AFTER_DRAIN) { E(acc, cur, wr, wc, fr, fq, lds); if constexpr (Epi::PROBE_TWICE) { auto E2 = E.second(); E2(acc, cur, wr, wc, fr, fq, lds); } S.done(cur); }
        if (!has_next) break;
        zl_ = true;
        if constexpr (!(SP2 && !IMM))
#pragma unroll
        for (int a = 0; a < 2; ++a)
#pragma unroll
            for (int b = 0; b < 2; ++b)
#pragma unroll
                for (int m = 0; m < 4; ++m)
#pragma unroll
                    for (int n = 0; n < 2; ++n) acc[a][b][m][n] = (f32x4){0.f, 0.f, 0.f, 0.f};
        cur = nxt; cA = nA; cA1 = nA1; cB = nB; cspec = nspec; ++ui; zfc_ = true;
        if constexpr (ALIGN_EPI) { if (wr == 1) PG8_BAR; }
    }
    PG8_WAIT_V(0); asm volatile("" :: "v"(pf_dummy));
    if constexpr (!ALIGN_EPI) { if (wr == 0) PG8_BAR; }
    PG8_BAR;
    if constexpr (Epi::AFTER_DRAIN) { E.fused(acc, cur, wr, wc, fr, fq, lds, wid, lane); S.done(cur); }
#undef PG8_SA
#undef PG8_SB
#undef PG8_STAGE
#undef PG8_STAGE_A1
#undef PG8_KO
#undef PG8_LDA
#undef PG8_LDB
#undef PG8_MMA
#undef PG8_WAIT_V
#undef PG8_WAIT_L
#undef PG8_BAR
#undef PG8_SCHED
}
}
namespace attn_body {
using bf16=__hip_bfloat16;
using bf16x8=__attribute__((ext_vector_type(8)))short;
using s16x4=__attribute__((ext_vector_type(4)))short;
using f32x16=__attribute__((ext_vector_type(16)))float;
using u32x4=__attribute__((ext_vector_type(4)))unsigned;
constexpr int BATCH=16,NHEAD=8,SEQ=2048,D=64; constexpr int QP=512,KP=128,VP=128,OP=1024,OCOL=512;
constexpr int NW=8,QBLK=32,QB=QBLK*NW,KVBLK=64,NQB=SEQ/QB;
constexpr int ATTN_UNIT_ROWS=QB;
__device__ __forceinline__ int crow(int r,int hi){return (r&3)+8*(r>>2)+4*hi;}
#define SBAR() __builtin_amdgcn_sched_barrier(0)
__device__ __forceinline__ void cmask(f32x16&p0,f32x16&p1,int jb,int qrel,int hi){
  const float NEG=-INFINITY; int kb=64*jb+4*hi;
  #pragma unroll
  for(int r=0;r<16;++r){int kv=kb+(r&3)+8*(r>>2); if(kv>qrel)p0[r]=NEG; if(kv+32>qrel)p1[r]=NEG;}
}

constexpr int NSLOT=3, SLOTB=8192;
constexpr int LDS_K=0, LDS_V=NSLOT*SLOTB, LDS_WS=2*NSLOT*SLOTB, LDS_OST=LDS_WS+NW*64*4, LDS_BYTES=LDS_OST+NW*4096;
constexpr float C2=0.125f*1.4426950408889634f;
__device__ __forceinline__ void glds16(const void*gsrc,unsigned lds_dst){unsigned keep;
  asm volatile("s_mov_b32 %0, m0\n\ts_mov_b32 m0, %2\n\ts_nop 0\n\tglobal_load_lds_dwordx4 %1, off\n\ts_mov_b32 m0, %0":"=&s"(keep):"v"(gsrc),"s"(lds_dst):"memory");}
__device__ __forceinline__ float max3f(float a,float b,float c){float r;asm("v_max3_f32 %0, %1, %2, %3":"=v"(r):"v"(a),"v"(b),"v"(c));return r;}
__device__ __forceinline__ float max2f(float a,float b){float r;asm("v_max_f32_e32 %0, %1, %2":"=v"(r):"v"(a),"v"(b));return r;}
__device__ __forceinline__ float fadd_s(float a,float b){float r;asm("v_add_f32_e32 %0, %1, %2":"=v"(r):"v"(a),"v"(b));return r;}
__device__ __forceinline__ float fsub_s(float a,float b){float r;asm("v_sub_f32_e32 %0, %1, %2":"=v"(r):"v"(a),"v"(b));return r;}
typedef float f32x2_t __attribute__((ext_vector_type(2))); typedef __bf16 bf16x2_t __attribute__((ext_vector_type(2)));
__device__ __forceinline__ unsigned cvtpk_s(float lo,float hi){f32x2_t v={lo,hi};bf16x2_t b=__builtin_convertvector(v,bf16x2_t);return __builtin_bit_cast(unsigned,b);}
#define WAIT_BAR(N) asm volatile("s_waitcnt vmcnt(" #N ") lgkmcnt(0)\n\ts_barrier":::"memory")

__device__ __forceinline__ void qkt(f32x16&p0,f32x16&p1,const char*Kslot,const bf16x8*qr,const f32x16&negm,int r32,int hi){
  const char*kb=Kslot+hi*1024+r32*16;
  #pragma unroll
  for(int d0=0;d0<4;++d0){
    const bf16x8 b0=*reinterpret_cast<const bf16x8*>(kb+d0*2048);
    const bf16x8 b1=*reinterpret_cast<const bf16x8*>(kb+d0*2048+512);
    if(d0==0){p0=__builtin_amdgcn_mfma_f32_32x32x16_bf16(b0,qr[0],negm,0,0,0);p1=__builtin_amdgcn_mfma_f32_32x32x16_bf16(b1,qr[0],negm,0,0,0);}
    else{p0=__builtin_amdgcn_mfma_f32_32x32x16_bf16(b0,qr[d0],p0,0,0,0);p1=__builtin_amdgcn_mfma_f32_32x32x16_bf16(b1,qr[d0],p1,0,0,0);}}
}
typedef __attribute__((address_space(3))) const char* lds_cptr;
typedef short v4i16_t __attribute__((ext_vector_type(4)));
__device__ __forceinline__ void kload8(bf16x8*kf,lds_cptr kp){
  kf[0]=*(const __attribute__((address_space(3))) bf16x8*)(kp);      kf[1]=*(const __attribute__((address_space(3))) bf16x8*)(kp+512);
  kf[2]=*(const __attribute__((address_space(3))) bf16x8*)(kp+2048); kf[3]=*(const __attribute__((address_space(3))) bf16x8*)(kp+2560);
  kf[4]=*(const __attribute__((address_space(3))) bf16x8*)(kp+4096); kf[5]=*(const __attribute__((address_space(3))) bf16x8*)(kp+4608);
  kf[6]=*(const __attribute__((address_space(3))) bf16x8*)(kp+6144); kf[7]=*(const __attribute__((address_space(3))) bf16x8*)(kp+6656);
}
__device__ __forceinline__ void kload2(bf16x8*kf,lds_cptr kp,int j){ kf[2*j]=*(const __attribute__((address_space(3))) bf16x8*)(kp+j*2048); kf[2*j+1]=*(const __attribute__((address_space(3))) bf16x8*)(kp+j*2048+512); }
__device__ __forceinline__ s16x4 vtr(lds_cptr p){ return __builtin_bit_cast(s16x4,__builtin_amdgcn_ds_read_tr16_b64_v4i16((__attribute__((address_space(3))) v4i16_t*)p)); }
__device__ __forceinline__ float rowmax(const f32x16&p0,const f32x16&p1){
  float a=max3f(p0[0],p0[1],p1[0]),b=max3f(p0[2],p0[3],p1[1]);a=max3f(a,p1[2],p1[3]);
  #pragma unroll
  for(int r=4;r<16;r+=4){a=max3f(a,p0[r],p0[r+1]);b=max3f(b,p0[r+2],p0[r+3]);a=max3f(a,p1[r],p1[r+1]);b=max3f(b,p1[r+2],p1[r+3]);}
  const float m=max2f(a,b);
  auto rr=__builtin_amdgcn_permlane32_swap(__float_as_uint(m),__float_as_uint(m),false,false);
  return max2f(__uint_as_float(rr[0]),__uint_as_float(rr[1]));
}
__device__ __forceinline__ void pv(f32x16*o,int vb,bf16x8 pa0,bf16x8 pa1,bf16x8 pa2,bf16x8 pa3){
  #pragma unroll
  for(int d0=0;d0<2;++d0){s16x4 lo[4],hi[4];
    #pragma unroll
    for(int ks=0;ks<4;++ks){
      asm volatile("ds_read_b64_tr_b16 %0,%1 offset:%c2":"=&v"(lo[ks]):"v"(vb),"i"(d0*4096+ks*1024):"memory");
      asm volatile("ds_read_b64_tr_b16 %0,%1 offset:%c2":"=&v"(hi[ks]):"v"(vb),"i"(d0*4096+ks*1024+512):"memory");}
    asm volatile("s_waitcnt lgkmcnt(0)":::"memory");SBAR();
    #define PK(k) (bf16x8){lo[k][0],lo[k][1],lo[k][2],lo[k][3],hi[k][0],hi[k][1],hi[k][2],hi[k][3]}
    o[d0]=__builtin_amdgcn_mfma_f32_32x32x16_bf16(pa0,PK(0),o[d0],0,0,0);
    o[d0]=__builtin_amdgcn_mfma_f32_32x32x16_bf16(pa1,PK(1),o[d0],0,0,0);
    o[d0]=__builtin_amdgcn_mfma_f32_32x32x16_bf16(pa2,PK(2),o[d0],0,0,0);
    o[d0]=__builtin_amdgcn_mfma_f32_32x32x16_bf16(pa3,PK(3),o[d0],0,0,0);
    #undef PK
  }
}

#ifndef ATTN_STORE16
#define ATTN_STORE16(p,v) (*(u32x4*)(p)=(v))
#endif
template<int THRL> __device__ __forceinline__ void attn_unit(float coff,int b,int h,int qb,const bf16*Q,const bf16*__restrict__ K,const bf16*__restrict__ V,bf16*O,char*shm){
  int tid_=threadIdx.x; asm volatile("":"+v"(tid_)); const int tid=tid_,lane=tid&63,r32=lane&31,hi=lane>>5; const int wid=__builtin_amdgcn_readfirstlane(tid>>6);
  const long rowbase=(long)b*SEQ; const int q0=qb*QB;
  const bf16*Qw=Q+(rowbase+q0+wid*QBLK)*QP+h*D;
  const int kvh=h>>2; const bf16*Kh=K+rowbase*KP+kvh*D,*Vh=V+rowbase*VP+kvh*D;
  const unsigned lds0=(unsigned)(uintptr_t)shm;
  float*wsf=(float*)(shm+LDS_WS)+wid*64;
  const bf16*ksrc=Kh+(long)lane*KP+wid*8;
  const bf16*vsrc=Vh+(long)(16*(wid&3)+(lane>>2))*VP+(wid>>2)*32+(lane&3)*8;
  const unsigned kdst=lds0+LDS_K+wid*1024, vdst=lds0+LDS_V+wid*1024;
  #define DMA_K(t,slot) glds16(ksrc+(long)(t)*KVBLK*KP,(unsigned)__builtin_amdgcn_readfirstlane(kdst+(slot)))
  #define DMA_V(t,slot) glds16(vsrc+(long)(t)*KVBLK*VP,(unsigned)__builtin_amdgcn_readfirstlane(vdst+(slot)))
  const int vb0=(int)(lds0+LDS_V)+((lane>>4)&1)*32+(lane&3)*8+(4*hi+((lane&15)>>2))*64;
  const char*Kbase=shm+LDS_K; bf16x8 kf[8];
  const lds_cptr shm3=(lds_cptr)shm; const lds_cptr kp0=shm3+LDS_K+hi*1024+r32*16; const lds_cptr vp0=shm3+LDS_V+((lane>>4)&1)*32+(lane&3)*8+(4*hi+((lane&15)>>2))*64;
  const int NT=SEQ/KVBLK;
  DMA_K(0,0);DMA_V(0,0);DMA_K(1,SLOTB);
  bf16x8 qr[4];
  #pragma unroll
  for(int d0=0;d0<4;++d0)qr[d0]=*reinterpret_cast<const bf16x8*>(&Qw[(long)r32*QP+d0*16+hi*8]);
  float mhat=0.f,l_reg=0.f;f32x16 o[2];o[0]=f32x16{};o[1]=f32x16{};f32x16 negm=f32x16{};
#ifdef ATTN_NOMAX
  _Pragma("unroll") for(int r=0;r<16;++r)negm[r]=-coff;
#endif
  asm volatile("":"+v"(negm));
  const int qrel=wid*QBLK+r32;
  #define CMASK(P0,P1,t) do{}while(0)
  bool resc=false;
#ifdef ATTN_NOMAX
  #define START(P0,P1) do{ resc=false; _Pragma("unroll") for(int r=0;r<16;++r)P0[r]=__builtin_amdgcn_exp2f(P0[r]); }while(0)
#else
  #define START(P0,P1) do{ const float rm=rowmax(P0,P1); resc=false; \
    { const float dl=rm; mhat=fadd_s(mhat,dl); \
      _Pragma("unroll") for(int r=0;r<16;++r){P0[r]=fsub_s(P0[r],dl);P1[r]=fsub_s(P1[r],dl);} \
      _Pragma("unroll") for(int r=0;r<16;++r)negm[r]=-mhat; asm volatile("":"+v"(negm)); } \
    _Pragma("unroll") for(int r=0;r<16;++r)P0[r]=__builtin_amdgcn_exp2f(P0[r]); }while(0)
#endif
  #define RESC() do{ if(resc){ asm volatile("s_waitcnt lgkmcnt(0)":::"memory"); \
      _Pragma("unroll") for(int d_=0;d_<2;++d_) _Pragma("unroll") for(int r=0;r<16;++r)o[d_][r]*=wsf[crow(r,hi)]; } }while(0)
  f32x16 pA0,pA1,pB0,pB1;
  int sl_prev=0,sl_cur=0,sl_next=SLOTB;
  #define ROT() do{sl_prev=sl_cur;sl_cur=sl_next;sl_next=(sl_next==(NSLOT-1)*SLOTB)?0:sl_next+SLOTB;}while(0)
  DMA_K(2,2*SLOTB);
  WAIT_BAR(3);
  qkt(pA0,pA1,Kbase,qr,negm,r32,hi);asm volatile("s_nop 15\n\ts_nop 7":"+v"(pA0),"+v"(pA1));CMASK(pA0,pA1,0);
  START(pA0,pA1);
  _Pragma("unroll") for(int r=0;r<16;++r)pA1[r]=__builtin_amdgcn_exp2f(pA1[r]);
  WAIT_BAR(0);
  DMA_K(3,0);DMA_V(1,SLOTB);
  ROT();
  kload8(kf,kp0+sl_cur);
  WAIT_BAR(2);
  s16x4 vlo[8],vhi[8]; u32x4 pw0,pw1,pw2,pw3;
  #define PKW(P,B) cvtpk_s(P[B],P[B+1])
  #define PAF(k) __builtin_bit_cast(bf16x8,pw##k)
  #define VFR(i) (bf16x8){vlo[i][0],vlo[i][1],vlo[i][2],vlo[i][3],vhi[i][0],vhi[i][1],vhi[i][2],vhi[i][3]}
  #define PIN(x) asm volatile("":"+v"(x))
  #define MX3(a,b,c) __builtin_fmaxf(__builtin_fmaxf((a),(b)),(c))
  #define GAPA(MF,A0,A1,A2,A3,W0,W1,PW) do{ __builtin_amdgcn_s_setprio(1); MF; __builtin_amdgcn_s_setprio(0); sacc+=A0; sacc+=A1; sacc+=A2; sacc+=A3; PIN(sacc); W0; W1; PIN(PW); SBAR(); }while(0)
  #define EX(v) __builtin_amdgcn_exp2f(v)
  #define GAPB(MF,X,B) do{ __builtin_amdgcn_s_setprio(1); MF; __builtin_amdgcn_s_setprio(0); X[B]=EX(X[B]); X[B+1]=EX(X[B+1]); X[B+2]=EX(X[B+2]); X[B+3]=EX(X[B+3]); PIN(X); SBAR(); }while(0)
  #define VRD(i) do{ vlo[i]=vtr(vp_+(((i)>>2)*4096+((i)&3)*1024)); vhi[i]=vtr(vp_+(((i)>>2)*4096+((i)&3)*1024+512)); }while(0)
  #define KRD(G,j) do{ if(G){ kload2(kf,kp0+sl_next,j); SBAR(); } }while(0)
#ifdef ATTN_NOMAX
  #define MAXBLOCK(C0,C1) do{}while(0)
#else
  #define MAXBLOCK(C0,C1) do{ \
    { float a=MX3(C0[0],C0[1],C1[0]),b=MX3(C0[2],C0[3],C1[1]); a=MX3(a,C1[2],C1[3]); \
      _Pragma("unroll") for(int r=4;r<16;r+=4){a=MX3(a,C0[r],C0[r+1]);b=MX3(b,C0[r+2],C0[r+3]);a=MX3(a,C1[r],C1[r+1]);b=MX3(b,C1[r+2],C1[r+3]);} \
      float rm=__builtin_fmaxf(a,b); { auto rr=__builtin_amdgcn_permlane32_swap(__float_as_uint(rm),__float_as_uint(rm),false,false); rm=__builtin_fmaxf(__uint_as_float(rr[0]),__uint_as_float(rr[1])); } \
      resc=false; \
      if(__builtin_expect(__any(rm>(float)THRL),0)){ const float dl=__builtin_fmaxf(rm,0.f); mhat+=dl; \
        _Pragma("unroll") for(int r=0;r<16;++r){C0[r]-=dl;C1[r]-=dl;} \
        _Pragma("unroll") for(int r=0;r<16;++r)negm[r]=-mhat; asm volatile("":"+v"(negm)); \
        const float f=__builtin_amdgcn_exp2f(-dl); l_reg*=f; if(hi==0)wsf[r32]=f; resc=true; } } \
  }while(0)
#endif
  #define STEP(C0,C1,P0,P1,t,GK,GV,GL) do{ SBAR(); \
    const lds_cptr vp_=vp0+sl_prev; \
    VRD(0); SBAR(); float sacc=(P0[0]+P0[1]); \
    GAPA(C0=__builtin_amdgcn_mfma_f32_32x32x16_bf16(kf[0],qr[0],negm,0,0,0), P0[2],P0[3],P0[4],P0[5],     pw0[0]=PKW(P0,0), pw0[1]=PKW(P0,2), pw0); \
    VRD(4); SBAR(); GAPA(C1=__builtin_amdgcn_mfma_f32_32x32x16_bf16(kf[1],qr[0],negm,0,0,0), P0[6],P0[7],P0[8],P0[9],     pw0[2]=PKW(P0,4), pw0[3]=PKW(P0,6), pw0); \
    VRD(1); SBAR(); GAPA(C0=__builtin_amdgcn_mfma_f32_32x32x16_bf16(kf[2],qr[1],C0,0,0,0),   P0[10],P0[11],P0[12],P0[13], pw1[0]=PKW(P0,8), pw1[1]=PKW(P0,10), pw1); \
    VRD(5); SBAR(); GAPA(C1=__builtin_amdgcn_mfma_f32_32x32x16_bf16(kf[3],qr[1],C1,0,0,0),   P0[14],P0[15],P1[0],P1[1],   pw1[2]=PKW(P0,12),pw1[3]=PKW(P0,14), pw1); \
    VRD(2); SBAR(); GAPA(C0=__builtin_amdgcn_mfma_f32_32x32x16_bf16(kf[4],qr[2],C0,0,0,0),   P1[2],P1[3],P1[4],P1[5],     pw2[0]=PKW(P1,0), pw2[1]=PKW(P1,2), pw2); \
    VRD(6); SBAR(); GAPA(C1=__builtin_amdgcn_mfma_f32_32x32x16_bf16(kf[5],qr[2],C1,0,0,0),   P1[6],P1[7],P1[8],P1[9],     pw2[2]=PKW(P1,4), pw2[3]=PKW(P1,6), pw2); \
    VRD(3); SBAR(); GAPA(C0=__builtin_amdgcn_mfma_f32_32x32x16_bf16(kf[6],qr[3],C0,0,0,0),   P1[10],P1[11],P1[12],P1[13], pw3[0]=PKW(P1,8), pw3[1]=PKW(P1,10), pw3); \
    VRD(7); SBAR(); GAPA(C1=__builtin_amdgcn_mfma_f32_32x32x16_bf16(kf[7],qr[3],C1,0,0,0),   P1[14],P1[15],0.f,0.f,       pw3[2]=PKW(P1,12),pw3[3]=PKW(P1,14), pw3); \
    l_reg+=sacc; \
    if(GK){DMA_K((t)+3,sl_cur);} if(GV){DMA_V((t)+1,sl_next);} \
    CMASK(C0,C1,t); \
    MAXBLOCK(C0,C1); \
    SBAR(); \
    GAPB(o[0]=__builtin_amdgcn_mfma_f32_32x32x16_bf16(PAF(0),VFR(0),o[0],0,0,0), C0,0); \
    GAPB(o[1]=__builtin_amdgcn_mfma_f32_32x32x16_bf16(PAF(0),VFR(4),o[1],0,0,0), C0,4); \
    KRD(GL,0); GAPB(o[0]=__builtin_amdgcn_mfma_f32_32x32x16_bf16(PAF(1),VFR(1),o[0],0,0,0), C0,8); \
    KRD(GL,1); GAPB(o[1]=__builtin_amdgcn_mfma_f32_32x32x16_bf16(PAF(1),VFR(5),o[1],0,0,0), C0,12); \
    KRD(GL,2); GAPB(o[0]=__builtin_amdgcn_mfma_f32_32x32x16_bf16(PAF(2),VFR(2),o[0],0,0,0), C1,0); \
    KRD(GL,3); GAPB(o[1]=__builtin_amdgcn_mfma_f32_32x32x16_bf16(PAF(2),VFR(6),o[1],0,0,0), C1,4); \
    GAPB(o[0]=__builtin_amdgcn_mfma_f32_32x32x16_bf16(PAF(3),VFR(3),o[0],0,0,0), C1,8); \
    GAPB(o[1]=__builtin_amdgcn_mfma_f32_32x32x16_bf16(PAF(3),VFR(7),o[1],0,0,0), C1,12); \
    }while(0)
  int t=1;
  #undef CMASK
  #define CMASK(P0,P1,t) do{}while(0)
  for(;t+5<NT;t+=2){
    STEP(pB0,pB1,pA0,pA1,t,true,true,true);     WAIT_BAR(2); RESC(); ROT();
    STEP(pA0,pA1,pB0,pB1,t+1,true,true,true);   WAIT_BAR(2); RESC(); ROT();
  }
  #undef CMASK
  #define CMASK(P0,P1,t) do{}while(0)
  #define ENDW(tt) do{ if((tt)+3<NT){WAIT_BAR(2);} else if((tt)+2<NT){WAIT_BAR(1);} else {WAIT_BAR(0);} }while(0)
  for(;t+1<NT;t+=2){
    STEP(pB0,pB1,pA0,pA1,t,(t+3<NT),(t+1<NT),(t+1<NT));       ENDW(t);   RESC(); ROT();
    STEP(pA0,pA1,pB0,pB1,t+1,(t+4<NT),(t+2<NT),(t+2<NT));     ENDW(t+1); RESC(); ROT();
  }
  STEP(pB0,pB1,pA0,pA1,NT-1,false,false,false); RESC();
  { float sacc=pB0[0]+pB0[1]; _Pragma("unroll") for(int r=2;r<16;++r)sacc+=pB0[r]; _Pragma("unroll") for(int r=0;r<16;++r)sacc+=pB1[r]; l_reg+=sacc;
    pw0=(u32x4){PKW(pB0,0),PKW(pB0,2),PKW(pB0,4),PKW(pB0,6)};pw1=(u32x4){PKW(pB0,8),PKW(pB0,10),PKW(pB0,12),PKW(pB0,14)};pw2=(u32x4){PKW(pB1,0),PKW(pB1,2),PKW(pB1,4),PKW(pB1,6)};pw3=(u32x4){PKW(pB1,8),PKW(pB1,10),PKW(pB1,12),PKW(pB1,14)};
    SBAR(); pv(o,vb0+sl_cur,PAF(0),PAF(1),PAF(2),PAF(3)); }
  #undef PKW
  #undef PAF
  #undef VFR
  #undef PIN
  #undef MX3
  #undef GAPA
  #undef GAPB
  #undef EX
  #undef VRD
  #undef KRD
  #undef STEP
  #undef ENDW
  {auto rr=__builtin_amdgcn_permlane32_swap(__float_as_uint(l_reg),__float_as_uint(l_reg),false,false);l_reg=__uint_as_float(rr[0])+__uint_as_float(rr[1]);}
  if(hi==0)wsf[32+r32]=l_reg;asm volatile("s_waitcnt lgkmcnt(0)":::"memory");
  float rli[16];
  #pragma unroll
  for(int r=0;r<16;++r)rli[r]=__builtin_amdgcn_rcpf(wsf[32+crow(r,hi)]);
  bf16*Ow=O+(rowbase+q0+wid*QBLK)*OP+OCOL+h*D;
  { bf16*stg=(bf16*)(shm+LDS_OST)+wid*2048;
    #pragma unroll
    for(int r=0;r<16;++r){const int orow=crow(r,hi);
      #pragma unroll
      for(int d0=0;d0<2;++d0)stg[orow*64+d0*32+r32]=__float2bfloat16(o[d0][r]*rli[r]);}
    asm volatile("s_waitcnt lgkmcnt(0)":::"memory");
    #pragma unroll
    for(int i=0;i<4;++i){const int row=i*8+(lane>>3),ch=lane&7; const u32x4 v=*(const u32x4*)(stg+row*64+ch*8); ATTN_STORE16(Ow+(long)row*OP+ch*8,v);} }
  asm volatile("s_waitcnt lgkmcnt(0)\n\ts_barrier":::"memory");
  #undef DMA_K
  #undef DMA_V
  #undef CMASK
  #undef START
  #undef RESC
  #undef ROT
}
constexpr int ATTN_LDS_BYTES=LDS_BYTES;
struct AttnTensors { const bf16* Q; const bf16* K; const bf16* V; bf16* O; };
struct AttnUnit { int b, h, qb; };
struct AttnOrder {
  int vcu, G;
  __device__ __forceinline__ AttnOrder(int grid,int v):vcu(v),G(grid){}
  __device__ __forceinline__ bool next(int i,AttnUnit&u)const{ const int L=i*G+vcu; if(L>=1024)return false; const int hq=L>>8, rem=L&255, grp=rem>>3; u.qb=rem&7; u.b=grp>>1; u.h=(grp&1)*4+hq; return true; }
  __device__ __forceinline__ void a_ready(const AttnUnit&)const{}
  __device__ __forceinline__ void done(const AttnUnit&)const{}
};
template<class Sched,int THRL=8> __device__ __forceinline__ void attn_phase(char*lds,const AttnTensors&T,const Sched&S,float coff){
  AttnUnit u;
  for(int i=0;S.next(i,u);++i){ S.a_ready(u); attn_unit<THRL>(coff,u.b,u.h,u.qb,T.Q,T.K,T.V,T.O,lds); S.done(u); }
}
#undef SBAR
#undef WAIT_BAR
}
#define GAS __attribute__((address_space(1)))
#define LAS __attribute__((address_space(3)))
typedef unsigned short bf16;
typedef unsigned v4u __attribute__((ext_vector_type(4)));
typedef float f32x4 __attribute__((ext_vector_type(4)));
typedef short bf16x8 __attribute__((ext_vector_type(8)));
typedef GAS unsigned gu32;
typedef GAS unsigned long long gu64;
#define RLX_AGENT __ATOMIC_RELAXED, __HIP_MEMORY_SCOPE_AGENT
#define LDS_WAIT() asm volatile("s_waitcnt lgkmcnt(0)" ::: "memory")
#define VM_WAIT() asm volatile("s_waitcnt vmcnt(0)" ::: "memory")
__device__ __forceinline__ unsigned long long rt() { return __builtin_amdgcn_s_memrealtime(); }
__device__ __forceinline__ unsigned f2bf(float f) { unsigned u = __builtin_bit_cast(unsigned, f); return (u + 0x7fffu + ((u >> 16) & 1u)) >> 16; }
__device__ __forceinline__ unsigned pk2(float lo, float hi) { typedef float pk2f_t __attribute__((ext_vector_type(2))); typedef __bf16 pk2b_t __attribute__((ext_vector_type(2))); const pk2f_t v = {lo, hi}; return __builtin_bit_cast(unsigned, __builtin_convertvector(v, pk2b_t)); }

#define XB_TMO      128
#define XB_XCNT(j)  (256  + 64 * (j))
#define XB_XSUB(j)  (1280 + 64 * (j))
#define XB_XGEN(j)  (2304 + 64 * (j))
#define XB_TOP      3328
#define XB_TOPGEN   3392
#define XCD_BAR_WORDS 3456
#define XB_SPIN_CAP (1u << 18)

__device__ __forceinline__ unsigned xb_ld(unsigned* p)              { return __hip_atomic_load(p, __ATOMIC_RELAXED, __HIP_MEMORY_SCOPE_AGENT); }
__device__ __forceinline__ unsigned xb_add(unsigned* p, unsigned v) { return __hip_atomic_fetch_add(p, v, __ATOMIC_RELAXED, __HIP_MEMORY_SCOPE_AGENT); }
__device__ __forceinline__ unsigned xb_xcc_id() { return (unsigned)__builtin_amdgcn_s_getreg((3 << 11) | 20) & 0xFu; }
#define XB_SPIN(cond, bar) do { unsigned _sp = 0; while (cond) { __builtin_amdgcn_s_sleep(1); \
    if ((++_sp & 255u) == 0u) { if (xb_ld(&(bar)[XB_TMO])) break; if (_sp > XB_SPIN_CAP) { atomicAdd(&(bar)[XB_TMO], 1u); break; } } } } while (0)

struct XcdBarrier {
    unsigned* bar; unsigned x;
    volatile LAS unsigned* st;
};

__device__ __forceinline__ XcdBarrier xcd_barrier_post(unsigned* bar, volatile LAS unsigned* st) {
    XcdBarrier b; b.bar = bar; b.x = xb_xcc_id(); b.st = st;
    if (threadIdx.x == 0) (void)xb_add(&bar[XB_XCNT(b.x)], 1u);
    return b;
}
__device__ __forceinline__ void xcd_barrier_complete(unsigned* bar, unsigned x, unsigned& nloc, unsigned& nx) {
    const unsigned G = gridDim.x * gridDim.y * gridDim.z;
    unsigned sum, cnt, mine, sp = 0u;
    for (;;) {
        sum = 0u; cnt = 0u; mine = 0u;
#pragma unroll
        for (unsigned j = 0; j < 16; ++j) { const unsigned c = xb_ld(&bar[XB_XCNT(j)]); sum += c; cnt += (c > 0u) ? 1u : 0u; mine = (j == x) ? c : mine; }
        if (sum == G) break;
        __builtin_amdgcn_s_sleep(1);
        if ((++sp & 255u) == 0u) { if (xb_ld(&bar[XB_TMO])) break; if (sp > XB_SPIN_CAP) { atomicAdd(&bar[XB_TMO], 1u); break; } }
    }
    nloc = mine > 0u ? mine : 1u; nx = cnt > 0u ? cnt : 1u;
}

__device__ __forceinline__ void xcd_barrier(const XcdBarrier& b) {
    asm volatile("s_waitcnt vmcnt(0)" ::: "memory");
    __syncthreads();
    if (threadIdx.x == 0) {
        unsigned* bar = b.bar;
        __builtin_amdgcn_s_waitcnt(0);
        unsigned nloc = b.st[0], nx = b.st[1];
        if (nloc == 0u) { xcd_barrier_complete(bar, b.x, nloc, nx); b.st[0] = nloc; b.st[1] = nx; }
        const unsigned old = xb_add(&bar[XB_XSUB(b.x)], 1u);
        const unsigned gen = old / nloc;
        if (old + 1u == (gen + 1u) * nloc) {
            __builtin_amdgcn_fence(__ATOMIC_RELEASE, "agent");
            asm volatile("s_waitcnt vmcnt(0)" ::: "memory");
            const unsigned og = xb_add(&bar[XB_TOP], 1u);
            const unsigned tg = og / nx;
            if (og + 1u == (tg + 1u) * nx) xb_add(&bar[XB_TOPGEN], 1u);
            else XB_SPIN(xb_ld(&bar[XB_TOPGEN]) == tg, bar);
            __builtin_amdgcn_fence(__ATOMIC_ACQUIRE, "agent");
            xb_add(&bar[XB_XGEN(b.x)], 1u);
            asm volatile("s_waitcnt vmcnt(0)" ::: "memory");
        } else {
            __builtin_amdgcn_fence(__ATOMIC_ACQUIRE, "agent");
            XB_SPIN(xb_ld(&bar[XB_XGEN(b.x)]) == gen, bar);
            asm volatile("s_waitcnt vmcnt(0)" ::: "memory");
        }
    }
    __syncthreads();
}

constexpr int NWAVES = 8;
#ifndef MK_N_LAUNCHES
#define MK_N_LAUNCHES 1
#endif
#ifndef PHASE_MASK
#define PHASE_MASK 0x1ff
#endif
#define PH_ON(k) ((PHASE_MASK >> (k)) & 1)
constexpr int N_PHASES = 8;
constexpr int N_LAUNCHES = MK_N_LAUNCHES;
static_assert(N_LAUNCHES == 1 || N_LAUNCHES == N_PHASES, "MK_N_LAUNCHES is 1 or 8");

constexpr int BATCH = 16, SEQ = 2048, DM = 1024, M = BATCH * SEQ, DFF = 2752, DFFP = 2816, NGU = 2 * DFFP, NIN = 1280, INW = 1280;
constexpr size_t MiB = 1u << 20;
constexpr size_t WS_CTL = 0, CTL_ZERO_BYTES = 128 * 1024;
constexpr size_t WS_W1 = 2 * MiB, WS_WD1 = 13 * MiB, WS_W2 = 19 * MiB, WS_WD2 = 30 * MiB, WS_WIN = 36 * MiB, WS_WOUT = 40 * MiB, WS_DFT = 42 * MiB;
constexpr size_t WS_MISC = 58 * MiB;
constexpr size_t WS_STATS = 59 * MiB;
constexpr size_t WS_XB = 67 * MiB;
constexpr size_t WS_ACT = 131 * MiB;
constexpr size_t WS_XT = 131 * MiB, WS_Q = 195 * MiB, WS_K = 227 * MiB, WS_V = 235 * MiB, WS_MIX = 243 * MiB;
constexpr size_t WS_X1 = 307 * MiB;
constexpr size_t WS_END = 435 * MiB;
static_assert(WS_W1 + (size_t)NGU * DM * 2 <= WS_WD1 && WS_WD1 + (size_t)DM * DFFP * 2 <= WS_W2 && WS_W2 + (size_t)NGU * DM * 2 <= WS_WD2 && WS_WD2 + (size_t)DM * DFFP * 2 <= WS_WIN, "ws map 1");
static_assert(WS_WIN + (size_t)NIN * DM * 2 <= WS_WOUT && WS_WOUT + (size_t)DM * DM * 2 <= WS_DFT && WS_DFT + (size_t)2048 * 4096 * 2 <= WS_MISC && WS_STATS + 4 * (size_t)M * 16 * 4 <= WS_XB, "ws map 2");
static_assert(WS_XB + (size_t)M * DM * 2 <= WS_ACT && WS_ACT + (size_t)M * DFFP * 2 <= WS_X1 && WS_XT + (size_t)BATCH * 4 * 256 * 1024 * 2 <= WS_Q && WS_Q + (size_t)M * 512 * 2 <= WS_K, "ws map 3");
static_assert(WS_K + (size_t)M * 128 * 2 <= WS_V && WS_V + (size_t)M * 128 * 2 <= WS_MIX && WS_MIX + (size_t)M * DM * 2 <= WS_X1 && WS_X1 + (size_t)M * DM * 4 <= WS_END, "ws map 4");
constexpr int CW_BAR = 4096;
constexpr int CW_SEAM = 16384;
constexpr int RING_BYTES = 131072;
constexpr int EPI_STAGE_BYTES = 8 * 2560;
constexpr int LDSCTL_OFF = RING_BYTES + EPI_STAGE_BYTES, MISC_OFF = LDSCTL_OFF + 320;
constexpr int LDS_BYTES = 163840;
static_assert(MISC_OFF + 128 <= pg8::WIN_TBL_OFF && pg8::WIN_TBL_OFF + 8704 <= LDS_BYTES && pg8::STAGE_BYTES == RING_BYTES && attn_body::ATTN_LDS_BYTES <= RING_BYTES, "LDS map");

template <int CTRL> __device__ __forceinline__ float dpp_mov(float v) { return __builtin_bit_cast(float, __builtin_amdgcn_update_dpp(0, __builtin_bit_cast(int, v), CTRL, 0xf, 0xf, false)); }
__device__ __forceinline__ float wave_sum(float v) {
    v += dpp_mov<0xB1>(v);
    v += dpp_mov<0x4E>(v);
    v += dpp_mov<0x141>(v);
    v += dpp_mov<0x140>(v);
    return pg8::xsum32(pg8::xsum16(v));
}
__device__ __forceinline__ float wave_max(float v) {
    v = fmaxf(v, dpp_mov<0xB1>(v)); v = fmaxf(v, dpp_mov<0x4E>(v)); v = fmaxf(v, dpp_mov<0x141>(v)); v = fmaxf(v, dpp_mov<0x140>(v));
    { const auto r = __builtin_amdgcn_permlane16_swap(__float_as_uint(v), __float_as_uint(v), false, false); const unsigned r0 = r[0], r1 = r[1]; v = fmaxf(__uint_as_float(r0), __uint_as_float(r1)); }
    { const auto r = __builtin_amdgcn_permlane32_swap(__float_as_uint(v), __float_as_uint(v), false, false); const unsigned r0 = r[0], r1 = r[1]; v = fmaxf(__uint_as_float(r0), __uint_as_float(r1)); }
    return v;
}
__device__ __forceinline__ void p0_transpose_item(const float* __restrict__ W, int N, int k0, int n0, bf16* __restrict__ dst, int ldk, const float* __restrict__ gain, LAS float* scr, int lane) {
    const int kk = lane >> 3, nq = lane & 7;
    f32x4 v[8];
#pragma unroll
    for (int i = 0; i < 8; ++i) v[i] = __builtin_nontemporal_load((const f32x4*)(W + (size_t)(k0 + 8 * i + kk) * N + n0 + 4 * nq));
#pragma unroll
    for (int i = 0; i < 8; ++i) { const float gsc = gain ? gain[k0 + 8 * i + kk] : 1.0f; LAS float* p = scr + (8 * i + kk) * 33 + 4 * nq;
        p[0] = v[i][0] * gsc; p[1] = v[i][1] * gsc; p[2] = v[i][2] * gsc; p[3] = v[i][3] * gsc; }
    LDS_WAIT(); asm volatile("" ::: "memory");
    const int c = lane & 7;
#pragma unroll
    for (int j = 0; j < 4; ++j) { const int n = (lane >> 3) + 8 * j; const LAS float* s = scr + (8 * c) * 33 + n;
        v4u o; o.x = pk2(s[0 * 33], s[1 * 33]); o.y = pk2(s[2 * 33], s[3 * 33]); o.z = pk2(s[4 * 33], s[5 * 33]); o.w = pk2(s[6 * 33], s[7 * 33]);
        *(v4u*)(dst + (size_t)n * ldk + k0 + 8 * c) = o; }
    LDS_WAIT(); asm volatile("" ::: "memory");
}

struct V8 { f32x4 a0, a1, a2, a3, a4, a5, a6, a7; float g0, g1, g2, g3, g4, g5, g6, g7; };
__device__ __forceinline__ V8 p0_item_load(const float* __restrict__ W, int N, int k0, int n0, int lane, const float* __restrict__ gain) {
    const float* p = W + (size_t)(k0 + (lane >> 3)) * N + n0 + 4 * (lane & 7); const size_t st = (size_t)8 * N; V8 r;
    { const float* gp = gain + k0 + (lane >> 3); r.g0 = gain ? gp[0] : 1.0f; r.g1 = gain ? gp[8] : 1.0f; r.g2 = gain ? gp[16] : 1.0f; r.g3 = gain ? gp[24] : 1.0f; r.g4 = gain ? gp[32] : 1.0f; r.g5 = gain ? gp[40] : 1.0f; r.g6 = gain ? gp[48] : 1.0f; r.g7 = gain ? gp[56] : 1.0f; }
    r.a0 = __builtin_nontemporal_load((const f32x4*)(p));          r.a1 = __builtin_nontemporal_load((const f32x4*)(p + st));     r.a2 = __builtin_nontemporal_load((const f32x4*)(p + 2 * st)); r.a3 = __builtin_nontemporal_load((const f32x4*)(p + 3 * st));
    r.a4 = __builtin_nontemporal_load((const f32x4*)(p + 4 * st)); r.a5 = __builtin_nontemporal_load((const f32x4*)(p + 5 * st)); r.a6 = __builtin_nontemporal_load((const f32x4*)(p + 6 * st)); r.a7 = __builtin_nontemporal_load((const f32x4*)(p + 7 * st));
    return r;
}
__device__ __forceinline__ void p0_item_finish(const V8 v, int k0, bf16* __restrict__ dst, int ldk, const float* __restrict__ gain, LAS float* scr, int lane) {
    const int kk = lane >> 3, nq = lane & 7;
#ifdef TR_NOCONF
#define P0_PUT(i, x) do { const float gsc = v.g##i; LAS float* p = scr + kk * 264 + 33 * nq + (i); p[0] = (x)[0] * gsc; p[8] = (x)[1] * gsc; p[16] = (x)[2] * gsc; p[24] = (x)[3] * gsc; } while (0)
#else
#define P0_PUT(i, x) do { const float gsc = v.g##i; LAS float* p = scr + (8 * (i) + kk) * 33 + 4 * nq; p[0] = (x)[0] * gsc; p[1] = (x)[1] * gsc; p[2] = (x)[2] * gsc; p[3] = (x)[3] * gsc; } while (0)
#endif
    P0_PUT(0, v.a0); P0_PUT(1, v.a1); P0_PUT(2, v.a2); P0_PUT(3, v.a3); P0_PUT(4, v.a4); P0_PUT(5, v.a5); P0_PUT(6, v.a6); P0_PUT(7, v.a7);
#undef P0_PUT
    LDS_WAIT(); asm volatile("" ::: "memory");
    const int c = lane & 7;
#pragma unroll
#ifdef TR_NOCONF
    for (int j = 0; j < 4; ++j) { const int n = (lane >> 3) + 8 * j; const LAS float* s = scr + 8 * n + c + (n >> 2);
        v4u o; o.x = pk2(s[0 * 264], s[1 * 264]); o.y = pk2(s[2 * 264], s[3 * 264]); o.z = pk2(s[4 * 264], s[5 * 264]); o.w = pk2(s[6 * 264], s[7 * 264]);
        *(v4u*)(dst + (size_t)n * ldk + k0 + 8 * c) = o; }
#else
    for (int j = 0; j < 4; ++j) { const int n = (lane >> 3) + 8 * j; const LAS float* s = scr + (8 * c) * 33 + n;
        v4u o; o.x = pk2(s[0 * 33], s[1 * 33]); o.y = pk2(s[2 * 33], s[3 * 33]); o.z = pk2(s[4 * 33], s[5 * 33]); o.w = pk2(s[6 * 33], s[7 * 33]);
        *(v4u*)(dst + (size_t)n * ldk + k0 + 8 * c) = o; }
#endif
    LDS_WAIT(); asm volatile("" ::: "memory");
}

struct Args { const float* in[17]; float* out; unsigned char* ws; int ph_lo, ph_hi, li, pad; };

__global__ void __launch_bounds__(NWAVES * 64, 2) mk_fwd(Args args) {
    extern __shared__ __attribute__((aligned(16))) unsigned char lds[];
    LAS unsigned char* const ldsp = (LAS unsigned char*)lds;
    volatile LAS unsigned* const MISC = (volatile LAS unsigned*)(ldsp + MISC_OFF);
    const int tid0 = threadIdx.x;
    gu32* const ctl = (gu32*)(args.ws + WS_CTL);
    for (int u = tid0; u < (LDS_BYTES - LDSCTL_OFF) / 4; u += NWAVES * 64) ((LAS unsigned*)(ldsp + LDSCTL_OFF))[u] = 0u;
    __syncthreads();
    XcdBarrier bar; bar.bar = (unsigned*)(ctl + CW_BAR); bar.x = 0; bar.st = nullptr;
    if (N_LAUNCHES == 1) bar = xcd_barrier_post((unsigned*)(ctl + CW_BAR), MISC + 8);
#ifndef PROBE_BAR2
#define PROBE_BAR2 0
#endif
#define GRID_BAR() do { if (N_LAUNCHES == 1) { xcd_barrier(bar); if (PROBE_BAR2) xcd_barrier(bar); } } while (0)
    const int lo = args.ph_lo, hi = args.ph_hi;

#ifndef PROBE_REPEAT
#define PROBE_REPEAT 0
#endif
    for (int ph2 = 2 * lo; ph2 < 2 * hi; ++ph2) {
        const int ph = ph2 >> 1;
        if ((ph2 & 1) && !((PROBE_REPEAT >> ph) & 1)) continue;
        const __attribute__((address_space(4))) Args* ap = (const __attribute__((address_space(4))) Args*)__builtin_amdgcn_kernarg_segment_ptr(); asm volatile("" : "+s"(ap));
        int tid_ = threadIdx.x; asm volatile("" : "+v"(tid_));
        int G = gridDim.x, bx = blockIdx.x; asm volatile("" : "+s"(G), "+s"(bx));
        const int vcu = (G % 8 == 0) ? (bx % 8) * (G / 8) + bx / 8 : bx, NGW = G * NWAVES;
        const bool late_ok = (G == 256);
        const int tid = tid_, lane = tid & 63, wave = __builtin_amdgcn_readfirstlane(tid >> 6), gw = vcu * NWAVES + wave;
        unsigned char* const ws = ap->ws;
        const float* const x = ap->in[0];
        const float* const g_ffn1 = ap->in[1]; const float* const w_gate1 = ap->in[2]; const float* const w_up1 = ap->in[3]; const float* const w_down1 = ap->in[4];
        const float* const g_mix = ap->in[5]; const float* const w_in = ap->in[6]; const float* const fnet_w = ap->in[7]; const float* const fnet_b = ap->in[8];
        const float* const q_norm = ap->in[9]; const float* const k_norm = ap->in[10]; const float* const w_out = ap->in[11];
        const float* const g_ffn2 = ap->in[12]; const float* const w_gate2 = ap->in[13]; const float* const w_up2 = ap->in[14]; const float* const w_down2 = ap->in[15];
        const float* const g_final = ap->in[16];
        float* const out = ap->out;
        bf16* const W1 = (bf16*)(ws + WS_W1); bf16* const WD1 = (bf16*)(ws + WS_WD1); bf16* const W2 = (bf16*)(ws + WS_W2); bf16* const WD2 = (bf16*)(ws + WS_WD2);
        bf16* const WIN = (bf16*)(ws + WS_WIN); bf16* const WOUT = (bf16*)(ws + WS_WOUT); bf16* const DFT = (bf16*)(ws + WS_DFT);
        float* const BIASP = (float*)(ws + WS_MISC); float* const ROPEC = (float*)(ws + WS_MISC + 4096); float* const ROPES = (float*)(ws + WS_MISC + 8192); float* const TV = (float*)(ws + WS_MISC + 16384); float* const ALTP = (float*)(ws + WS_MISC + 65536);
        float* const ST1 = (float*)(ws + WS_STATS); float* const ST2 = ST1 + (size_t)M * 16; float* const ST3 = ST2 + (size_t)M * 16; float* const ST4 = ST3 + (size_t)M * 16;
        bf16* const XB = (bf16*)(ws + WS_XB); bf16* const ACT = (bf16*)(ws + WS_ACT); bf16* const XT = (bf16*)(ws + WS_XT);
        bf16* const QB_ = (bf16*)(ws + WS_Q); bf16* const KB_ = (bf16*)(ws + WS_K); bf16* const VB_ = (bf16*)(ws + WS_V); bf16* const MIX = (bf16*)(ws + WS_MIX);
        float* const X1 = (float*)(ws + WS_X1);

#ifdef PROBE_CLOCK
        unsigned long long pc_t0 = 0, pc_r0 = 0;
        if (ph == PROBE_CLOCK) { pc_t0 = __builtin_amdgcn_s_memtime(); pc_r0 = __builtin_amdgcn_s_memrealtime(); }
#endif
        if (ph == 0 && PH_ON(0)) {
            LAS float* scr = (LAS float*)(ldsp + wave * 16384);
            const int gw0 = wave * G + bx;
            const int n1_ = 2752 * (late_ok ? 1 : 2), n2_ = 1376 * (late_ok ? 1 : 2);
            const int o2_ = n1_ % NGW, o3_ = (o2_ + n2_) % NGW, o4_ = (o3_ + 384) % NGW, o5_ = (o4_ + 1024) % NGW;
#define ROT_START(off) ((gw0 + NGW - (off)) % NGW)
            for (int it = 2752 * 0 + gw0; it < 2752 * (late_ok ? 1 : 2); it += NGW) {
                const int f = it / 2752, r = it % 2752, mat = r / 1376, r2 = r % 1376, kb = r2 / 86, nb = r2 % 86, n0 = nb * 32;
                const int drow = 256 * (n0 >> 7) + (n0 & 127) + 128 * mat;
                const float* Wsrc = f ? (mat ? w_up2 : w_gate2) : (mat ? w_up1 : w_gate1);
                p0_transpose_item(Wsrc, DFF, kb * 64, n0, (f ? W2 : W1) + (size_t)drow * DM, DM, f ? g_ffn2 : g_ffn1, scr, lane);
            }
            for (int it = ROT_START(o2_); it < 1376 * (late_ok ? 1 : 2); it += NGW) {
                const int f = it / 1376, r = it % 1376, kb = r / 32, nb = r % 32;
                p0_transpose_item(f ? w_down2 : w_down1, DM, kb * 64, nb * 32, (f ? WD2 : WD1) + (size_t)(nb * 32) * DFFP, DFFP, nullptr, scr, lane);
            }
            unsigned zz = 0u; asm volatile("" : "+v"(zz)); const v4u zero4 = {zz, zz, zz, zz};
            for (int it = ROT_START(o5_); it < 256 * (late_ok ? 1 : 2); it += NGW) {
                const int f = it >> 8, r = (it >> 1) & 127, hh = it & 1; const int row = 256 * 21 + 64 + (r & 63) + 128 * (r >> 6);
                *(v4u*)((f ? W2 : W1) + (size_t)row * DM + hh * 512 + lane * 8) = zero4;
            }
            for (int it = ROT_START(o5_); it < 128 * (late_ok ? 1 : 2); it += NGW) {
                const int f = it >> 7, row = (it & 127) * 8 + (lane >> 3);
                *(v4u*)((f ? WD2 : WD1) + (size_t)row * DFFP + DFF + (lane & 7) * 8) = zero4;
            }
            for (int it = ROT_START(o3_); it < 384; it += NGW) {
                const int kb = it / 24, blk = it % 24, bjj = blk & 1; int drow;
                if (blk < 16) { const int head = blk >> 1; drow = 256 * (2 + (head >> 2)) + 128 * bjj + 32 * (head & 3); }
                else if (blk < 20) { drow = 1024 + 128 * bjj + 32 * ((blk - 16) >> 1); }
                else { drow = 1024 + 128 * bjj + 32 * (2 + ((blk - 20) >> 1)); }
                p0_transpose_item(w_in, INW, kb * 64, 512 + 32 * blk, WIN + (size_t)drow * DM, DM, g_mix, scr, lane);
            }
            if (!late_ok) {
            for (int it = gw0; it < 256; it += NGW) {
                const int kb = 8 + it / 32, nb = it % 32;
                p0_transpose_item(w_out, DM, kb * 64, nb * 32, WOUT + (size_t)(nb * 32) * DM, DM, nullptr, scr, lane);
            }
            for (int it = gw0; it < 1024; it += NGW) {
                const int g = it >> 8, cb = (it >> 4) & 15, n = (it & 15) * 64 + lane;
                LAS float* Fl = scr;
                { const int r = lane >> 3, d0 = (lane & 7) * 16, ps = cb * 8 + r; const float* fp = fnet_w + (size_t)(g * 128 + (ps <= 64 ? ps : 192 - ps) - r) * 128;
                  f32x4 f4[4];
#pragma unroll
                  for (int e = 0; e < 4; ++e) f4[e] = *(const f32x4*)(fp + r * 128 + d0 + 4 * e);
#pragma unroll
                  for (int e = 0; e < 4; ++e)
#pragma unroll
                      for (int j = 0; j < 4; ++j) Fl[(d0 + 4 * e + j) * 8 + r] = f4[e][j]; }
                LDS_WAIT(); asm volatile("" ::: "memory");
                float a[8];
#pragma unroll
                for (int cc = 0; cc < 8; ++cc) a[cc] = 0.f;
                const float* wo = w_out + (size_t)(g * 128) * DM + n;
                for (int d = 0; d < 128; d += 16) {
                    float bq[16];
#pragma unroll
                    for (int e = 0; e < 16; ++e) bq[e] = wo[(size_t)(d + e) * DM];
#pragma unroll
                    for (int e = 0; e < 16; ++e) { const f32x4 fa = *(const LAS f32x4*)(Fl + (d + e) * 8), fb = *(const LAS f32x4*)(Fl + (d + e) * 8 + 4);
#pragma unroll
                        for (int cc = 0; cc < 4; ++cc) { a[cc] += fa[cc] * bq[e]; a[4 + cc] += fb[cc] * bq[e]; } }
                }
                v4u o; o.x = pk2(a[0], a[1]); o.y = pk2(a[2], a[3]); o.z = pk2(a[4], a[5]); o.w = pk2(a[6], a[7]);
                *(v4u*)(WOUT + (size_t)n * DM + g * 128 + cb * 8) = o;
                LDS_WAIT(); asm volatile("" ::: "memory");
            }
            for (int it = gw0; it < 128; it += NGW) {
                f32x4 p0 = {0.f, 0.f, 0.f, 0.f}, p1 = {0.f, 0.f, 0.f, 0.f}; f32x4 wv[8][2]; float fb[8];
#pragma unroll
                for (int i = 0; i < 8; ++i) { const int r = lane + 64 * i; fb[i] = fnet_b[r]; wv[i][0] = *(const f32x4*)(w_out + (size_t)r * DM + it * 8); wv[i][1] = *(const f32x4*)(w_out + (size_t)r * DM + it * 8 + 4); }
#pragma unroll
                for (int i = 0; i < 8; ++i) { p0 += wv[i][0] * fb[i]; p1 += wv[i][1] * fb[i]; }
                float o8[8];
#pragma unroll
                for (int j = 0; j < 4; ++j) { o8[j] = wave_sum(p0[j]); o8[4 + j] = wave_sum(p1[j]); }
                if (lane == 0) { *(f32x4*)(BIASP + it * 8) = (f32x4){o8[0], o8[1], o8[2], o8[3]}; *(f32x4*)(BIASP + it * 8 + 4) = (f32x4){o8[4], o8[5], o8[6], o8[7]}; }
            }
            }
            for (int it = ROT_START(o4_); it < 1024; it += NGW) {
                const int kb8 = it >> 3, g = (it >> 1) & 3, q = it & 1, c = lane; const bool spec = q && (lane == 0);
                LAS float* T = scr;
                LAS float* Wl = scr + 256;
                { const float a0 = (float)lane * (1.0f / 64.0f), a1 = (float)(lane + 64) * (1.0f / 64.0f); T[lane] = q ? sinpif(a0) : cospif(a0); T[lane + 64] = q ? sinpif(a1) : cospif(a1); }
                { const int r = lane >> 3, c0 = (lane & 7) * 16; const float* wp = w_in + (size_t)(kb8 * 8 + r) * INW + g * 128 + c0; const float gk = g_mix[kb8 * 8 + r];
                  f32x4 w4[4];
#pragma unroll
                  for (int e = 0; e < 4; ++e) w4[e] = *(const f32x4*)(wp + 4 * e);
#pragma unroll
                  for (int e = 0; e < 4; ++e)
#pragma unroll
                      for (int j = 0; j < 4; ++j) Wl[(c0 + 4 * e + j) * 8 + r] = w4[e][j] * gk; }
                LDS_WAIT(); asm volatile("" ::: "memory");
                float ac[8];
#pragma unroll
                for (int kk = 0; kk < 8; ++kk) ac[kk] = 0.f;
#pragma unroll 4
                for (int cp = 0; cp < 128; ++cp) {
                    const f32x4 wa = *(const LAS f32x4*)(Wl + cp * 8), wb = *(const LAS f32x4*)(Wl + cp * 8 + 4);
                    const float tt = T[(cp * c) & 127]; const float t = spec ? ((cp & 1) ? -1.0f : 1.0f) : tt;
#pragma unroll
                    for (int kk = 0; kk < 4; ++kk) { ac[kk] += wa[kk] * t; ac[4 + kk] += wb[kk] * t; }
                }
                v4u o; o.x = pk2(ac[0], ac[1]); o.y = pk2(ac[2], ac[3]); o.z = pk2(ac[4], ac[5]); o.w = pk2(ac[6], ac[7]);
                *(v4u*)(WIN + (size_t)((g >> 1) * 256 + q * 128 + (g & 1) * 64 + c) * DM + kb8 * 8) = o;
                LDS_WAIT(); asm volatile("" ::: "memory");
            }
            if (!late_ok) {
            for (int it = gw0; it < 4096; it += NGW) {
                const int row = it >> 1, hh = it & 1, kb = row >> 8, r = row & 255, k = 128 * kb + (r & 127), n0 = hh * 512 + lane * 8; float v[8];
#pragma unroll
                for (int e = 0; e < 8; ++e) { const float ph_ = (float)((k * (n0 + e)) & 2047) * (1.0f / 1024.0f); v[e] = (r < 128 ? cospif(ph_) : sinpif(ph_)) * (1.0f / 512.0f); }
                v4u o; o.x = pk2(v[0], v[1]); o.y = pk2(v[2], v[3]); o.z = pk2(v[4], v[5]); o.w = pk2(v[6], v[7]);
                *(v4u*)(DFT + (size_t)row * 1024 + n0) = o;
            }
            }
            if (gw0 == 0) {
#pragma unroll
                for (int e = 0; e < 16; ++e) { const float inv = powf(10000.0f, -(float)(2 * e) / 32.0f); const float ang = (float)lane * inv; ROPEC[lane * 16 + e] = cosf(ang); ROPES[lane * 16 + e] = sinf(ang); }
            }
            for (int m0 = gw0 * 4; m0 < M; m0 += NGW * 4) {
                f32x4 v[4][4];
#pragma unroll
                for (int r = 0; r < 4; ++r)
#pragma unroll
                    for (int j = 0; j < 4; ++j) v[r][j] = __builtin_nontemporal_load((const f32x4*)(x + (size_t)(m0 + r) * DM) + lane + 64 * j);
#pragma unroll
                for (int r = 0; r < 4; ++r) { float s = 0.f;
#pragma unroll
                    for (int j = 0; j < 4; ++j) s += (v[r][j][0] * v[r][j][0] + v[r][j][1] * v[r][j][1]) + (v[r][j][2] * v[r][j][2] + v[r][j][3] * v[r][j][3]);
                    s = wave_sum(s);
                    unsigned long long* o8 = (unsigned long long*)(XB + (size_t)(m0 + r) * DM) + lane;
#pragma unroll
                    for (int j = 0; j < 4; ++j) o8[64 * j] = (unsigned long long)pk2(v[r][j][0], v[r][j][1]) | ((unsigned long long)pk2(v[r][j][2], v[r][j][3]) << 32);
                    if (lane < 16) ST1[(size_t)(m0 + r) * 16 + lane] = s * (1.0f / 16.0f); }
            }
            __syncthreads();
        } else if ((ph == 1 || ph == 6) && PH_ON(1)) {
#ifndef GEMM_KROT
#define GEMM_KROT 0
#endif
#ifndef PROBE_HALFCU
#define PROBE_HALFCU 0
#endif
            ((LAS unsigned*)(ldsp + pg8::WIN_TBL_OFF + 4096))[tid >> 6] = 0u;
            pg8::Gemm g{XB, ph == 1 ? W1 : W2, M, NGU, DM}; pg8::StaticOrder S; S.init(M, NGU, G, bx); S.rot = GEMM_KROT;
            if (PROBE_HALFCU && ph == 1) { if ((bx >> 3) & 1) S.init(M, 0, G, bx); else S.init(M, NGU, G / 2, (bx & 7) + 8 * (bx >> 4)); }
            pg8::EpiSwiGLU E{ACT, ph == 1 ? ST1 : ST3, ph != 1};
            #ifndef SWIGLU_SP2
#define SWIGLU_SP2 true
#endif
#ifndef GEMM_IMM
#define GEMM_IMM false
#endif
            #ifndef SWIGLU_ALIGN
#define SWIGLU_ALIGN true
#endif
            #ifndef GEMM_PF
#define GEMM_PF false
#endif
            pg8::gemm_phase<pg8::EpiSwiGLU, pg8::StaticOrder, SWIGLU_ALIGN, SWIGLU_SP2, false, false, GEMM_IMM, GEMM_PF>(ldsp, g, S, E);
        } else if ((ph == 2 || ph == 5) && PH_ON(2)) {
            pg8::Gemm g{ph == 5 ? MIX : ACT, ph == 2 ? WD1 : WOUT, M, DM, ph == 5 ? DM : DFFP}; pg8::StaticOrder S; S.init(M, DM, G, bx);
#ifndef REV_MASK
#define REV_MASK 0
#endif
            S.rev = (REV_MASK >> ph) & 1;
            pg8::EpiResid E{XB, ph == 2 ? ST2 : ST3, ph == 5 ? BIASP : (const float*)nullptr, ph == 5 ? 1.0f : 0.5f, ph == 5};
            pg8::gemm_phase<pg8::EpiResid, pg8::StaticOrder, true, true>(ldsp, g, S, E);
        } else if (ph == 3 && PH_ON(3)) {
            { LAS float* tb = (LAS float*)(ldsp + pg8::WIN_TBL_OFF);
              for (int i = tid; i < 1024; i += NWAVES * 64) { tb[i] = ROPEC[i]; tb[1024 + i] = ROPES[i]; }
              if (tid < 64) tb[2048 + tid] = q_norm[tid]; else if (tid < 128) tb[2112 + tid - 64] = k_norm[tid - 64];
              __syncthreads(); }
            pg8::Gemm g{XB, WIN, M, NIN, DM}; pg8::StaticOrder S; S.init(M, NIN, G, bx); S.mode = 1;
            pg8::EpiWin E{ST2, XT, TV, ALTP, QB_, KB_, VB_, q_norm, k_norm, ROPEC, ROPES};
            pg8::gemm_phase<pg8::EpiWin, pg8::StaticOrder, true, true, true, false>(ldsp, g, S, E);
#ifndef LATE_REP
#define LATE_REP 1
#endif
            if (late_ok && 2 * G + bx >= 640) for (int lrep_ = 0; lrep_ < LATE_REP; ++lrep_) {
                LAS float* scr = (LAS float*)(ldsp + wave * 16384);
                const int gwi = (bx - 128) * NWAVES + wave, ngwi = 128 * NWAVES;
#ifndef LREP_A
#define LREP_A 1
#endif
#ifndef LREP_B
#define LREP_B 1
#endif
#ifndef LREP_C
#define LREP_C 1
#endif
#ifndef LREP_D
#define LREP_D 1
#endif
            for (int rA_ = 0; rA_ < LREP_A; ++rA_)
            for (int it = gwi; it < 4096; it += ngwi) {
                const int row = it >> 1, hh = it & 1, kb = row >> 8, r = row & 255, k = 128 * kb + (r & 127), n0 = hh * 512 + lane * 8; float v[8];
#pragma unroll
                #ifdef DFT_HWSIN
                for (int e = 0; e < 8; ++e) { const float rv_ = (float)((k * (n0 + e)) & 2047) * (1.0f / 2048.0f); v[e] = (r < 128 ? __builtin_amdgcn_cosf(rv_) : __builtin_amdgcn_sinf(rv_)) * (1.0f / 512.0f); }
#else
                for (int e = 0; e < 8; ++e) { const float ph_ = (float)((k * (n0 + e)) & 2047) * (1.0f / 1024.0f); v[e] = (r < 128 ? cospif(ph_) : sinpif(ph_)) * (1.0f / 512.0f); }
#endif
                v4u o; o.x = pk2(v[0], v[1]); o.y = pk2(v[2], v[3]); o.z = pk2(v[4], v[5]); o.w = pk2(v[6], v[7]);
                *(v4u*)(DFT + (size_t)row * 1024 + n0) = o;
            }
#ifdef LATE_PIPE
            for (int rB_ = 0; rB_ < LREP_B; ++rB_) {
                struct TI { const float* W; bf16* dst; const float* gain; int N, k0, n0, ldk; };
                auto tdec = [&](int gid) { TI t;
                    if (gid < 2752) { const int mat = gid / 1376, r2 = gid % 1376, kb = r2 / 86, nb = r2 % 86, n0 = nb * 32; const int drow = 256 * (n0 >> 7) + (n0 & 127) + 128 * mat;
                        t.W = mat ? w_up2 : w_gate2; t.N = DFF; t.k0 = kb * 64; t.n0 = n0; t.dst = W2 + (size_t)drow * DM; t.ldk = DM; t.gain = g_ffn2; }
                    else if (gid < 4128) { const int r = gid - 2752, kb = r / 32, nb = r % 32; t.W = w_down2; t.N = DM; t.k0 = kb * 64; t.n0 = nb * 32; t.dst = WD2 + (size_t)(nb * 32) * DFFP; t.ldk = DFFP; t.gain = nullptr; }
                    else { const int r = gid - 4128, kb = 8 + r / 32, nb = r % 32; t.W = w_out; t.N = DM; t.k0 = kb * 64; t.n0 = nb * 32; t.dst = WOUT + (size_t)(nb * 32) * DM; t.ldk = DM; t.gain = nullptr; }
                    return t; };
#ifdef LATE_PIPE2
                int gid = gwi; V8 cur = {}, nx1 = {};
                if (gid < 4384) { const TI t = tdec(gid); cur = p0_item_load(t.W, t.N, t.k0, t.n0, lane, t.gain); }
                if (gid + ngwi < 4384) { const TI t = tdec(gid + ngwi); nx1 = p0_item_load(t.W, t.N, t.k0, t.n0, lane, t.gain); }
                for (; gid < 4384; gid += ngwi) {
                    const TI t = tdec(gid); const int gn = gid + 2 * ngwi; V8 nx2 = nx1;
                    if (gn < 4384) { const TI tn = tdec(gn); nx2 = p0_item_load(tn.W, tn.N, tn.k0, tn.n0, lane, tn.gain); }
                    p0_item_finish(cur, t.k0, t.dst, t.ldk, t.gain, scr, lane);
                    cur = nx1; nx1 = nx2;
                }
#else
                int gid = gwi; V8 cur = {};
                if (gid < 4384) { const TI t = tdec(gid); cur = p0_item_load(t.W, t.N, t.k0, t.n0, lane, t.gain); }
                for (; gid < 4384; gid += ngwi) {
                    const TI t = tdec(gid); const int gn = gid + ngwi; V8 nxt = cur;
                    if (gn < 4384) { const TI tn = tdec(gn); nxt = p0_item_load(tn.W, tn.N, tn.k0, tn.n0, lane, tn.gain); }
                    p0_item_finish(cur, t.k0, t.dst, t.ldk, t.gain, scr, lane);
                    cur = nxt;
                }
#endif
            }
#else
            for (int it = 2752 * 1 + gwi; it < 2752 * 2; it += ngwi) {
                const int f = it / 2752, r = it % 2752, mat = r / 1376, r2 = r % 1376, kb = r2 / 86, nb = r2 % 86, n0 = nb * 32;
                const int drow = 256 * (n0 >> 7) + (n0 & 127) + 128 * mat;
                const float* Wsrc = f ? (mat ? w_up2 : w_gate2) : (mat ? w_up1 : w_gate1);
                p0_transpose_item(Wsrc, DFF, kb * 64, n0, (f ? W2 : W1) + (size_t)drow * DM, DM, f ? g_ffn2 : g_ffn1, scr, lane);
            }
            for (int it = 1376 * 1 + gwi; it < 1376 * 2; it += ngwi) {
                const int f = it / 1376, r = it % 1376, kb = r / 32, nb = r % 32;
                p0_transpose_item(f ? w_down2 : w_down1, DM, kb * 64, nb * 32, (f ? WD2 : WD1) + (size_t)(nb * 32) * DFFP, DFFP, nullptr, scr, lane);
            }
#endif
            unsigned zz = 0u; asm volatile("" : "+v"(zz)); const v4u zero4 = {zz, zz, zz, zz};
            for (int it = 256 * 1 + gwi; it < 256 * 2; it += ngwi) {
                const int f = it >> 8, r = (it >> 1) & 127, hh = it & 1; const int row = 256 * 21 + 64 + (r & 63) + 128 * (r >> 6);
                *(v4u*)((f ? W2 : W1) + (size_t)row * DM + hh * 512 + lane * 8) = zero4;
            }
            for (int it = 128 * 1 + gwi; it < 128 * 2; it += ngwi) {
                const int f = it >> 7, row = (it & 127) * 8 + (lane >> 3);
                *(v4u*)((f ? WD2 : WD1) + (size_t)row * DFFP + DFF + (lane & 7) * 8) = zero4;
            }
#ifndef LATE_PIPE
            for (int it = gwi; it < 256; it += ngwi) {
                const int kb = 8 + it / 32, nb = it % 32;
                p0_transpose_item(w_out, DM, kb * 64, nb * 32, WOUT + (size_t)(nb * 32) * DM, DM, nullptr, scr, lane);
            }
#endif
            for (int rC_ = 0; rC_ < LREP_C; ++rC_)
            for (int it = gwi; it < 1024; it += ngwi) {
                const int g = it >> 8, cb = (it >> 4) & 15, n = (it & 15) * 64 + lane;
                LAS float* Fl = scr;
                { const int r = lane >> 3, d0 = (lane & 7) * 16, ps = cb * 8 + r; const float* fp = fnet_w + (size_t)(g * 128 + (ps <= 64 ? ps : 192 - ps) - r) * 128;
                  f32x4 f4[4];
#pragma unroll
                  for (int e = 0; e < 4; ++e) f4[e] = *(const f32x4*)(fp + r * 128 + d0 + 4 * e);
#pragma unroll
                  for (int e = 0; e < 4; ++e)
#pragma unroll
                      for (int j = 0; j < 4; ++j) Fl[(d0 + 4 * e + j) * 8 + r] = f4[e][j]; }
                LDS_WAIT(); asm volatile("" ::: "memory");
                float a[8];
#pragma unroll
                for (int cc = 0; cc < 8; ++cc) a[cc] = 0.f;
                const float* wo = w_out + (size_t)(g * 128) * DM + n;
#ifdef FOLD_UNROLL
#pragma unroll
#endif
                for (int d = 0; d < 128; d += 16) {
                    float bq[16];
#pragma unroll
                    for (int e = 0; e < 16; ++e) bq[e] = wo[(size_t)(d + e) * DM];
#pragma unroll
                    for (int e = 0; e < 16; ++e) { const f32x4 fa = *(const LAS f32x4*)(Fl + (d + e) * 8), fb = *(const LAS f32x4*)(Fl + (d + e) * 8 + 4);
#pragma unroll
                        for (int cc = 0; cc < 4; ++cc) { a[cc] += fa[cc] * bq[e]; a[4 + cc] += fb[cc] * bq[e]; } }
                }
                v4u o; o.x = pk2(a[0], a[1]); o.y = pk2(a[2], a[3]); o.z = pk2(a[4], a[5]); o.w = pk2(a[6], a[7]);
                *(v4u*)(WOUT + (size_t)n * DM + g * 128 + cb * 8) = o;
                LDS_WAIT(); asm volatile("" ::: "memory");
            }
            for (int rD_ = 0; rD_ < LREP_D; ++rD_)
            for (int it = gwi; it < 128; it += ngwi) {
                f32x4 p0 = {0.f, 0.f, 0.f, 0.f}, p1 = {0.f, 0.f, 0.f, 0.f}; f32x4 wv[8][2]; float fb[8];
#pragma unroll
                for (int i = 0; i < 8; ++i) { const int r = lane + 64 * i; fb[i] = fnet_b[r]; wv[i][0] = *(const f32x4*)(w_out + (size_t)r * DM + it * 8); wv[i][1] = *(const f32x4*)(w_out + (size_t)r * DM + it * 8 + 4); }
#pragma unroll
                for (int i = 0; i < 8; ++i) { p0 += wv[i][0] * fb[i]; p1 += wv[i][1] * fb[i]; }
                float o8[8];
#pragma unroll
                for (int j = 0; j < 4; ++j) { o8[j] = wave_sum(p0[j]); o8[4 + j] = wave_sum(p1[j]); }
                if (lane == 0) { *(f32x4*)(BIASP + it * 8) = (f32x4){o8[0], o8[1], o8[2], o8[3]}; *(f32x4*)(BIASP + it * 8 + 4) = (f32x4){o8[4], o8[5], o8[6], o8[7]}; }
            }
            }
        } else if (ph == 4 && PH_ON(4)) {
#ifndef PROBE_SUB
#define PROBE_SUB 0
#endif
#ifndef P4_SWAP
#define P4_SWAP 0
#endif
            const bool attn_first = P4_SWAP && ((vcu >> 3) & 1);
            for (int step = 0; step < 2; ++step) {
                if ((step == 0) != attn_first) {
                    for (int rep_ = 0; rep_ < 1 + (PROBE_SUB & 1); ++rep_) {
                        pg8::Gemm g{DFT, XT, M, 512, 1024}; pg8::StaticOrder S; S.init(M, 512, G, bx); S.mode = 2;
                        pg8::EpiDft E{MIX, TV, ALTP};
                        pg8::gemm_phase<pg8::EpiDft, pg8::StaticOrder, true, true, false, 2>(ldsp, g, S, E);
                    }
                } else {
                    for (int rep_ = 0; rep_ < 1 + ((PROBE_SUB >> 1) & 1); ++rep_) {
                        const attn_body::AttnTensors AT{(const attn_body::bf16*)QB_, (const attn_body::bf16*)KB_, (const attn_body::bf16*)VB_, (attn_body::bf16*)MIX};
                        const attn_body::AttnOrder S(G, vcu);
                        float gq = fabsf(q_norm[lane]), gk = fabsf(k_norm[lane]);
                        gq = wave_max(gq); gk = wave_max(gk);
                        const float coff = 8.0f * 1.4426950408889634f * gq * gk;
#ifdef ATTN_SPRIO
                        if (wave < 4) __builtin_amdgcn_s_setprio(1); else __builtin_amdgcn_s_setprio(0);
#endif
                        attn_body::attn_phase<attn_body::AttnOrder>((char*)lds, AT, S, coff);
                    }
                }
            }
        } else if (ph == 7 && PH_ON(7)) {
            pg8::Gemm g{ACT, WD2, M, DM, DFFP}; pg8::StaticOrder S; S.init(M, DM, G, bx);
            S.rev = (REV_MASK >> 7) & 1;
            pg8::EpiFinal E{XB, ST4, (unsigned*)(ctl + CW_SEAM), g_final, out, 0.5f};
            pg8::gemm_phase<pg8::EpiFinal, pg8::StaticOrder, true, true>(ldsp, g, S, E);
        }
#ifdef PROBE_CLOCK
        if (ph == PROBE_CLOCK) { const unsigned long long t1 = __builtin_amdgcn_s_memtime(), r1 = __builtin_amdgcn_s_memrealtime();
            if (bx == 0 && tid == 0) { const unsigned long long mhz = (t1 - pc_t0) * 100ull / (r1 - pc_r0); MISC[16] = (unsigned)mhz; } }
#endif
#ifdef PROBE_SKEW
        if (ph == PROBE_SKEW && tid == 0) { ((unsigned long long*)(ap->ws + WS_MISC + 786432))[bx] = __builtin_amdgcn_s_memrealtime(); }
        if (ph == PROBE_SKEW + 1 && bx == 0 && tid == 0) {
#if defined(PROBE_SKEW_XCD)
            unsigned long long base = ~0ull; for (int i = 0; i < G; ++i) { const unsigned long long v = ((volatile unsigned long long*)(ap->ws + WS_MISC + 786432))[i]; base = v < base ? v : base; }
            unsigned long long mnm = ~0ull, mxm = 0ull; for (int x = 0; x < 8; ++x) { unsigned long long s = 0; for (int i = x; i < G; i += 8) s += ((volatile unsigned long long*)(ap->ws + WS_MISC + 786432))[i] - base; s /= (unsigned long long)(G / 8); mnm = s < mnm ? s : mnm; mxm = s > mxm ? s : mxm; }
#if defined(PROBE_SKEW_ID)
            { int slow = 0, fast = 0; unsigned long long smx = 0, smn = ~0ull; for (int x = 0; x < 8; ++x) { unsigned long long s = 0; for (int i = x; i < G; i += 8) s += ((volatile unsigned long long*)(ap->ws + WS_MISC + 786432))[i] - base; if (s > smx) { smx = s; slow = x; } if (s < smn) { smn = s; fast = x; } }
              MISC[16] = (unsigned)((slow * 8 + fast) * 5000) + (unsigned)((mxm - mnm) > 4999 ? 4999 : (mxm - mnm)); }
#else
            MISC[16] = (unsigned)(mxm - mnm);
#endif
#else
            unsigned long long mn = ~0ull, mx = 0ull; for (int i = 0; i < G; ++i) { const unsigned long long v = ((volatile unsigned long long*)(ap->ws + WS_MISC + 786432))[i]; mn = v < mn ? v : mn; mx = v > mx ? v : mx; } MISC[16] = (unsigned)(mx - mn);
#endif
        }
#endif
        if (ph2 + 1 < 2 * hi && !(!(ph2 & 1) && ph + 1 == hi && !((PROBE_REPEAT >> ph) & 1))) GRID_BAR();
    }
#undef GRID_BAR
#ifdef PROBE_SKEW
    if (blockIdx.x == 0 && threadIdx.x == 0) { const unsigned sk = MISC[16]; const unsigned long long r0 = __builtin_amdgcn_s_memrealtime(); const unsigned long long ticks = (unsigned long long)sk * 20ull;
        while (__builtin_amdgcn_s_memrealtime() - r0 < ticks) __builtin_amdgcn_s_sleep(8); }
#endif
#ifdef PROBE_CLOCK
    if (blockIdx.x == 0 && threadIdx.x == 0) { const unsigned mhz = MISC[16]; const unsigned long long r0 = __builtin_amdgcn_s_memrealtime(); const unsigned long long ticks = (unsigned long long)(mhz / 4u) * 100ull;
        while (__builtin_amdgcn_s_memrealtime() - r0 < ticks) __builtin_amdgcn_s_sleep(8); }
#endif
}

extern "C" void kernel_launch(void* const* d_in, const int* in_sizes, int n_in, void* d_out, int out_size, void* d_ws, size_t ws_size, hipStream_t stream) {
    static int grid = 0;
    if (grid == 0) {
        if (n_in != 17 || in_sizes[0] != M * DM || out_size != M * DM || ws_size < WS_END) { fprintf(stderr, "kernel_launch: unexpected shapes (n_in %d, in0 %d, out %d, ws %zu); nothing launched\n", n_in, n_in > 0 ? in_sizes[0] : -1, out_size, ws_size); grid = -1; return; }
        int dev = 0, cus = 0, per_cu = 0;
        if (hipGetDevice(&dev) != hipSuccess || hipDeviceGetAttribute(&cus, hipDeviceAttributeMultiprocessorCount, dev) != hipSuccess) { fprintf(stderr, "kernel_launch: device query failed\n"); grid = -1; return; }
        if (hipFuncSetAttribute((const void*)mk_fwd, hipFuncAttributeMaxDynamicSharedMemorySize, LDS_BYTES) != hipSuccess) { fprintf(stderr, "kernel_launch: hipFuncSetAttribute failed\n"); grid = -1; return; }
        if (hipOccupancyMaxActiveBlocksPerMultiprocessor(&per_cu, (const void*)mk_fwd, NWAVES * 64, LDS_BYTES) != hipSuccess || per_cu < 1) { fprintf(stderr, "kernel_launch: occupancy query reports %d workgroups per CU\n", per_cu); per_cu = 1; }
        (void)hipGetLastError();
        grid = cus;
    }
    if (grid < 0) return;
    if (hipMemsetAsync((char*)d_ws + WS_CTL, 0, CTL_ZERO_BYTES, stream) != hipSuccess) { fprintf(stderr, "kernel_launch: hipMemsetAsync failed\n"); return; }
    Args a{};
    for (int i = 0; i < 17; ++i) a.in[i] = (const float*)d_in[i];
    a.out = (float*)d_out; a.ws = (unsigned char*)d_ws;
    for (int li = 0; li < N_LAUNCHES; ++li) {
        a.ph_lo = (N_LAUNCHES == 1) ? 0 : li; a.ph_hi = (N_LAUNCHES == 1) ? N_PHASES : li + 1; a.li = li;
        hipLaunchKernelGGL(mk_fwd, dim3(grid), dim3(NWAVES * 64), LDS_BYTES, stream, a);
        const hipError_t le = hipPeekAtLastError();
        if (le != hipSuccess) { fprintf(stderr, "kernel_launch: launch %d failed: %s\n", li, hipGetErrorName(le)); break; }
    }
}
```
